# Optimizing an MI355X kernel written in HIP

```python
import math
import jax
import jax.numpy as jnp
from jax import lax
import numpy as np

D_MODEL = 1024
BATCH = 2
SEQ = 16384
DEPTH = 2

GRID_W = 64
CTX_LEN = 256
HEAD_DIM = 64
A_HEADS = 6
A_KV = 2
B_HEADS = 4
B_QK_DIM = HEAD_DIM // 2
C_HEADS = 6
C_KV = 2
MIX_WIDTH = (A_HEADS + B_HEADS + C_HEADS) * HEAD_DIM
IN_WIDTHS = (A_HEADS * HEAD_DIM, A_KV * HEAD_DIM, A_KV * HEAD_DIM,
             B_HEADS * HEAD_DIM, B_HEADS * HEAD_DIM, B_HEADS * HEAD_DIM,
             C_HEADS * HEAD_DIM, C_KV * HEAD_DIM, C_KV * HEAD_DIM)
IN_WIDTH = sum(IN_WIDTHS)
D_FF = -(-(8 * D_MODEL) // (3 * 256)) * 256
WINDOW = 128
Q_BLOCK = 128
ROPE_THETA = 10000.0
EPS = 1e-6
NEG_INF = -1e30

kernel_name = 'hybrid_parallel_heads_dit_block'


def rmsnorm(x, g):
    xf = x.astype(jnp.float32)
    y = xf * lax.rsqrt(jnp.mean(xf * xf, axis=-1, keepdims=True) + EPS)
    return (y * g.astype(jnp.float32)).astype(x.dtype)


def modulate(h, shift, scale):
    return h * (1 + scale) + shift


def split_columns(p):
    offsets = [int(o) for o in np.cumsum(IN_WIDTHS)[:-1]]
    return jnp.split(p, offsets, axis=-1)


def to_heads(t, n):
    b, s, _ = t.shape
    return t.reshape(b, s, n, -1).transpose(0, 2, 1, 3)


def merge_heads(o):
    b, h, s, d = o.shape
    return o.transpose(0, 2, 1, 3).reshape(b, s, h * d)


def group(q, g):
    b, h, s, d = q.shape
    return q.reshape(b, g, h // g, s, d)


def ungroup(o):
    b, g, r, s, d = o.shape
    return o.reshape(b, g * r, s, d)


def rope_1d(x, pos):
    half = x.shape[-1] // 2
    freqs = ROPE_THETA ** (-jnp.arange(half, dtype=jnp.float32) / half)
    ang = pos.astype(jnp.float32)[:, None] * freqs[None, :]
    cos = jnp.cos(ang).astype(x.dtype)
    sin = jnp.sin(ang).astype(x.dtype)
    x1, x2 = x[..., :half], x[..., half:]
    return jnp.concatenate([x1 * cos - x2 * sin, x1 * sin + x2 * cos], axis=-1)


def rope_2d(x, rows, cols):
    h = x.shape[-1] // 2
    return jnp.concatenate([rope_1d(x[..., :h], rows), rope_1d(x[..., h:], cols)], axis=-1)


def scores(q, k, scale):
    return jnp.einsum('bgrqd,bgkd->bgrqk', q, k, preferred_element_type=jnp.float32) * scale


def weigh(p, v):
    return jnp.einsum('bgrqk,bgkd->bgrqd', p.astype(v.dtype), v)


def sweep_blocks(fn, *qs):
    def split(q):
        b, g, r, s, d = q.shape
        return jnp.moveaxis(q.reshape(b, g, r, s // Q_BLOCK, Q_BLOCK, d), 3, 0)
    out = lax.map(lambda blk: fn(*blk), tuple(split(q) for q in qs))
    nb, b, g, r, qb, dv = out.shape
    return jnp.moveaxis(out, 0, 3).reshape(b, g, r, nb * qb, dv)


def window_attention(q, k, v, kc, vc, sink, scale):
    b, g, r, s, d = q.shape
    nb = s // Q_BLOCK

    def band(t):
        tp = jnp.pad(t, ((0, 0), (0, 0), (Q_BLOCK, Q_BLOCK), (0, 0)))
        tp = tp.reshape(b, g, nb + 2, Q_BLOCK, t.shape[-1])
        blocks = jnp.concatenate([tp[:, :, :-2], tp[:, :, 1:-1], tp[:, :, 2:]], axis=3)
        return jnp.moveaxis(blocks, 2, 0)

    kb, vb = band(k), band(v)
    qb = jnp.moveaxis(q.reshape(b, g, r, nb, Q_BLOCK, d), 3, 0)
    qpos = jnp.arange(nb)[:, None] * Q_BLOCK + jnp.arange(Q_BLOCK)[None, :]
    kpos = jnp.arange(nb)[:, None] * Q_BLOCK - Q_BLOCK + jnp.arange(3 * Q_BLOCK)[None, :]
    valid = ((jnp.abs(qpos[:, :, None] - kpos[:, None, :]) <= WINDOW)
             & (kpos >= 0)[:, None, :] & (kpos < s)[:, None, :])
    sink_col = jnp.broadcast_to(sink.astype(jnp.float32)[None, :, :, None, None], (b, g, r, Q_BLOCK, 1))

    def one(args):
        qblk, kblk, vblk, vmask = args
        s_loc = jnp.where(vmask, scores(qblk, kblk, scale), NEG_INF)
        s_all = jnp.concatenate([s_loc, scores(qblk, kc, scale), sink_col], axis=-1)
        p = jax.nn.softmax(s_all, axis=-1)
        return weigh(p[..., :3 * Q_BLOCK], vblk) + weigh(p[..., 3 * Q_BLOCK:-1], vc)

    out = lax.map(one, (qb, kb, vb, valid))
    return jnp.moveaxis(out, 0, 3).reshape(b, g, r, s, -1)


def diff_lambda(lam_q1, lam_k1, lam_q2, lam_k2, lam_init):
    f = lambda a, c: jnp.exp(jnp.sum(a.astype(jnp.float32) * c.astype(jnp.float32)))
    return f(lam_q1, lam_k1) - f(lam_q2, lam_k2) + lam_init


def token_mixers(hx, hc, w_in, g_q, g_k, lam_q1, lam_k1, lam_q2, lam_k2, lam_init, g_subln, sink,
                 rows, cols, with_ctx_out):
    axq, axk, axv, bxq, bxk, bxv, cxq, cxk, cxv = split_columns(hx @ w_in)
    acq, ack, acv, bcq, bck, bcv, ccq, cck, ccv = split_columns(hc @ w_in)
    pos = lambda t: rope_2d(t, rows, cols)

    sa = HEAD_DIM ** -0.5
    qa = pos(rmsnorm(to_heads(axq, A_HEADS), g_q))
    ka = pos(rmsnorm(to_heads(axk, A_KV), g_k))
    qa_c = rmsnorm(to_heads(acq, A_HEADS), g_q)
    ka_c = rmsnorm(to_heads(ack, A_KV), g_k)
    va_c = to_heads(acv, A_KV)
    ka_all = jnp.concatenate([ka, ka_c], axis=2)
    va_all = jnp.concatenate([to_heads(axv, A_KV), va_c], axis=2)
    oa = ungroup(sweep_blocks(
        lambda qblk: weigh(jax.nn.softmax(scores(qblk, ka_all, sa), axis=-1), va_all),
        group(qa, A_KV)))

    sb = B_QK_DIM ** -0.5
    lam = diff_lambda(lam_q1, lam_k1, lam_q2, lam_k2, lam_init)
    qb_x = to_heads(bxq, B_HEADS)
    kb_x = to_heads(bxk, B_HEADS)
    qb_c = to_heads(bcq, B_HEADS)
    kb_c = to_heads(bck, B_HEADS)
    vb_c = to_heads(bcv, B_HEADS)
    q1, q2 = pos(qb_x[..., :B_QK_DIM]), pos(qb_x[..., B_QK_DIM:])
    k1_all = jnp.concatenate([pos(kb_x[..., :B_QK_DIM]), kb_c[..., :B_QK_DIM]], axis=2)
    k2_all = jnp.concatenate([pos(kb_x[..., B_QK_DIM:]), kb_c[..., B_QK_DIM:]], axis=2)
    vb_all = jnp.concatenate([to_heads(bxv, B_HEADS), vb_c], axis=2)

    def diff_block(qb1, qb2):
        p = (jax.nn.softmax(scores(qb1, k1_all, sb), axis=-1)
             - lam * jax.nn.softmax(scores(qb2, k2_all, sb), axis=-1))
        return weigh(p, vb_all)

    ob = sweep_blocks(diff_block, group(q1, B_HEADS), group(q2, B_HEADS))
    ob = rmsnorm(ungroup(ob), g_subln) * (1.0 - lam_init)

    sc = HEAD_DIM ** -0.5
    sink_gr = sink.reshape(C_KV, C_HEADS // C_KV)
    qc_x = pos(to_heads(cxq, C_HEADS))
    kc_x = pos(to_heads(cxk, C_KV))
    vc_x = to_heads(cxv, C_KV)
    qc_c = to_heads(ccq, C_HEADS)
    kc_c = to_heads(cck, C_KV)
    vc_c = to_heads(ccv, C_KV)
    oc = ungroup(window_attention(group(qc_x, C_KV), kc_x, vc_x, kc_c, vc_c, sink_gr, sc))

    ox = merge_heads(jnp.concatenate([oa, ob, oc], axis=1))
    if not with_ctx_out:
        return ox, None

    oa_c = ungroup(weigh(jax.nn.softmax(scores(group(qa_c, A_KV), ka_c, sa), axis=-1), va_c))
    p_b = (jax.nn.softmax(scores(group(qb_c[..., :B_QK_DIM], B_HEADS), kb_c[..., :B_QK_DIM], sb), axis=-1)
           - lam * jax.nn.softmax(scores(group(qb_c[..., B_QK_DIM:], B_HEADS), kb_c[..., B_QK_DIM:], sb), axis=-1))
    ob_c = rmsnorm(ungroup(weigh(p_b, vb_c)), g_subln) * (1.0 - lam_init)
    s_cc = scores(group(qc_c, C_KV), kc_c, sc)
    sink_col = jnp.broadcast_to(sink_gr.astype(jnp.float32)[None, :, :, None, None], s_cc.shape[:-1] + (1,))
    p_c = jax.nn.softmax(jnp.concatenate([s_cc, sink_col], axis=-1), axis=-1)
    oc_c = ungroup(weigh(p_c[..., :-1], vc_c))
    return ox, merge_heads(jnp.concatenate([oa_c, ob_c, oc_c], axis=1))


def swiglu(h, w1, w3, w2):
    return (jax.nn.silu(h @ w1) * (h @ w3)) @ w2


def setup_inputs(seed: int = 0) -> dict:
    key = jax.random.key(seed)
    ks = jax.random.split(key, 24)
    D = D_MODEL

    def nrm(k, shape, scale):
        return jax.random.normal(k, shape, jnp.float32) * scale

    return {
        'x': nrm(ks[0], (BATCH, SEQ, D), 1.0),
        'c': nrm(ks[1], (BATCH, D), 1.0),
        'ctx': nrm(ks[2], (BATCH, CTX_LEN, D), 1.0),
        'c_ctx': nrm(ks[3], (D,), 1.0),
        'w_ada': nrm(ks[4], (DEPTH, D, 6 * D), 0.5 * D ** -0.5),
        'b_ada': nrm(ks[5], (DEPTH, 6 * D), 0.02),
        'g_attn': 1.0 + nrm(ks[6], (DEPTH, D), 0.05),
        'g_ffn': 1.0 + nrm(ks[7], (DEPTH, D), 0.05),
        'w_in': nrm(ks[8], (DEPTH, D, IN_WIDTH), D ** -0.5),
        'g_q': 1.0 + nrm(ks[9], (DEPTH, HEAD_DIM), 0.05),
        'g_k': 1.0 + nrm(ks[10], (DEPTH, HEAD_DIM), 0.05),
        'lam_q1': nrm(ks[11], (DEPTH, B_QK_DIM), 0.1),
        'lam_k1': nrm(ks[12], (DEPTH, B_QK_DIM), 0.1),
        'lam_q2': nrm(ks[13], (DEPTH, B_QK_DIM), 0.1),
        'lam_k2': nrm(ks[14], (DEPTH, B_QK_DIM), 0.1),
        'g_subln': 1.0 + nrm(ks[15], (DEPTH, HEAD_DIM), 0.05),
        'sink_logit': nrm(ks[16], (DEPTH, C_HEADS), 0.5),
        'w_out': nrm(ks[17], (DEPTH, MIX_WIDTH, D), MIX_WIDTH ** -0.5),
        'w_ff1': nrm(ks[18], (DEPTH, D, D_FF), D ** -0.5),
        'w_ff3': nrm(ks[19], (DEPTH, D, D_FF), D ** -0.5),
        'w_ff2': nrm(ks[20], (DEPTH, D_FF, D), D_FF ** -0.5),
        'g_final': 1.0 + nrm(ks[21], (D,), 0.05),
    }


def reference(x, c, ctx, c_ctx, w_ada, b_ada, g_attn, g_ffn, w_in, g_q, g_k, lam_q1, lam_k1, lam_q2, lam_k2,
              g_subln, sink_logit, w_out, w_ff1, w_ff3, w_ff2, g_final):
    n_tok = x.shape[1]
    ROWS = n_tok // GRID_W
    rows = jnp.repeat(jnp.arange(ROWS, dtype=jnp.int32), GRID_W)
    cols = jnp.tile(jnp.arange(GRID_W, dtype=jnp.int32), ROWS)
    silu_c = jax.nn.silu(c)
    silu_cc = jax.nn.silu(c_ctx)
    for layer in range(DEPTH):
        last = layer == DEPTH - 1
        lam_init = 0.8 - 0.6 * math.exp(-0.3 * layer)
        mx = jnp.split((silu_c @ w_ada[layer] + b_ada[layer])[:, None, :], 6, axis=-1)
        mc = jnp.split(silu_cc @ w_ada[layer] + b_ada[layer], 6, axis=-1)
        hx = modulate(rmsnorm(x, g_attn[layer]), mx[0], mx[1])
        hc = modulate(rmsnorm(ctx, g_attn[layer]), mc[0], mc[1])
        ox, octx = token_mixers(hx, hc, w_in[layer], g_q[layer], g_k[layer], lam_q1[layer], lam_k1[layer],
                                lam_q2[layer], lam_k2[layer], lam_init, g_subln[layer], sink_logit[layer],
                                rows, cols, not last)
        x = x + mx[2] * (ox @ w_out[layer])
        x = x + mx[5] * swiglu(modulate(rmsnorm(x, g_ffn[layer]), mx[3], mx[4]),
                               w_ff1[layer], w_ff3[layer], w_ff2[layer])
        if not last:
            ctx = ctx + mc[2] * (octx @ w_out[layer])
            ctx = ctx + mc[5] * swiglu(modulate(rmsnorm(ctx, g_ffn[layer]), mc[3], mc[4]),
                                       w_ff1[layer], w_ff3[layer], w_ff2[layer])
    return rmsnorm(x, g_final)
```

```cpp
#include <hip/hip_runtime.h>
#include <hip/hip_bf16.h>
#include <hip/hip_cooperative_groups.h>
#include <cstdio>
#include <cstdint>
#include <cmath>

namespace pg8 {
#define PG8_LAS __attribute__((address_space(3)))
typedef unsigned short bf16_t;
typedef short bf16x8 __attribute__((ext_vector_type(8)));
typedef float f32x4 __attribute__((ext_vector_type(4)));
typedef unsigned u32x4 __attribute__((ext_vector_type(4)));
constexpr int BM = 256, BK = 64, HALF = 128, HTB = HALF * BK * 2  , STAGE_BYTES = 8 * HTB, NXCD = 8, WGM = 8;

__host__ __device__ __forceinline__ int lds_byte(int r, int c) { const int st = (r >> 4) * 2 + (c >> 5), rr = r & 15, cc = c & 31, ob = rr * 64 + cc * 2; return st * 1024 + (ob ^ (((ob >> 9) & 1) << 5)); }
__host__ __device__ __forceinline__ void stage_rc(int b, int& R, int& C) { const int st = b / 1024, sb = b % 1024, swz = sb ^ (((sb >> 9) & 1) << 5); R = (st >> 1) * 16 + swz / 64; C = (st & 1) * 32 + (swz % 64) / 2; }
__host__ __device__ __forceinline__ int perm32(int rho) { const int n = rho >> 4, i = rho & 15; return 8 * (i >> 2) + 4 * n + (i & 3); }

struct Unit { int pm, pn, half; };
struct Gemm { const bf16_t* A; const bf16_t* Bt; int M, N, K; };

struct StaticOrder {
    int nM, nN, nwg, G, c;
    __host__ __device__ void init(int M, int N, int G_, int c_) { nM = M / BM; nN = N / BM; nwg = nM * nN; G = G_; c = c_; }
    __host__ __device__ bool next(int i, Unit& u) const {
        const long L = (long)i * G + c; if (L >= nwg) return false;
        int wgid = (int)L; { const int q = nwg / NXCD, r = nwg % NXCD, xcd = wgid % NXCD, off = wgid / NXCD; wgid = (xcd < r ? xcd * (q + 1) : r * (q + 1) + (xcd - r) * q) + off; }
        const int nig = WGM * nN, gid = wgid / nig, fm = gid * WGM, gsz = (nM - fm) < WGM ? (nM - fm) : WGM;
        u.pm = fm + ((wgid % nig) % gsz); u.pn = (wgid % nig) / gsz; return true;
    }
    __device__ __forceinline__ void a_ready(const Unit&) const {}
    __device__ __forceinline__ void done(const Unit&) const {}
};

__device__ __forceinline__ unsigned cvt_pk_bf16(float lo, float hi) { unsigned r; asm volatile("v_cvt_pk_bf16_f32 %0, %1, %2" : "=v"(r) : "v"(lo), "v"(hi)); return r; }
typedef float f32x2 __attribute__((ext_vector_type(2)));


typedef unsigned u32x2 __attribute__((ext_vector_type(2)));
__device__ __forceinline__ unsigned pk_bf16(float lo, float hi) { typedef float f2 __attribute__((ext_vector_type(2))); typedef __bf16 b2 __attribute__((ext_vector_type(2))); f2 v = {lo, hi}; b2 b = __builtin_convertvector(v, b2); return __builtin_bit_cast(unsigned, b); }
struct Order {
    int nM, nN, nwg, nreg, G, c;
    __device__ void init(int with_ctx, int N, int G_, int c_) { nM = 128; nN = N / BM; nreg = nM * nN; nwg = nreg + (with_ctx ? 4 * nN : 0); G = G_; c = c_; }
    __device__ bool next(int i, Unit& u) const {
        const long L = (long)i * G + c; if (L >= nwg) return false;
        if (L >= nreg) { const int q = (int)L - nreg, tile = q / (2 * nN), rem = q % (2 * nN); u.pm = tile ? 129 : 64; u.pn = rem >> 1; u.half = 1 + (rem & 1); return true; }
        int wgid = (int)L; { const int q = nreg / NXCD, r = nreg % NXCD, xcd = wgid % NXCD, off = wgid / NXCD; wgid = (xcd < r ? xcd * (q + 1) : r * (q + 1) + (xcd - r) * q) + off; }
        const int nig = WGM * nN, gid = wgid / nig, fm = gid * WGM, gsz = (nM - fm) < WGM ? (nM - fm) : WGM;
        u.pm = fm + ((wgid % nig) % gsz); u.pn = (wgid % nig) / gsz; u.half = 0;
        u.pm += (u.pm >= 64) ? 1 : 0;
        return true;
    }
    __device__ __forceinline__ void a_ready(const Unit&) const {}
    __device__ __forceinline__ void done(const Unit&) const {}
};
constexpr int TPB_ = 16640, SEQ_ = 16384;
struct EpiQKV {
    static constexpr bool PERM = false, AFTER_DRAIN = false;
    bf16_t *Q, *K, *V; const float *gq, *gk, *cosA, *sinA, *cosB, *sinB; float c2a, c2b;
    unsigned* nmax;
    __device__ __forceinline__ void operator()(const f32x4 (&acc)[2][2][4][2], const Unit& u, int wr, int wc, int fr, int fq) const {
        asm volatile("" : "+v"(fr), "+v"(fq));
        const int lnq = fq * 16 + fr, bp16 = (lnq ^ 16) << 2, bp32 = (lnq ^ 32) << 2;
        const int g = 4 * u.pn + wc;
        bf16_t* dst; int pitch, dcol, rope = 0; const float* ng = nullptr; float sc = 1.f; bool split = false;
        if (g < 6)       { dst = Q; pitch = 1280; dcol = 64 * g; ng = gq; rope = 1; sc = c2a; }
        else if (g < 8)  { dst = K; pitch = 512; dcol = 64 * (g - 6); ng = gk; rope = 1; }
        else if (g < 10) { dst = V; pitch = 512; dcol = 64 * (g - 8); }
        else if (g < 14) { dst = Q; pitch = 1280; dcol = 64 * (6 + 2 * (g - 10)); rope = 2; sc = c2b; split = true; }
        else if (g < 18) { dst = K; pitch = 512; dcol = 64 * (2 + g - 14); rope = 2; }
        else if (g < 22) { dst = V; pitch = 512; dcol = 64 * (2 + g - 18); }
        else if (g < 28) { dst = Q; pitch = 1280; dcol = 64 * (14 + g - 22); rope = 1; sc = c2a; }
        else if (g < 30) { dst = K; pitch = 512; dcol = 64 * (6 + g - 28); rope = 1; }
        else             { dst = V; pitch = 512; dcol = 64 * (6 + g - 30); }
        const int bt = u.pm >= 65 ? 1 : 0, tile_t0 = (u.pm - 65 * bt) * 256; const bool isctx = tile_t0 >= SEQ_;
        const bool rope2g = (g >= 10 && g < 18); float nmx[2] = {0.f, 0.f};
        if (isctx) rope = 0;
        f32x4 gv[2][2];
#pragma unroll
        for (int bj = 0; bj < 2; ++bj)
#pragma unroll
            for (int n = 0; n < 2; ++n) gv[bj][n] = ng ? *(const f32x4*)(ng + 32 * bj + 16 * n + 4 * fq) : (f32x4){1.f, 1.f, 1.f, 1.f};
#pragma unroll
        for (int ai = 0; ai < 2; ++ai) { if (u.half == 2 - ai) continue;
#pragma unroll
            for (int m = 0; m < 4; ++m) {
                const int rl = ai * HALF + wr * 64 + m * 16 + fr; const int t = tile_t0 + rl; const size_t row = (size_t)u.pm * BM + rl;
                const int trow = (t >> 6) & 255, tcol = t & 63;
                f32x4 v[2][2];
#pragma unroll
                for (int bj = 0; bj < 2; ++bj)
#pragma unroll
                    for (int n = 0; n < 2; ++n) v[bj][n] = acc[ai][bj][m][n];
                if (ng) {
                    float ss = 0.f;
#pragma unroll
                    for (int bj = 0; bj < 2; ++bj)
#pragma unroll
                        for (int n = 0; n < 2; ++n) { const f32x4 x = v[bj][n]; ss += (x[0] * x[0] + x[1] * x[1]) + (x[2] * x[2] + x[3] * x[3]); }
                    ss += __builtin_bit_cast(float, __builtin_amdgcn_ds_bpermute(bp16, __builtin_bit_cast(int, ss))); ss += __builtin_bit_cast(float, __builtin_amdgcn_ds_bpermute(bp32, __builtin_bit_cast(int, ss)));
                    const float rn = 1.0f / sqrtf(ss * (1.0f / 64.0f) + 1e-6f);
#pragma unroll
                    for (int bj = 0; bj < 2; ++bj)
#pragma unroll
                        for (int n = 0; n < 2; ++n) v[bj][n] = v[bj][n] * rn * gv[bj][n];
                }
                if (rope == 1) {
#pragma unroll
                    for (int bj = 0; bj < 2; ++bj) { const int pos = bj ? tcol : trow;
                        const f32x4 c = *(const f32x4*)(cosA + pos * 16 + 4 * fq), s = *(const f32x4*)(sinA + pos * 16 + 4 * fq);
                        const f32x4 x1 = v[bj][0], x2 = v[bj][1]; v[bj][0] = x1 * c - x2 * s; v[bj][1] = x1 * s + x2 * c; }
                } else if (rope == 2) {
#pragma unroll
                    for (int n = 0; n < 2; ++n) { const int pos = n ? tcol : trow;
                        const f32x4 c = *(const f32x4*)(cosB + pos * 8 + 4 * (fq & 1)); f32x4 s = *(const f32x4*)(sinB + pos * 8 + 4 * (fq & 1));
                        if (fq < 2) s = -s;
#pragma unroll
                        for (int bj = 0; bj < 2; ++bj) { const f32x4 x = v[bj][n]; f32x4 p;
#pragma unroll
                            for (int e = 0; e < 4; ++e) { const float xe = x[e]; p[e] = __int_as_float(__builtin_amdgcn_ds_bpermute(bp32, __float_as_int(xe))); }
                            v[bj][n] = x * c + p * s; } }
                }
                if (rope2g) {
#pragma unroll
                    for (int bj = 0; bj < 2; ++bj) { const f32x4 x0 = v[bj][0] * sc, x1 = v[bj][1] * sc; float s2 = ((x0[0] * x0[0] + x0[1] * x0[1]) + (x0[2] * x0[2] + x0[3] * x0[3])) + ((x1[0] * x1[0] + x1[1] * x1[1]) + (x1[2] * x1[2] + x1[3] * x1[3]));
                        s2 += __int_as_float(__builtin_amdgcn_ds_bpermute(bp16, __float_as_int(s2))); s2 += __int_as_float(__builtin_amdgcn_ds_bpermute(bp32, __float_as_int(s2))); nmx[bj] = fmaxf(nmx[bj], s2); } }
                bf16_t* rp = dst + row * pitch + dcol + 4 * fq;
                if (!split) {
#pragma unroll
                    for (int bj = 0; bj < 2; ++bj)
#pragma unroll
                        for (int n = 0; n < 2; ++n) { const f32x4 x = v[bj][n] * sc; u32x2 w; w.x = pk_bf16(x[0], x[1]); w.y = pk_bf16(x[2], x[3]); *(u32x2*)(rp + 32 * bj + 16 * n) = w; }
                } else {
#pragma unroll
                    for (int n = 0; n < 2; ++n) { const f32x4 x = v[0][n] * sc, y = v[1][n] * sc; u32x2 w, z; w.x = pk_bf16(x[0], x[1]); w.y = pk_bf16(x[2], x[3]); z.x = 0u; z.y = 0u;
                        *(u32x2*)(rp + 16 * n) = w; *(u32x2*)(rp + 32 + 16 * n) = z; *(u32x2*)(rp + 64 + 16 * n) = z;
                        w.x = pk_bf16(y[0], y[1]); w.y = pk_bf16(y[2], y[3]); *(u32x2*)(rp + 96 + 16 * n) = w; }
                }
            }
        }
        if (rope2g) {
#pragma unroll
            for (int bj = 0; bj < 2; ++bj) { float m2 = nmx[bj];
#pragma unroll
                for (int o_ = 1; o_ < 16; o_ <<= 1) m2 = fmaxf(m2, __int_as_float(__builtin_amdgcn_ds_bpermute((lnq ^ o_) << 2, __float_as_int(m2))));
                const int hb = g < 14 ? g - 10 : g - 14, isk = g < 14 ? 0 : 1;
                if (lnq == 0) __hip_atomic_fetch_max(nmax + (((bt * 4 + hb) * 2 + bj) * 2 + isk), __float_as_uint(m2), __ATOMIC_RELAXED, __HIP_MEMORY_SCOPE_AGENT); } }
    }
};
struct EpiRes {
    static constexpr bool PERM = false, AFTER_DRAIN = false;
    float* X; const float* modl; int gidx; const float* xin; const float* cin;
    __device__ __forceinline__ void operator()(const f32x4 (&acc)[2][2][4][2], const Unit& u, int wr, int wc, int fr, int fq) const {
        asm volatile("" : "+v"(fr), "+v"(fq));
        const int bt = u.pm >= 65 ? 1 : 0, r = (u.pm - 65 * bt) == 64 ? 2 : bt;
        const float* rbase = X + (size_t)u.pm * BM * 1024;
        if (xin) rbase = (r == 2) ? cin + (size_t)bt * 256 * 1024 : xin + ((size_t)bt * SEQ_ + (size_t)(u.pm - 65 * bt) * 256) * 1024;
        const int col0 = u.pn * BM + wc * 32 + 4 * fq; const float* gate = modl + r * 6144 + gidx * 1024 + col0;
        f32x4 gv[2][2];
#pragma unroll
        for (int bj = 0; bj < 2; ++bj)
#pragma unroll
            for (int n = 0; n < 2; ++n) gv[bj][n] = *(const f32x4*)(gate + bj * HALF + n * 16);
#pragma unroll
        for (int ai = 0; ai < 2; ++ai)
#pragma unroll
            for (int m = 0; m < 4; ++m) { if (u.half == 2 - ai) continue; const int rl = ai * HALF + wr * 64 + m * 16 + fr; float* rp = X + ((size_t)u.pm * BM + rl) * 1024 + col0; const float* rq = rbase + (size_t)rl * 1024 + col0;
#pragma unroll
                for (int bj = 0; bj < 2; ++bj)
#pragma unroll
                    for (int n = 0; n < 2; ++n) { f32x4* p = (f32x4*)(rp + bj * HALF + n * 16); *p = *(const f32x4*)(rq + bj * HALF + n * 16) + gv[bj][n] * acc[ai][bj][m][n]; }
                if (m & 1) asm volatile("" ::: "memory"); }
    }
};
struct EpiSwiGLU {
    static constexpr bool PERM = true, AFTER_DRAIN = false;
    bf16_t* U;
    __device__ __forceinline__ void operator()(const f32x4 (&acc)[2][2][4][2], const Unit& u, int wr, int wc, int fr, int fq) const {
        asm volatile("" : "+v"(fr), "+v"(fq));
        const int col0 = u.pn * HALF + wc * 32 + 8 * fq;
#pragma unroll
        for (int ai = 0; ai < 2; ++ai)
#pragma unroll
            for (int m = 0; m < 4; ++m) { if (u.half == 2 - ai) continue; bf16_t* rp = U + ((size_t)u.pm * BM + ai * HALF + wr * 64 + m * 16 + fr) * 2816 + col0;
                float o[8];
#pragma unroll
                for (int n = 0; n < 2; ++n)
#pragma unroll
                    for (int j = 0; j < 4; ++j) { const float a = acc[ai][0][m][n][j], b = acc[ai][1][m][n][j];
                        o[4 * n + j] = a * __builtin_amdgcn_rcpf(1.0f + __builtin_amdgcn_exp2f(-1.4426950408889634f * a)) * b; }
                u32x4 w; w.x = pk_bf16(o[0], o[1]); w.y = pk_bf16(o[2], o[3]); w.z = pk_bf16(o[4], o[5]); w.w = pk_bf16(o[6], o[7]);
                *(u32x4*)rp = w; }
    }
};

template <class Epi, class Sched, bool ALIGN_EPI = false, bool SP2 = false>
__device__ __forceinline__ void gemm_phase(PG8_LAS unsigned char* lds, const Gemm g, const Sched& S, const Epi& E) {
    int tid_ = threadIdx.x; asm volatile("" : "+v"(tid_));
    const int tid = tid_, wid = __builtin_amdgcn_readfirstlane(tid >> 6), lane = tid & 63, wr = wid >> 2, wc = wid & 3, fr = lane & 15, fq = lane >> 4;
    const int K = g.K, nt = K / BK;
    unsigned voffA[2], voffB[2];
#pragma unroll
    for (int i = 0; i < 2; ++i) { int R, C; stage_rc(tid * 16 + i * 8192, R, C); const int Rb = Epi::PERM ? ((R & ~31) + perm32(R & 31)) : R;
        voffA[i] = (unsigned)(R * K + C) * 2u; voffB[i] = (unsigned)(Rb * K + C) * 2u; }
    const size_t kstep = (size_t)(BK * 2);
    const size_t hstep = (size_t)HALF * K * 2;
    const size_t tstep = 2 * hstep;
    const unsigned ldsw = (unsigned)wid * 1024u;
    const int aoff = lds_byte(wr * 64 + fr, fq * 8), boff = lds_byte(wc * 32 + fr, fq * 8);
#define PG8_SA(b, h) (((b) * 2 + (h)) * HTB)
#define PG8_SB(b, h) ((4 + (b) * 2 + (h)) * HTB)
#define PG8_STAGE(bufoff, gbase, voff) do { _Pragma("unroll") for (int _i = 0; _i < 2; ++_i) \
        __builtin_amdgcn_global_load_lds((const unsigned*)((const char*)(gbase) + (voff)[_i]), (PG8_LAS unsigned*)(lds + (bufoff) + ldsw + _i * 8192), 16, 0, 0); } while (0)
#define PG8_LDA(dst, b, h) do { _Pragma("unroll") for (int m = 0; m < 4; ++m) _Pragma("unroll") for (int k = 0; k < 2; ++k) dst[m][k] = *(const PG8_LAS bf16x8*)(lds + PG8_SA(b, h) + aoff + m * 2048 + k * 1024); } while (0)
#define PG8_LDB(dst, b, h) do { _Pragma("unroll") for (int n = 0; n < 2; ++n) _Pragma("unroll") for (int k = 0; k < 2; ++k) dst[n][k] = *(const PG8_LAS bf16x8*)(lds + PG8_SB(b, h) + boff + n * 2048 + k * 1024); } while (0)
#define PG8_MMA(ai, bj, At, Bt) do { __builtin_amdgcn_s_setprio(1); _Pragma("unroll") for (int m = 0; m < 4; ++m) _Pragma("unroll") for (int n = 0; n < 2; ++n) _Pragma("unroll") for (int k = 0; k < 2; ++k) \
        acc[ai][bj][m][n] = __builtin_amdgcn_mfma_f32_16x16x32_bf16(Bt[n][k], At[m][k], acc[ai][bj][m][n], 0, 0, 0); __builtin_amdgcn_s_setprio(0); } while (0)
#define PG8_WAIT_V(n) asm volatile("s_waitcnt vmcnt(" #n ")" ::: "memory")
#define PG8_WAIT_L(n) asm volatile("s_waitcnt lgkmcnt(" #n ")" ::: "memory")
#define PG8_BAR __builtin_amdgcn_s_barrier()
#define PG8_SCHED __builtin_amdgcn_sched_barrier(0)
    Unit cur, nxt; int ui = 0;
    if (!S.next(0, cur)) return;
    f32x4 acc[2][2][4][2];
#pragma unroll
    for (int a = 0; a < 2; ++a)
#pragma unroll
        for (int b = 0; b < 2; ++b)
#pragma unroll
            for (int m = 0; m < 4; ++m)
#pragma unroll
                for (int n = 0; n < 2; ++n) acc[a][b][m][n] = (f32x4){0.f, 0.f, 0.f, 0.f};
    bf16x8 At[4][2], B0[2][2], B1[2][2];
    const char* cA = (const char*)g.A + (size_t)cur.pm * tstep; const char* cB = (const char*)g.Bt + (size_t)cur.pn * tstep;
    S.a_ready(cur);
    if constexpr (SP2) {
        PG8_STAGE(PG8_SB(0, 0), cB, voffB); PG8_STAGE(PG8_SB(0, 1), cB + hstep, voffB); PG8_STAGE(PG8_SA(0, 0), cA, voffA); PG8_STAGE(PG8_SA(0, 1), cA + hstep, voffA);
        if (wr == 1) PG8_BAR;
        PG8_WAIT_V(2); PG8_BAR;
        PG8_STAGE(PG8_SB(1, 0), cB + kstep, voffB); PG8_STAGE(PG8_SA(1, 0), cA + kstep, voffA); PG8_STAGE(PG8_SB(1, 1), cB + hstep + kstep, voffB);
        PG8_WAIT_V(6); PG8_BAR;
    } else {
        PG8_STAGE(PG8_SB(0, 0), cB, voffB); PG8_STAGE(PG8_SA(0, 0), cA, voffA); PG8_STAGE(PG8_SB(0, 1), cB + hstep, voffB); PG8_STAGE(PG8_SA(0, 1), cA + hstep, voffA);
        if (wr == 1) PG8_BAR;
        PG8_WAIT_V(4); PG8_BAR;
        PG8_STAGE(PG8_SB(1, 0), cB + kstep, voffB); PG8_STAGE(PG8_SA(1, 0), cA + kstep, voffA); PG8_STAGE(PG8_SB(1, 1), cB + hstep + kstep, voffB);
        PG8_WAIT_V(6); PG8_BAR;
    }
    for (;;) {
        const int hm = cur.half;
        const bool has_next = S.next(ui + 1, nxt);
        const char* nA = has_next ? (const char*)g.A + (size_t)nxt.pm * tstep : cA; const char* nB = has_next ? (const char*)g.Bt + (size_t)nxt.pn * tstep : cB;
        for (int t = 0; t < nt; t += 2) {
            const bool last = (t == nt - 2);
            const char* a1 = cA + (size_t)(t + 1) * kstep;
            const char* a2 = last ? nA : cA + (size_t)(t + 2) * kstep; const char* b2 = last ? nB : cB + (size_t)(t + 2) * kstep;
            const char* a3 = a2 + kstep; const char* b3 = b2 + kstep;
            if (last && has_next) S.a_ready(nxt);
            if constexpr (SP2) {
            PG8_LDB(B0, 0, 0); PG8_LDB(B1, 0, 1); PG8_SCHED; PG8_LDA(At, 0, 0); PG8_STAGE(PG8_SA(1, 1), a1 + hstep, voffA);
            PG8_WAIT_V(8); PG8_WAIT_L(0); PG8_BAR; if (hm != 2) { PG8_MMA(0, 0, At, B0); PG8_MMA(0, 1, At, B1); } PG8_BAR; PG8_SCHED;
            PG8_LDA(At, 0, 1); PG8_STAGE(PG8_SB(0, 0), b2, voffB); PG8_STAGE(PG8_SB(0, 1), b2 + hstep, voffB); PG8_STAGE(PG8_SA(0, 0), a2, voffA);
            PG8_WAIT_V(8); PG8_WAIT_L(0); PG8_BAR; if (hm != 1) { PG8_MMA(1, 0, At, B0); PG8_MMA(1, 1, At, B1); } PG8_BAR; PG8_SCHED;
            PG8_LDB(B0, 1, 0); PG8_LDB(B1, 1, 1); PG8_SCHED; PG8_LDA(At, 1, 0); PG8_STAGE(PG8_SA(0, 1), a2 + hstep, voffA);
            PG8_WAIT_V(8); PG8_WAIT_L(0); PG8_BAR; if (hm != 2) { PG8_MMA(0, 0, At, B0); PG8_MMA(0, 1, At, B1); } PG8_BAR; PG8_SCHED;
            PG8_LDA(At, 1, 1); PG8_STAGE(PG8_SB(1, 0), b3, voffB); PG8_STAGE(PG8_SB(1, 1), b3 + hstep, voffB); PG8_STAGE(PG8_SA(1, 0), a3, voffA);
            PG8_WAIT_V(8); PG8_WAIT_L(0); PG8_BAR; if (hm != 1) { PG8_MMA(1, 0, At, B0); PG8_MMA(1, 1, At, B1); } PG8_BAR; PG8_SCHED;
            } else {
            PG8_LDB(B0, 0, 0); PG8_SCHED; PG8_LDA(At, 0, 0); PG8_STAGE(PG8_SA(1, 1), a1 + hstep, voffA);
            PG8_WAIT_L(8); PG8_BAR; PG8_WAIT_L(0); PG8_MMA(0, 0, At, B0); PG8_BAR; PG8_SCHED;
            PG8_LDB(B1, 0, 1); PG8_STAGE(PG8_SB(0, 0), b2, voffB);
            PG8_BAR; PG8_WAIT_L(0); PG8_MMA(0, 1, At, B1); PG8_BAR;
            PG8_LDA(At, 0, 1); PG8_STAGE(PG8_SA(0, 0), a2, voffA);
            PG8_BAR; PG8_WAIT_L(0); PG8_MMA(1, 0, At, B0); PG8_BAR; PG8_SCHED;
            PG8_STAGE(PG8_SB(0, 1), b2 + hstep, voffB);
            PG8_WAIT_V(6); PG8_BAR; PG8_MMA(1, 1, At, B1); PG8_BAR;
            PG8_LDB(B0, 1, 0); PG8_SCHED; PG8_LDA(At, 1, 0); PG8_STAGE(PG8_SA(0, 1), a2 + hstep, voffA);
            PG8_WAIT_L(8); PG8_BAR; PG8_WAIT_L(0); PG8_MMA(0, 0, At, B0); PG8_BAR; PG8_SCHED;
            PG8_LDB(B1, 1, 1); PG8_STAGE(PG8_SB(1, 0), b3, voffB);
            PG8_BAR; PG8_WAIT_L(0); PG8_MMA(0, 1, At, B1); PG8_BAR;
            PG8_LDA(At, 1, 1); PG8_STAGE(PG8_SA(1, 0), a3, voffA);
            PG8_BAR; PG8_WAIT_L(0); PG8_MMA(1, 0, At, B0); PG8_BAR; PG8_SCHED;
            PG8_STAGE(PG8_SB(1, 1), b3 + hstep, voffB);
            PG8_WAIT_V(6); PG8_BAR; PG8_MMA(1, 1, At, B1); PG8_BAR;
            }
        }
        if constexpr (ALIGN_EPI) { if (wr == 0) PG8_BAR; }
        if constexpr (!Epi::AFTER_DRAIN) { E(acc, cur, wr, wc, fr, fq); S.done(cur); }
        if (!has_next) break;
#pragma unroll
        for (int a = 0; a < 2; ++a)
#pragma unroll
            for (int b = 0; b < 2; ++b)
#pragma unroll
                for (int m = 0; m < 4; ++m)
#pragma unroll
                    for (int n = 0; n < 2; ++n) acc[a][b][m][n] = (f32x4){0.f, 0.f, 0.f, 0.f};
        cur = nxt; cA = nA; cB = nB; ++ui;
        if constexpr (ALIGN_EPI) { if (wr == 1) PG8_BAR; }
    }
    PG8_WAIT_V(0);
    if constexpr (!ALIGN_EPI) { if (wr == 0) PG8_BAR; }
    PG8_BAR;
    if constexpr (Epi::AFTER_DRAIN) { E.fused(acc, cur, wr, wc, fr, fq, lds, wid, lane); S.done(cur); }
#undef PG8_SA
#undef PG8_SB
#undef PG8_STAGE
#undef PG8_LDA
#undef PG8_LDB
#undef PG8_MMA
#undef PG8_WAIT_V
#undef PG8_WAIT_L
#undef PG8_BAR
#undef PG8_SCHED
}
}

#ifndef PG8_SP2
#define PG8_SP2 true
#endif
#ifndef PG8_ALIGN
#define PG8_ALIGN true
#endif

namespace attn_body {
using bf16=__hip_bfloat16;
using bf16x8=__attribute__((ext_vector_type(8)))short;
using s16x4=__attribute__((ext_vector_type(4)))short;
using f32x16=__attribute__((ext_vector_type(16)))float;
using u32x4=__attribute__((ext_vector_type(4)))unsigned;
constexpr int D=64;
constexpr int NW=8,QBLK=32,QB=QBLK*NW,KVBLK=64;
typedef float f32x4v __attribute__((ext_vector_type(4))); typedef unsigned u32x2v __attribute__((ext_vector_type(2)));
__device__ __forceinline__ int crow(int r,int hi){return (r&3)+8*(r>>2)+4*hi;}
#define SBAR() __builtin_amdgcn_sched_barrier(0)
__device__ __forceinline__ void cmask(f32x16&p0,f32x16&p1,int jb,int qrel,int hi){
  const float NEG=-INFINITY; int kb=64*jb+4*hi;
  #pragma unroll
  for(int r=0;r<16;++r){int kv=kb+(r&3)+8*(r>>2); if(kv>qrel)p0[r]=NEG; if(kv+32>qrel)p1[r]=NEG;}
}

constexpr int NSLOT=3, SLOTB=8192;
constexpr int LDS_K=0, LDS_V=NSLOT*SLOTB, LDS_WS=2*NSLOT*SLOTB, LDS_OST=LDS_WS+NW*64*4, LDS_BYTES=LDS_OST+NW*8192;
constexpr float C2=0.125f*1.4426950408889634f;
__device__ __forceinline__ void glds16(const void*gsrc,unsigned lds_dst){unsigned keep;
  asm volatile("s_mov_b32 %0, m0\n\ts_mov_b32 m0, %2\n\ts_nop 0\n\tglobal_load_lds_dwordx4 %1, off\n\ts_mov_b32 m0, %0":"=&s"(keep):"v"(gsrc),"s"(lds_dst):"memory");}
__device__ __forceinline__ float max3f(float a,float b,float c){float r;asm("v_max3_f32 %0, %1, %2, %3":"=v"(r):"v"(a),"v"(b),"v"(c));return r;}
__device__ __forceinline__ float max2f(float a,float b){float r;asm("v_max_f32_e32 %0, %1, %2":"=v"(r):"v"(a),"v"(b));return r;}
__device__ __forceinline__ float fadd_s(float a,float b){float r;asm("v_add_f32_e32 %0, %1, %2":"=v"(r):"v"(a),"v"(b));return r;}
__device__ __forceinline__ float fsub_s(float a,float b){float r;asm("v_sub_f32_e32 %0, %1, %2":"=v"(r):"v"(a),"v"(b));return r;}
typedef float f32x2_t __attribute__((ext_vector_type(2))); typedef __bf16 bf16x2_t __attribute__((ext_vector_type(2)));
__device__ __forceinline__ unsigned cvtpk_s(float lo,float hi){f32x2_t v={lo,hi};bf16x2_t b=__builtin_convertvector(v,bf16x2_t);return __builtin_bit_cast(unsigned,b);}
#define WAIT_BAR(N) asm volatile("s_waitcnt vmcnt(" #N ") lgkmcnt(0)\n\ts_barrier":::"memory")

__device__ __forceinline__ void qkt(f32x16&p0,f32x16&p1,const char*Kslot,const bf16x8*qr,const f32x16&negm,int r32,int hi){
  const char*kb=Kslot+hi*1024+r32*16;
  #pragma unroll
  for(int d0=0;d0<4;++d0){
    const bf16x8 b0=*reinterpret_cast<const bf16x8*>(kb+d0*2048);
    const bf16x8 b1=*reinterpret_cast<const bf16x8*>(kb+d0*2048+512);
    if(d0==0){p0=__builtin_amdgcn_mfma_f32_32x32x16_bf16(b0,qr[0],negm,0,0,0);p1=__builtin_amdgcn_mfma_f32_32x32x16_bf16(b1,qr[0],negm,0,0,0);}
    else{p0=__builtin_amdgcn_mfma_f32_32x32x16_bf16(b0,qr[d0],p0,0,0,0);p1=__builtin_amdgcn_mfma_f32_32x32x16_bf16(b1,qr[d0],p1,0,0,0);}}
}
typedef __attribute__((address_space(3))) const char* lds_cptr;
typedef short v4i16_t __attribute__((ext_vector_type(4)));
__device__ __forceinline__ void kload8(bf16x8*kf,lds_cptr kp){
  kf[0]=*(const __attribute__((address_space(3))) bf16x8*)(kp);      kf[1]=*(const __attribute__((address_space(3))) bf16x8*)(kp+512);
  kf[2]=*(const __attribute__((address_space(3))) bf16x8*)(kp+2048); kf[3]=*(const __attribute__((address_space(3))) bf16x8*)(kp+2560);
  kf[4]=*(const __attribute__((address_space(3))) bf16x8*)(kp+4096); kf[5]=*(const __attribute__((address_space(3))) bf16x8*)(kp+4608);
  kf[6]=*(const __attribute__((address_space(3))) bf16x8*)(kp+6144); kf[7]=*(const __attribute__((address_space(3))) bf16x8*)(kp+6656);
}
__device__ __forceinline__ void kload4(bf16x8*kf,lds_cptr kp){
  kf[0]=*(const __attribute__((address_space(3))) bf16x8*)(kp);      kf[1]=*(const __attribute__((address_space(3))) bf16x8*)(kp+512);
  kf[2]=*(const __attribute__((address_space(3))) bf16x8*)(kp+2048); kf[3]=*(const __attribute__((address_space(3))) bf16x8*)(kp+2560);
}
__device__ __forceinline__ void qkt_h(f32x16&p0,f32x16&p1,const char*Kslot,const bf16x8*qr,const f32x16&negm,int r32,int hi){
  const char*kb=Kslot+hi*1024+r32*16;
  #pragma unroll
  for(int d0=0;d0<2;++d0){
    const bf16x8 b0=*reinterpret_cast<const bf16x8*>(kb+d0*2048);
    const bf16x8 b1=*reinterpret_cast<const bf16x8*>(kb+d0*2048+512);
    if(d0==0){p0=__builtin_amdgcn_mfma_f32_32x32x16_bf16(b0,qr[0],negm,0,0,0);p1=__builtin_amdgcn_mfma_f32_32x32x16_bf16(b1,qr[0],negm,0,0,0);}
    else{p0=__builtin_amdgcn_mfma_f32_32x32x16_bf16(b0,qr[d0],p0,0,0,0);p1=__builtin_amdgcn_mfma_f32_32x32x16_bf16(b1,qr[d0],p1,0,0,0);}}
}
__device__ __forceinline__ void kload2(bf16x8*kf,lds_cptr kp,int j){ kf[2*j]=*(const __attribute__((address_space(3))) bf16x8*)(kp+j*2048); kf[2*j+1]=*(const __attribute__((address_space(3))) bf16x8*)(kp+j*2048+512); }
__device__ __forceinline__ s16x4 vtr(lds_cptr p){ return __builtin_bit_cast(s16x4,__builtin_amdgcn_ds_read_tr16_b64_v4i16((__attribute__((address_space(3))) v4i16_t*)p)); }
__device__ __forceinline__ float rowmax(const f32x16&p0,const f32x16&p1){
  float a=max3f(p0[0],p0[1],p1[0]),b=max3f(p0[2],p0[3],p1[1]);a=max3f(a,p1[2],p1[3]);
  #pragma unroll
  for(int r=4;r<16;r+=4){a=max3f(a,p0[r],p0[r+1]);b=max3f(b,p0[r+2],p0[r+3]);a=max3f(a,p1[r],p1[r+1]);b=max3f(b,p1[r+2],p1[r+3]);}
  const float m=max2f(a,b);
  auto rr=__builtin_amdgcn_permlane32_swap(__float_as_uint(m),__float_as_uint(m),false,false);
  return max2f(__uint_as_float(rr[0]),__uint_as_float(rr[1]));
}
__device__ __forceinline__ void pv(f32x16*o,int vb,bf16x8 pa0,bf16x8 pa1,bf16x8 pa2,bf16x8 pa3){
  #pragma unroll
  for(int d0=0;d0<2;++d0){s16x4 lo[4],hi[4];
    #pragma unroll
    for(int ks=0;ks<4;++ks){
      asm volatile("ds_read_b64_tr_b16 %0,%1 offset:%c2":"=&v"(lo[ks]):"v"(vb),"i"(d0*4096+ks*1024):"memory");
      asm volatile("ds_read_b64_tr_b16 %0,%1 offset:%c2":"=&v"(hi[ks]):"v"(vb),"i"(d0*4096+ks*1024+512):"memory");}
    asm volatile("s_waitcnt lgkmcnt(0)":::"memory");SBAR();
    #define PK(k) (bf16x8){lo[k][0],lo[k][1],lo[k][2],lo[k][3],hi[k][0],hi[k][1],hi[k][2],hi[k][3]}
    o[d0]=__builtin_amdgcn_mfma_f32_32x32x16_bf16(pa0,PK(0),o[d0],0,0,0);
    o[d0]=__builtin_amdgcn_mfma_f32_32x32x16_bf16(pa1,PK(1),o[d0],0,0,0);
    o[d0]=__builtin_amdgcn_mfma_f32_32x32x16_bf16(pa2,PK(2),o[d0],0,0,0);
    o[d0]=__builtin_amdgcn_mfma_f32_32x32x16_bf16(pa3,PK(3),o[d0],0,0,0);
    #undef PK
  }
}

#ifndef ATTN_STORE16
#define ATTN_STORE16(p,v) (*(u32x4*)(p)=(v))
#endif

struct AttnParams {
  const bf16* Q;
  const bf16* K;
  const bf16* V;
  bf16* O;
  const float* gsub;
  int NT;
  int base_a, base_b;
  int mask;
  int dq0;
  int nomax; float mfix;
  int khalf;
  int mode;
  float sinkl2;
  float lam;
  float oscale;
};
constexpr int QP=1280, KP=512, OP=1024;
__device__ __forceinline__ void wmask(f32x16&p0,f32x16&p1,int dq,int hi){
  const float NEG=-INFINITY;
  #pragma unroll
  for(int r=0;r<16;++r){int d0=dq-((r&3)+8*(r>>2)+4*hi); if((unsigned)(d0+128)>256u)p0[r]=NEG; if((unsigned)(d0+96)>256u)p1[r]=NEG;}
}
template<int THRL,bool BH> __device__ __forceinline__ void attn_unit(const AttnParams&P,char*shm){
  int tid_=threadIdx.x; asm volatile("":"+v"(tid_));
  const int tid=tid_,lane=tid&63,r32=lane&31,hi=lane>>5; const int wid=__builtin_amdgcn_readfirstlane(tid>>6);
  const int NT=P.NT,base_a=P.base_a,base_b=P.base_b; const bool msk=P.mask!=0; const bool nomx=P.nomax!=0; const float mfix=P.mfix;
  if(wid>=4)__builtin_amdgcn_s_setprio(1);
  volatile unsigned*pblk=(volatile unsigned*)(shm+LDS_BYTES)+wid*8;
  if(lane==0){ const unsigned long long po=(unsigned long long)P.O,pg=(unsigned long long)P.gsub; pblk[0]=(unsigned)po;pblk[1]=(unsigned)(po>>32);pblk[2]=(unsigned)pg;pblk[3]=(unsigned)(pg>>32);
    pblk[4]=__float_as_uint(P.lam);pblk[5]=__float_as_uint(P.oscale);pblk[6]=__float_as_uint(P.sinkl2);pblk[7]=(unsigned)P.mode; }
  const bf16*Kh=P.K,*Vh=P.V;
  const unsigned lds0=(unsigned)(uintptr_t)shm;
  float*wsf=(float*)(shm+LDS_WS)+wid*64;
  const bf16*ksrc=Kh+(long)lane*KP+wid*8;
  const bf16*vsrc=Vh+(long)(16*(wid&3)+(lane>>2))*KP+(wid>>2)*32+(lane&3)*8;
  const unsigned kdst=lds0+LDS_K+wid*1024, vdst=lds0+LDS_V+wid*1024;
  #define TROW(t) (((t)<4)?(base_a+64*(t)):(base_b+64*((t)-4)))
  #define DMA_K(t,slot) glds16(ksrc+(long)TROW(t)*KP,(unsigned)__builtin_amdgcn_readfirstlane(kdst+(slot)))
  #define DMA_V(t,slot) glds16(vsrc+(long)TROW(t)*KP,(unsigned)__builtin_amdgcn_readfirstlane(vdst+(slot)))
  const int vb0=(int)(lds0+LDS_V)+((lane>>4)&1)*32+(lane&3)*8+(4*hi+((lane&15)>>2))*64;
  const char*Kbase=shm+LDS_K; bf16x8 kf[8];
  const lds_cptr shm3=(lds_cptr)shm; const lds_cptr kp0=shm3+LDS_K+hi*1024+r32*16; const lds_cptr vp0=shm3+LDS_V+((lane>>4)&1)*32+(lane&3)*8+(4*hi+((lane&15)>>2))*64;
  const bf16*Qw=P.Q+(long)(wid*QBLK)*QP; const int kbo=BH?P.khalf*4096:0, qoff=BH?P.khalf*32:0;
  DMA_K(0,0);DMA_V(0,0);DMA_K(1,SLOTB);
  bf16x8 qr[4];
  #pragma unroll
  for(int d0=0;d0<(BH?2:4);++d0)qr[d0]=*reinterpret_cast<const bf16x8*>(&Qw[(long)r32*QP+qoff+d0*16+hi*8]);
  float mhat=0.f,l_reg=0.f;f32x16 o[2];o[0]=f32x16{};o[1]=f32x16{};f32x16 negm=f32x16{};asm volatile("":"+v"(negm));
  const int dqb=P.dq0+wid*QBLK+r32;
  #define CMASK(P0,P1,t) do{ if(msk&&(t)>=4)wmask(P0,P1,dqb-64*((t)-4),hi); }while(0)
  bool resc=false;
  #define START(P0,P1) do{ float rm=mfix; if(!nomx)rm=rowmax(P0,P1); resc=false; \
    { const float dl=rm; mhat=fadd_s(mhat,dl); \
      _Pragma("unroll") for(int r=0;r<16;++r){P0[r]=fsub_s(P0[r],dl);P1[r]=fsub_s(P1[r],dl);} \
      _Pragma("unroll") for(int r=0;r<16;++r)negm[r]=-mhat; asm volatile("":"+v"(negm)); } \
    _Pragma("unroll") for(int r=0;r<16;++r)P0[r]=__builtin_amdgcn_exp2f(P0[r]); }while(0)
  #define RESC() do{ if(resc){ asm volatile("s_waitcnt lgkmcnt(0)":::"memory"); \
      _Pragma("unroll") for(int d_=0;d_<2;++d_) _Pragma("unroll") for(int r=0;r<16;++r)o[d_][r]*=wsf[crow(r,hi)]; } }while(0)
  f32x16 pA0,pA1,pB0,pB1;
  int sl_prev=0,sl_cur=0,sl_next=SLOTB;
  #define ROT() do{sl_prev=sl_cur;sl_cur=sl_next;sl_next=(sl_next==(NSLOT-1)*SLOTB)?0:sl_next+SLOTB;}while(0)
  DMA_K(2,2*SLOTB);
  WAIT_BAR(3);
  if(BH)qkt_h(pA0,pA1,Kbase+kbo,qr,negm,r32,hi); else qkt(pA0,pA1,Kbase,qr,negm,r32,hi);
  asm volatile("s_nop 15\n\ts_nop 7":"+v"(pA0),"+v"(pA1));CMASK(pA0,pA1,0);
  START(pA0,pA1);
  _Pragma("unroll") for(int r=0;r<16;++r)pA1[r]=__builtin_amdgcn_exp2f(pA1[r]);
  WAIT_BAR(0);
  DMA_K(3,0);DMA_V(1,SLOTB);
  ROT();
  if(BH)kload4(kf,kp0+sl_cur+kbo); else kload8(kf,kp0+sl_cur);
  WAIT_BAR(2);
  s16x4 vlo[8],vhi[8]; u32x4 pw0,pw1,pw2,pw3;
  #define PKW(P,B) cvtpk_s(P[B],P[B+1])
  #define PAF(k) __builtin_bit_cast(bf16x8,pw##k)
  #define VFR(i) (bf16x8){vlo[i][0],vlo[i][1],vlo[i][2],vlo[i][3],vhi[i][0],vhi[i][1],vhi[i][2],vhi[i][3]}
  #define PIN(x) asm volatile("":"+v"(x))
  #define MX3(a,b,c) __builtin_fmaxf(__builtin_fmaxf((a),(b)),(c))
  #define QKS(NRM,HLF) do{ if(BH){ HLF; } else { NRM; } }while(0)
  #define GAPA(MF,A0,A1,A2,A3,W0,W1,PW) do{ MF; sacc+=A0; sacc+=A1; sacc+=A2; sacc+=A3; PIN(sacc); W0; W1; PIN(PW); SBAR(); }while(0)
  #define EX(v) __builtin_amdgcn_exp2f(v)
  #define GAPB(MF,X,B) do{ MF; X[B]=EX(X[B]); X[B+1]=EX(X[B+1]); X[B+2]=EX(X[B+2]); X[B+3]=EX(X[B+3]); PIN(X); SBAR(); }while(0)
  #define VRD(i) do{ vlo[i]=vtr(vp_+(((i)>>2)*4096+((i)&3)*1024)); vhi[i]=vtr(vp_+(((i)>>2)*4096+((i)&3)*1024+512)); }while(0)
  #define KRD(G,j) do{ if(G){ if(!BH){ kload2(kf,kp0+sl_next,j); SBAR(); } else if((j)<2){ kload2(kf,kp0+sl_next+kbo,j); SBAR(); } } }while(0)
  #define STEP(C0,C1,P0,P1,t,GK,GV,GL) do{ SBAR(); \
    const lds_cptr vp_=vp0+sl_prev; \
    VRD(0); SBAR(); float sacc=(P0[0]+P0[1]); \
    GAPA(QKS(C0=__builtin_amdgcn_mfma_f32_32x32x16_bf16(kf[0],qr[0],negm,0,0,0), C0=__builtin_amdgcn_mfma_f32_32x32x16_bf16(kf[0],qr[0],negm,0,0,0)), P0[2],P0[3],P0[4],P0[5],     pw0[0]=PKW(P0,0), pw0[1]=PKW(P0,2), pw0); \
    VRD(4); SBAR(); GAPA(QKS(C1=__builtin_amdgcn_mfma_f32_32x32x16_bf16(kf[1],qr[0],negm,0,0,0), (void)0), P0[6],P0[7],P0[8],P0[9],     pw0[2]=PKW(P0,4), pw0[3]=PKW(P0,6), pw0); \
    VRD(1); SBAR(); GAPA(QKS(C0=__builtin_amdgcn_mfma_f32_32x32x16_bf16(kf[2],qr[1],C0,0,0,0), C1=__builtin_amdgcn_mfma_f32_32x32x16_bf16(kf[1],qr[0],negm,0,0,0)),   P0[10],P0[11],P0[12],P0[13], pw1[0]=PKW(P0,8), pw1[1]=PKW(P0,10), pw1); \
    VRD(5); SBAR(); GAPA(QKS(C1=__builtin_amdgcn_mfma_f32_32x32x16_bf16(kf[3],qr[1],C1,0,0,0), (void)0),   P0[14],P0[15],P1[0],P1[1],   pw1[2]=PKW(P0,12),pw1[3]=PKW(P0,14), pw1); \
    VRD(2); SBAR(); GAPA(QKS(C0=__builtin_amdgcn_mfma_f32_32x32x16_bf16(kf[4],qr[2],C0,0,0,0), C0=__builtin_amdgcn_mfma_f32_32x32x16_bf16(kf[2],qr[1],C0,0,0,0)),   P1[2],P1[3],P1[4],P1[5],     pw2[0]=PKW(P1,0), pw2[1]=PKW(P1,2), pw2); \
    VRD(6); SBAR(); GAPA(QKS(C1=__builtin_amdgcn_mfma_f32_32x32x16_bf16(kf[5],qr[2],C1,0,0,0), (void)0),   P1[6],P1[7],P1[8],P1[9],     pw2[2]=PKW(P1,4), pw2[3]=PKW(P1,6), pw2); \
    VRD(3); SBAR(); GAPA(QKS(C0=__builtin_amdgcn_mfma_f32_32x32x16_bf16(kf[6],qr[3],C0,0,0,0), C1=__builtin_amdgcn_mfma_f32_32x32x16_bf16(kf[3],qr[1],C1,0,0,0)),   P1[10],P1[11],P1[12],P1[13], pw3[0]=PKW(P1,8), pw3[1]=PKW(P1,10), pw3); \
    VRD(7); SBAR(); GAPA(QKS(C1=__builtin_amdgcn_mfma_f32_32x32x16_bf16(kf[7],qr[3],C1,0,0,0), (void)0),   P1[14],P1[15],0.f,0.f,       pw3[2]=PKW(P1,12),pw3[3]=PKW(P1,14), pw3); \
    l_reg+=sacc; \
    if(GK){DMA_K((t)+3,sl_cur);} if(GV){DMA_V((t)+1,sl_next);} \
    CMASK(C0,C1,t); \
    resc=false; \
    if(!nomx){ float a=MX3(C0[0],C0[1],C1[0]),b=MX3(C0[2],C0[3],C1[1]); a=MX3(a,C1[2],C1[3]); \
      _Pragma("unroll") for(int r=4;r<16;r+=4){a=MX3(a,C0[r],C0[r+1]);b=MX3(b,C0[r+2],C0[r+3]);a=MX3(a,C1[r],C1[r+1]);b=MX3(b,C1[r+2],C1[r+3]);} \
      float rm=__builtin_fmaxf(a,b); { auto rr=__builtin_amdgcn_permlane32_swap(__float_as_uint(rm),__float_as_uint(rm),false,false); rm=__builtin_fmaxf(__uint_as_float(rr[0]),__uint_as_float(rr[1])); } \
      resc=false; \
      if(__builtin_expect(__any(rm>(float)THRL),0)){ const float dl=__builtin_fmaxf(rm,0.f); mhat+=dl; \
        _Pragma("unroll") for(int r=0;r<16;++r){C0[r]-=dl;C1[r]-=dl;} \
        _Pragma("unroll") for(int r=0;r<16;++r)negm[r]=-mhat; asm volatile("":"+v"(negm)); \
        const float f=__builtin_amdgcn_exp2f(-dl); l_reg*=f; if(hi==0)wsf[r32]=f; resc=true; } } \
    SBAR(); \
    GAPB(o[0]=__builtin_amdgcn_mfma_f32_32x32x16_bf16(PAF(0),VFR(0),o[0],0,0,0), C0,0); \
    GAPB(o[1]=__builtin_amdgcn_mfma_f32_32x32x16_bf16(PAF(0),VFR(4),o[1],0,0,0), C0,4); \
    KRD(GL,0); GAPB(o[0]=__builtin_amdgcn_mfma_f32_32x32x16_bf16(PAF(1),VFR(1),o[0],0,0,0), C0,8); \
    KRD(GL,1); GAPB(o[1]=__builtin_amdgcn_mfma_f32_32x32x16_bf16(PAF(1),VFR(5),o[1],0,0,0), C0,12); \
    KRD(GL,2); GAPB(o[0]=__builtin_amdgcn_mfma_f32_32x32x16_bf16(PAF(2),VFR(2),o[0],0,0,0), C1,0); \
    KRD(GL,3); GAPB(o[1]=__builtin_amdgcn_mfma_f32_32x32x16_bf16(PAF(2),VFR(6),o[1],0,0,0), C1,4); \
    GAPB(o[0]=__builtin_amdgcn_mfma_f32_32x32x16_bf16(PAF(3),VFR(3),o[0],0,0,0), C1,8); \
    GAPB(o[1]=__builtin_amdgcn_mfma_f32_32x32x16_bf16(PAF(3),VFR(7),o[1],0,0,0), C1,12); \
    }while(0)
  int t=1;
  #undef CMASK
  #define CMASK(P0,P1,t) do{}while(0)
  for(;!msk&&t+5<NT;t+=2){
    STEP(pB0,pB1,pA0,pA1,t,true,true,true);     WAIT_BAR(2); RESC(); ROT();
    STEP(pA0,pA1,pB0,pB1,t+1,true,true,true);   WAIT_BAR(2); RESC(); ROT();
  }
  #undef CMASK
  #define CMASK(P0,P1,t) do{ if(msk&&(t)>=4)wmask(P0,P1,dqb-64*((t)-4),hi); }while(0)
  #define ENDW(tt) do{ if((tt)+3<NT){WAIT_BAR(2);} else if((tt)+2<NT){WAIT_BAR(1);} else {WAIT_BAR(0);} }while(0)
  for(;t+1<NT;t+=2){
    STEP(pB0,pB1,pA0,pA1,t,(t+3<NT),(t+1<NT),(t+1<NT));       ENDW(t);   RESC(); ROT();
    STEP(pA0,pA1,pB0,pB1,t+1,(t+4<NT),(t+2<NT),(t+2<NT));     ENDW(t+1); RESC(); ROT();
  }
  STEP(pB0,pB1,pA0,pA1,NT-1,false,false,false); RESC();
  { float sacc=pB0[0]+pB0[1]; _Pragma("unroll") for(int r=2;r<16;++r)sacc+=pB0[r]; _Pragma("unroll") for(int r=0;r<16;++r)sacc+=pB1[r]; l_reg+=sacc;
    pw0=(u32x4){PKW(pB0,0),PKW(pB0,2),PKW(pB0,4),PKW(pB0,6)};pw1=(u32x4){PKW(pB0,8),PKW(pB0,10),PKW(pB0,12),PKW(pB0,14)};pw2=(u32x4){PKW(pB1,0),PKW(pB1,2),PKW(pB1,4),PKW(pB1,6)};pw3=(u32x4){PKW(pB1,8),PKW(pB1,10),PKW(pB1,12),PKW(pB1,14)};
    SBAR(); pv(o,vb0+sl_cur,PAF(0),PAF(1),PAF(2),PAF(3)); }
  #undef PKW
  #undef PAF
  #undef VFR
  #undef PIN
  #undef MX3
  #undef GAPA
  #undef QKS
  #undef GAPB
  #undef EX
  #undef VRD
  #undef KRD
  #undef STEP
  #undef ENDW
  {auto rr=__builtin_amdgcn_permlane32_swap(__float_as_uint(l_reg),__float_as_uint(l_reg),false,false);l_reg=__uint_as_float(rr[0])+__uint_as_float(rr[1]);}
  asm volatile("s_waitcnt lgkmcnt(0)":::"memory");
  const unsigned e0=__builtin_amdgcn_readfirstlane(pblk[0]),e1=__builtin_amdgcn_readfirstlane(pblk[1]),e2=__builtin_amdgcn_readfirstlane(pblk[2]),e3=__builtin_amdgcn_readfirstlane(pblk[3]);
  const float e_lam=__uint_as_float(__builtin_amdgcn_readfirstlane(pblk[4])),e_osc=__uint_as_float(__builtin_amdgcn_readfirstlane(pblk[5])),e_sink=__uint_as_float(__builtin_amdgcn_readfirstlane(pblk[6]));
  const int e_mode=(int)__builtin_amdgcn_readfirstlane(pblk[7]);
  bf16*const e_O=(bf16*)(((unsigned long long)e1<<32)|e0); const float*const e_gsub=(const float*)(((unsigned long long)e3<<32)|e2);
  l_reg+=__builtin_amdgcn_exp2f(e_sink-mhat);
  if(hi==0)wsf[32+r32]=l_reg;asm volatile("s_waitcnt lgkmcnt(0)":::"memory");
  float rli[16];
  #pragma unroll
  for(int r=0;r<16;++r)rli[r]=__builtin_amdgcn_rcpf(wsf[32+crow(r,hi)]);
  bf16*Ow=e_O+(long)(wid*QBLK)*OP;
  if(e_mode==0){ bf16*stg=(bf16*)(shm+LDS_OST)+wid*4096;
    #pragma unroll
    for(int r=0;r<16;++r){const int orow=crow(r,hi);
      #pragma unroll
      for(int d0=0;d0<2;++d0)stg[orow*64+d0*32+r32]=__float2bfloat16(o[d0][r]*rli[r]);}
    asm volatile("s_waitcnt lgkmcnt(0)":::"memory");
    #pragma unroll
    for(int i=0;i<4;++i){const int row=i*8+(lane>>3),ch=lane&7; const u32x4 v=*(const u32x4*)(stg+row*64+ch*8); ATTN_STORE16(Ow+(long)row*OP+ch*8,v);} }
  else { float*stg=(float*)(shm+LDS_OST)+wid*2048;
    if(e_mode==1){
      #pragma unroll
      for(int r=0;r<16;++r){const int orow=crow(r,hi);
        #pragma unroll
        for(int d0=0;d0<2;++d0)stg[orow*64+d0*32+r32]=o[d0][r]*rli[r];}
      asm volatile("s_waitcnt lgkmcnt(0)":::"memory");
    } else {
      #pragma unroll
      for(int r=0;r<16;++r){const int orow=crow(r,hi);
        #pragma unroll
        for(int d0=0;d0<2;++d0){const int ix=orow*64+d0*32+r32; stg[ix]=stg[ix]-e_lam*(o[d0][r]*rli[r]);}}
      asm volatile("s_waitcnt lgkmcnt(0)":::"memory");
      int ln=lane; asm volatile("":"+v"(ln));
      const int ch=ln&15; const f32x4v gs=*(const f32x4v*)(e_gsub+ch*4);
      const int bp1=(ln^1)<<2,bp2=(ln^2)<<2,bp4=(ln^4)<<2,bp8=(ln^8)<<2;
      #pragma unroll
      for(int i=0;i<8;++i){const int row=i*4+(ln>>4); const f32x4v v=*(const f32x4v*)(stg+row*64+ch*4);
        float ss=(v[0]*v[0]+v[1]*v[1])+(v[2]*v[2]+v[3]*v[3]);
        ss+=__builtin_bit_cast(float,__builtin_amdgcn_ds_bpermute(bp1,__builtin_bit_cast(int,ss)));ss+=__builtin_bit_cast(float,__builtin_amdgcn_ds_bpermute(bp2,__builtin_bit_cast(int,ss)));
        ss+=__builtin_bit_cast(float,__builtin_amdgcn_ds_bpermute(bp4,__builtin_bit_cast(int,ss)));ss+=__builtin_bit_cast(float,__builtin_amdgcn_ds_bpermute(bp8,__builtin_bit_cast(int,ss)));
        const float rn=e_osc*__builtin_amdgcn_rsqf(ss*(1.0f/64.0f)+1e-6f);
        u32x2v w; w[0]=cvtpk_s(v[0]*rn*gs[0],v[1]*rn*gs[1]); w[1]=cvtpk_s(v[2]*rn*gs[2],v[3]*rn*gs[3]);
        *(u32x2v*)(Ow+(long)row*OP+ch*4)=w;}
    }
  }
  __builtin_amdgcn_s_setprio(0);
  asm volatile("s_waitcnt lgkmcnt(0)\n\ts_barrier":::"memory");
  #undef TROW
  #undef DMA_K
  #undef DMA_V
  #undef CMASK
  #undef START
  #undef RESC
  #undef ROT
}

constexpr int ATTN_LDS_BYTES=LDS_BYTES;
#undef SBAR
#undef WAIT_BAR
}
namespace cg = cooperative_groups;
#define GAS __attribute__((address_space(1)))
#define LAS __attribute__((address_space(3)))
typedef unsigned short bf16;
typedef unsigned v4u __attribute__((ext_vector_type(4)));
typedef unsigned v2u __attribute__((ext_vector_type(2)));
typedef float f32x4 __attribute__((ext_vector_type(4)));
constexpr int NWAVES = 8;
constexpr int SEQ = 16384, CTXL = 256, TPB = SEQ + CTXL, NBATCH = 2, MROWS = NBATCH * TPB, D = 1024, NIN = 2048, FF = 2816, NUP = 2 * FF;
constexpr float LOG2E = 1.4426950408889634f;
constexpr float C2A = 0.125f * LOG2E, C2B = 0.17677669529663687f * LOG2E;
constexpr size_t MiB = 1u << 20;
constexpr size_t WS_MOD = 1 * MiB;
constexpr size_t WS_ROPE = WS_MOD + 512 * 1024;
constexpr size_t WS_WIN = 2 * MiB, WS_WOUT = 10 * MiB, WS_WUP = 14 * MiB, WS_WDN = 36 * MiB;
constexpr size_t WS_XRES = 48 * MiB;
constexpr size_t WS_XN = 178 * MiB;
constexpr size_t WS_Q = 244 * MiB, WS_K = 326 * MiB, WS_V = 359 * MiB, WS_O = 392 * MiB;
constexpr size_t WS_U = 244 * MiB;
constexpr size_t WS_END = 458 * MiB;
static_assert(WS_Q + (size_t)MROWS * 1280 * 2 <= WS_K && WS_K + (size_t)MROWS * 512 * 2 <= WS_V && WS_V + (size_t)MROWS * 512 * 2 <= WS_O && WS_O + (size_t)MROWS * 1024 * 2 <= WS_END, "ws map");
static_assert(WS_U + (size_t)MROWS * FF * 2 <= WS_END && WS_XN + (size_t)MROWS * D * 2 <= WS_Q && WS_XRES + (size_t)MROWS * D * 4 <= WS_XN, "ws map 2");
constexpr int LDS_BYTES = 147456;
#ifndef ABL_ZERO_C
#define ABL_ZERO_C 0
#endif

__device__ __forceinline__ unsigned f2bf(float f) { unsigned u = __builtin_bit_cast(unsigned, f); return (u + 0x7fffu + ((u >> 16) & 1u)) >> 16; }
__device__ __forceinline__ unsigned pk2(float lo, float hi) { return f2bf(lo) | (f2bf(hi) << 16); }
__device__ __forceinline__ float wave_sum_l(float v, int lane) {
#pragma unroll
    for (int o = 1; o < 64; o <<= 1) v += __int_as_float(__builtin_amdgcn_ds_bpermute((lane ^ o) << 2, __float_as_int(v)));
    return v;
}
__device__ __forceinline__ float wave_sum(float v) {
#pragma unroll
    for (int o = 1; o < 64; o <<= 1) v += __shfl_xor(v, o);
    return v;
}
__device__ __forceinline__ void tr_item(const float* W, int ldw, int k0, int ncol0, bf16* WT, int Kt, int prow0, LAS float* scr, int lane) {
#pragma unroll 8
    for (int i = 0; i < 32; ++i) { const int kk = 2 * i + (lane >> 5); scr[kk * 33 + (lane & 31)] = W[(size_t)(k0 + kk) * ldw + ncol0 + (lane & 31)]; }
    asm volatile("s_waitcnt lgkmcnt(0)" ::: "memory");
    const int c = lane & 7;
#pragma unroll
    for (int j = 0; j < 4; ++j) { const int n = (lane >> 3) + 8 * j; const LAS float* s = scr + (8 * c) * 33 + n;
        v4u o; o.x = pk2(s[0 * 33], s[1 * 33]); o.y = pk2(s[2 * 33], s[3 * 33]); o.z = pk2(s[4 * 33], s[5 * 33]); o.w = pk2(s[6 * 33], s[7 * 33]);
        *(v4u*)(WT + (size_t)(prow0 + n) * Kt + k0 + 8 * c) = o; }
    asm volatile("s_waitcnt lgkmcnt(0)" ::: "memory");
}


template <int KIND> __device__ __forceinline__ void norm_rows(int gw, int NGW, int lane, const float* xin, const float* cin, float* xres, bf16* xn, float* outp, const float* gvec, const float* modr, int sidx) {
    const int nrows = KIND == 2 ? NBATCH * SEQ : MROWS;
    for (int m0 = gw; m0 < nrows; m0 += 2 * NGW) {
        int mm[2]; mm[0] = m0; mm[1] = (m0 + NGW < nrows) ? m0 + NGW : m0;
        f32x4 v[2][4]; float ss[2]; int rr[2]; size_t xrow[2];
#pragma unroll
        for (int u = 0; u < 2; ++u) {
            const int m = mm[u];
            const float* src;
            if (KIND == 2) { const int b = m >= SEQ ? 1 : 0, t = m - b * SEQ; xrow[u] = (size_t)b * TPB + t; rr[u] = b; src = xres + xrow[u] * D; }
            else { const int b = m >= TPB ? 1 : 0, t = m - b * TPB; rr[u] = t >= SEQ ? 2 : b; xrow[u] = (size_t)m;
                   src = KIND == 0 ? (t < SEQ ? xin + ((size_t)b * SEQ + t) * D : cin + ((size_t)b * CTXL + (t - SEQ)) * D) : xres + (size_t)m * D; }
            const f32x4* xr = (const f32x4*)src + lane; float s = 0.f;
#pragma unroll
            for (int j = 0; j < 4; ++j) { v[u][j] = xr[64 * j]; s += (v[u][j][0] * v[u][j][0] + v[u][j][1] * v[u][j][1]) + (v[u][j][2] * v[u][j][2] + v[u][j][3] * v[u][j][3]); }
            ss[u] = s;
        }
#pragma unroll
        for (int u = 0; u < 2; ++u) {
            const float rn = 1.0f / sqrtf(wave_sum_l(ss[u], lane) * (1.0f / D) + 1e-6f);
            if (KIND == 2) { f32x4* o = (f32x4*)(outp + (size_t)mm[u] * D) + lane;
#pragma unroll
                for (int j = 0; j < 4; ++j) { const int col = 4 * (lane + 64 * j); const f32x4 g4 = *(const f32x4*)(gvec + col); o[64 * j] = v[u][j] * rn * g4; } }
            else { const float* sh = modr + rr[u] * 6144 + sidx * 1024; const float* sc = sh + 1024; v2u* o8 = (v2u*)(xn + xrow[u] * D) + lane;
#pragma unroll
                for (int j = 0; j < 4; ++j) { const int col = 4 * (lane + 64 * j); const f32x4 g4 = *(const f32x4*)(gvec + col), s4 = *(const f32x4*)(sh + col), c4 = *(const f32x4*)(sc + col);
                    const f32x4 y = (v[u][j] * rn * g4) * (c4 + 1.0f) + s4; v2u w; w.x = pg8::pk_bf16(y[0], y[1]); w.y = pg8::pk_bf16(y[2], y[3]); o8[64 * j] = w; } }
        }
    }
}

#ifndef SELFCHECK
#define SELFCHECK 0
#endif
__device__ __forceinline__ float bf2f(unsigned short x) { return __uint_as_float((unsigned)x << 16); }
__device__ __forceinline__ float wave_max(float v) {
#pragma unroll
    for (int o = 1; o < 64; o <<= 1) v = fmaxf(v, __shfl_xor(v, o));
    return v;
}
__device__ __forceinline__ float naive_row(const bf16* Qrow, const bf16* Kb, const bf16* Vb, int kind, int t, float sinkl2, int lane, LAS float* xch) {
    float q[64]; asm volatile("" : "+v"(Qrow));
#pragma unroll
    for (int c = 0; c < 8; ++c) { const v4u w = *(const v4u*)(Qrow + 8 * c);
#pragma unroll
        for (int e = 0; e < 4; ++e) { q[8 * c + 2 * e] = __uint_as_float(w[e] << 16); q[8 * c + 2 * e + 1] = __uint_as_float(w[e] & 0xffff0000u); } }
    int lo = 0, nb = 0, n;
    if (kind == 0) n = TPB; else if (kind == 1) n = CTXL; else { lo = t - 128 < 0 ? 0 : t - 128; const int hi = t + 128 > SEQ - 1 ? SEQ - 1 : t + 128; nb = hi - lo + 1; n = nb + CTXL; }
    float m = -INFINITY, l = 0.f, o[64];
#pragma unroll
    for (int d = 0; d < 64; ++d) o[d] = 0.f;
    for (int j = lane; j < n; j += 64) {
        const int row = kind == 0 ? j : (kind == 1 ? SEQ + j : (j < nb ? lo + j : SEQ + (j - nb)));
        float sc = 0.f;
#pragma unroll
        for (int c = 0; c < 8; ++c) { const v4u w = *(const v4u*)(Kb + (size_t)row * 512 + 8 * c);
#pragma unroll
            for (int e = 0; e < 4; ++e) { sc += q[8 * c + 2 * e] * __uint_as_float(w[e] << 16); sc += q[8 * c + 2 * e + 1] * __uint_as_float(w[e] & 0xffff0000u); } }
        if (sc > m) { const float f = __builtin_amdgcn_exp2f(m - sc); l *= f;
#pragma unroll
            for (int d = 0; d < 64; ++d) o[d] *= f;
            m = sc; }
        const float p = __builtin_amdgcn_exp2f(sc - m); l += p;
#pragma unroll
        for (int c = 0; c < 8; ++c) { const v4u w = *(const v4u*)(Vb + (size_t)row * 512 + 8 * c);
#pragma unroll
            for (int e = 0; e < 4; ++e) { o[8 * c + 2 * e] += p * __uint_as_float(w[e] << 16); o[8 * c + 2 * e + 1] += p * __uint_as_float(w[e] & 0xffff0000u); } }
    }
    const float M = wave_max(m); const float f = (m == -INFINITY) ? 0.f : __builtin_amdgcn_exp2f(m - M);
    float lt = wave_sum(l * f) + __builtin_amdgcn_exp2f(sinkl2 - M);
    const bool l0 = lane == 0;
#pragma unroll
    for (int d = 0; d < 64; ++d) { const float sd = wave_sum(o[d] * f); if (l0) xch[d] = sd; }
    asm volatile("s_waitcnt lgkmcnt(0)" ::: "memory"); const float od = xch[lane]; asm volatile("s_waitcnt lgkmcnt(0)" ::: "memory");
    return od / lt;
}

__device__ __forceinline__ void sincos_d(double a, float& sn, float& cs) {
    const double k = rint(a * 0.15915494309189535); const double r = a - k * 6.283185307179586476925;
    const double r2 = r * r; double ts = r, tc = 1.0, ss = r, cc = 1.0;
#pragma unroll 1
    for (int i = 1; i < 16; ++i) { tc = -tc * r2 / (double)((2 * i - 1) * (2 * i)); ts = -ts * r2 / (double)((2 * i) * (2 * i + 1)); cc += tc; ss += ts; }
    sn = (float)ss; cs = (float)cc;
}
#define XB_TMO      128
#define XB_XCNT(j)  (256  + 64 * (j))
#define XB_XSUB(j)  (1280 + 64 * (j))
#define XB_XGEN(j)  (2304 + 64 * (j))
#define XB_TOP      3328
#define XB_TOPGEN   3392
#define XCD_BAR_WORDS 3456
#define XB_SPIN_CAP (1u << 18)

__device__ __forceinline__ unsigned xb_ld(unsigned* p)              { return __hip_atomic_load(p, __ATOMIC_RELAXED, __HIP_MEMORY_SCOPE_AGENT); }
__device__ __forceinline__ unsigned xb_add(unsigned* p, unsigned v) { return __hip_atomic_fetch_add(p, v, __ATOMIC_RELAXED, __HIP_MEMORY_SCOPE_AGENT); }
__device__ __forceinline__ unsigned xb_xcc_id() { return (unsigned)__builtin_amdgcn_s_getreg((3 << 11) | 20) & 0xFu; }
#define XB_SPIN(cond, bar) do { unsigned _sp = 0; while (cond) { __builtin_amdgcn_s_sleep(1); \
    if ((++_sp & 255u) == 0u) { if (xb_ld(&(bar)[XB_TMO])) break; if (_sp > XB_SPIN_CAP) { atomicAdd(&(bar)[XB_TMO], 1u); break; } } } } while (0)

struct XcdBarrier {
    unsigned* bar; unsigned x;
    volatile LAS unsigned* st;
};

__device__ __forceinline__ XcdBarrier xcd_barrier_post(unsigned* bar, volatile LAS unsigned* st) {
    XcdBarrier b; b.bar = bar; b.x = xb_xcc_id(); b.st = st;
    if (threadIdx.x == 0) (void)xb_add(&bar[XB_XCNT(b.x)], 1u);
    return b;
}
__device__ __forceinline__ void xcd_barrier_complete(unsigned* bar, unsigned x, unsigned& nloc, unsigned& nx) {
    const unsigned G = gridDim.x * gridDim.y * gridDim.z;
    unsigned sum, cnt, mine, sp = 0u;
    for (;;) {
        sum = 0u; cnt = 0u; mine = 0u;
#pragma unroll
        for (unsigned j = 0; j < 16; ++j) { const unsigned c = xb_ld(&bar[XB_XCNT(j)]); sum += c; cnt += (c > 0u) ? 1u : 0u; mine = (j == x) ? c : mine; }
        if (sum == G) break;
        __builtin_amdgcn_s_sleep(1);
        if ((++sp & 255u) == 0u) { if (xb_ld(&bar[XB_TMO])) break; if (sp > XB_SPIN_CAP) { atomicAdd(&bar[XB_TMO], 1u); break; } }
    }
    nloc = mine > 0u ? mine : 1u; nx = cnt > 0u ? cnt : 1u;
}

__device__ __forceinline__ void xcd_barrier(const XcdBarrier& b) {
    asm volatile("s_waitcnt vmcnt(0)" ::: "memory");
    __syncthreads();
    if (threadIdx.x == 0) {
        unsigned* bar = b.bar;
        __builtin_amdgcn_s_waitcnt(0);
        unsigned nloc = b.st[0], nx = b.st[1];
        if (nloc == 0u) { xcd_barrier_complete(bar, b.x, nloc, nx); b.st[0] = nloc; b.st[1] = nx; }
        const unsigned old = xb_add(&bar[XB_XSUB(b.x)], 1u);
        const unsigned gen = old / nloc;
        if (old + 1u == (gen + 1u) * nloc) {
            __builtin_amdgcn_fence(__ATOMIC_RELEASE, "agent");
            asm volatile("s_waitcnt vmcnt(0)" ::: "memory");
            const unsigned og = xb_add(&bar[XB_TOP], 1u);
            const unsigned tg = og / nx;
            if (og + 1u == (tg + 1u) * nx) xb_add(&bar[XB_TOPGEN], 1u);
            else XB_SPIN(xb_ld(&bar[XB_TOPGEN]) == tg, bar);
            __builtin_amdgcn_fence(__ATOMIC_ACQUIRE, "agent");
            xb_add(&bar[XB_XGEN(b.x)], 1u);
            asm volatile("s_waitcnt vmcnt(0)" ::: "memory");
        } else {
            XB_SPIN(xb_ld(&bar[XB_XGEN(b.x)]) == gen, bar);
            __builtin_amdgcn_fence(__ATOMIC_ACQUIRE, "agent");
            asm volatile("s_waitcnt vmcnt(0)" ::: "memory");
        }
    }
    __syncthreads();
}
constexpr size_t WS_BAR = 65536;
constexpr int LDS_XB = LDS_BYTES - 64;
struct Args { const float* in[22]; float* out; unsigned char* ws; };
typedef const float* const __attribute__((address_space(4)))* kargp_t;
__device__ __forceinline__ const float* kin(int i) { kargp_t ka = (kargp_t)__builtin_amdgcn_kernarg_segment_ptr(); asm volatile("" : "+s"(ka)); return ka[i]; }
__device__ __forceinline__ unsigned char* kws() { return (unsigned char*)kin(23); }


#define x_in kin(0)
#define c_in kin(1)
#define ctx_in kin(2)
#define cctx_in kin(3)
#define w_ada kin(4)
#define b_ada kin(5)
#define g_attn kin(6)
#define g_ffn kin(7)
#define w_in kin(8)
#define g_q kin(9)
#define g_k kin(10)
#define lam_q1 kin(11)
#define lam_k1 kin(12)
#define lam_q2 kin(13)
#define lam_k2 kin(14)
#define g_subln kin(15)
#define sink_logit kin(16)
#define w_out kin(17)
#define w_ff1 kin(18)
#define w_ff3 kin(19)
#define w_ff2 kin(20)
#define g_final kin(21)
#define MOD ((float*)(kws() + WS_MOD))
#define NMAX ((unsigned*)(kws() + 8192))
#define cosA ((float*)(kws() + WS_ROPE))
#define sinA (cosA + 256 * 16)
#define cosB (cosA + 2 * 256 * 16)
#define sinB (cosA + 2 * 256 * 16 + 256 * 8)
#define WIN ((bf16*)(kws() + WS_WIN))
#define WOUT ((bf16*)(kws() + WS_WOUT))
#define WUP ((bf16*)(kws() + WS_WUP))
#define WDN ((bf16*)(kws() + WS_WDN))
#define XRES ((float*)(kws() + WS_XRES))
#define XN ((bf16*)(kws() + WS_XN))
#define bQ ((bf16*)(kws() + WS_Q))
#define bK ((bf16*)(kws() + WS_K))
#define bV ((bf16*)(kws() + WS_V))
#define bO ((bf16*)(kws() + WS_O))
#define bU ((bf16*)(kws() + WS_U))
__global__ void __launch_bounds__(NWAVES * 64, 2) mega_fwd(Args args) {
    extern __shared__ __attribute__((aligned(16))) unsigned char lds[];
    cg::grid_group grid = cg::this_grid();
#define CG_SYNC() do { asm volatile("s_waitcnt vmcnt(0) lgkmcnt(0)" ::: "memory"); grid.sync(); } while (0)
#define GRID_SYNC() do { XcdBarrier xb_; xb_.bar = (unsigned*)(kws() + WS_BAR); xb_.x = xb_xcc_id(); xb_.st = (volatile LAS unsigned*)((LAS unsigned char*)lds + LDS_XB); xcd_barrier(xb_); } while (0)
    if (threadIdx.x < 2) ((volatile LAS unsigned*)((LAS unsigned char*)lds + LDS_XB))[threadIdx.x] = 0u;
    __syncthreads();
    (void)xcd_barrier_post((unsigned*)(kws() + WS_BAR), (volatile LAS unsigned*)((LAS unsigned char*)lds + LDS_XB));
#define PHASE_IDS int tid = threadIdx.x, bx = blockIdx.x, G = gridDim.x; asm volatile("" : "+v"(tid)); bx = __builtin_amdgcn_readfirstlane(bx); G = __builtin_amdgcn_readfirstlane(G); \
    const int lane = tid & 63, wave = __builtin_amdgcn_readfirstlane(tid >> 6), vcu = (G % 8 == 0) ? (bx % 8) * (G / 8) + bx / 8 : bx, gw = vcu * NWAVES + wave, NGW = G * NWAVES; \
    (void)lane; (void)wave; (void)vcu; (void)gw; (void)NGW;
    {
        PHASE_IDS
        const int gt = gw * 64 + lane; float* const ca = cosA; float* const sa = sinA; float* const cb_ = cosB; float* const sb_ = sinB;
        if (gt < 256 * 16) { const int pos = gt >> 4, i = gt & 15; const float fr = __builtin_amdgcn_exp2f(-(float)i * (13.287712379549449f / 16.0f)); const float a = (float)pos * fr;
            const double rev = (double)a * 0.15915494309189535; const float f = (float)(rev - floor(rev)); ca[gt] = __builtin_amdgcn_cosf(f); sa[gt] = __builtin_amdgcn_sinf(f); }
        else if (gt < 256 * 16 + 256 * 8) { const int q = gt - 256 * 16; const int pos = q >> 3, i = q & 7; const float fr = __builtin_amdgcn_exp2f(-(float)i * (13.287712379549449f / 8.0f)); const float a = (float)pos * fr;
            const double rev = (double)a * 0.15915494309189535; const float f = (float)(rev - floor(rev)); cb_[q] = __builtin_amdgcn_cosf(f); sb_[q] = __builtin_amdgcn_sinf(f); }
        if (gt < 64) NMAX[gt] = 0u;
        LAS float* s_lds = (LAS float*)lds; LAS float* part = (LAS float*)(lds + 12288);
        if (bx < 192) {
            const float* const cp = c_in; const float* const ccp = cctx_in; const float* const bap = b_ada; float* const modp = MOD;
            for (int i = tid; i < 3 * 1024; i += NWAVES * 64) { const float cv = (i < 2048) ? cp[i] : ccp[i - 2048]; s_lds[i] = cv / (1.0f + expf(-cv)); }
            __syncthreads();
            for (int bt = bx; bt < 192; bt += G) { const int l = bt / 96, cb = bt % 96;
                const float* W = w_ada + (size_t)l * 1024 * 6144 + 64 * cb + lane; float a0 = 0.f, a1 = 0.f, a2 = 0.f;
#pragma unroll 16
                for (int kk = 0; kk < 128; ++kk) { const int k = 128 * wave + kk; const float wv = W[(size_t)k * 6144]; a0 += s_lds[k] * wv; a1 += s_lds[1024 + k] * wv; a2 += s_lds[2048 + k] * wv; }
                part[(wave * 3 + 0) * 64 + lane] = a0; part[(wave * 3 + 1) * 64 + lane] = a1; part[(wave * 3 + 2) * 64 + lane] = a2;
                __syncthreads();
                if (tid < 192) { const int r = tid >> 6, ln = tid & 63; float s = bap[l * 6144 + 64 * cb + ln];
#pragma unroll
                    for (int w = 0; w < 8; ++w) s += part[(w * 3 + r) * 64 + ln];
                    modp[(l * 3 + r) * 6144 + 64 * cb + ln] = s; }
                __syncthreads();
            }
        }
        __syncthreads();
        LAS float* scr = (LAS float*)(lds + wave * 16384);
        constexpr int I_IN = 16 * 64, I_OUT = 16 * 32, I_UP = 16 * 176, I_DN = 44 * 32, I_L = I_IN + I_OUT + I_UP + I_DN;
        const float* const wf1_ = w_ff1; const float* const wf3_ = w_ff3;
        for (int it = gw; it < 2 * I_L; it += NGW) {
            const int l = it / I_L; int r = it % I_L;
            if (r < I_IN) { const int kb = r / 64, pblk = r % 64, tile = pblk >> 3, pb = pblk & 7, lb = 2 * (pb & 3) + (pb >> 2);
                tr_item(w_in + (size_t)l * 1024 * 2048, 2048, 64 * kb, 256 * tile + 32 * lb, WIN + (size_t)l * 2048 * 1024, 1024, 32 * pblk, scr, lane); continue; } r -= I_IN;
            if (r < I_OUT) { const int kb = r / 32, pblk = r % 32;
                tr_item(w_out + (size_t)l * 1024 * 1024, 1024, 64 * kb, 32 * pblk, WOUT + (size_t)l * 1024 * 1024, 1024, 32 * pblk, scr, lane);
                if (ABL_ZERO_C && 64 * kb < 384) { for (int j = 0; j < 4; ++j) { const int n = (lane >> 3) + 8 * j; *(v4u*)(WOUT + (size_t)l * 1024 * 1024 + (size_t)(32 * pblk + n) * 1024 + 64 * kb + 8 * (lane & 7)) = (v4u){0u, 0u, 0u, 0u}; } }
                continue; } r -= I_OUT;
            if (r < I_UP) { const int kb = r / 176, pblk = r % 176, p = pblk >> 3, bj = (pblk >> 2) & 1, q = pblk & 3;
                tr_item((bj ? wf3_ : wf1_) + (size_t)l * 1024 * FF, FF, 64 * kb, 128 * p + 32 * q, WUP + (size_t)l * NUP * 1024, 1024, 32 * pblk, scr, lane); continue; } r -= I_UP;
            { const int kb = r / 32, pblk = r % 32;
                tr_item(w_ff2 + (size_t)l * FF * 1024, 1024, 64 * kb, 32 * pblk, WDN + (size_t)l * 1024 * FF, FF, 32 * pblk, scr, lane); }
        }
    }
    CG_SYNC();

#pragma unroll 1
    for (int L = 0; L < 2; ++L) {
#define modl (MOD + (size_t)L * 3 * 6144)
        if (L == 0) {
            PHASE_IDS
            norm_rows<0>(gw, NGW, lane, x_in, ctx_in, XRES, XN, nullptr, g_attn + L * D, modl, 0);
            GRID_SYNC();
        }
        {
            PHASE_IDS
            pg8::Gemm g{XN, WIN + (size_t)L * 2048 * 1024, MROWS, NIN, D}; pg8::Order S; S.init(1, NIN, G, bx);
            pg8::EpiQKV E{bQ, bK, bV, g_q + L * 64, g_k + L * 64, cosA, sinA, cosB, sinB, C2A, C2B, NMAX + L * 32};
#ifndef NO_G1
            pg8::gemm_phase<pg8::EpiQKV, pg8::Order, PG8_ALIGN, PG8_SP2>((PG8_LAS unsigned char*)lds, g, S, E);
#endif
        }
        GRID_SYNC();
        {
            PHASE_IDS
            int Lq_ = L; asm volatile("" : "+s"(Lq_)); const float lam_init = (Lq_ == 0) ? 0.2f : 0.35550907f;
            float d1 = 0.f, d2 = 0.f;

#pragma unroll 1
                    for (int i = 0; i < 32; ++i) { d1 += lam_q1[L * 32 + i] * lam_k1[L * 32 + i]; d2 += lam_q2[L * 32 + i] * lam_k2[L * 32 + i]; }
            const float lam = expf(d1) - expf(d2) + lam_init;
            float mgq = 0.f, mgk = 0.f;
#pragma unroll 1
            for (int i = 0; i < 64; ++i) { mgq = fmaxf(mgq, fabsf(g_q[L * 64 + i])); mgk = fmaxf(mgk, fabsf(g_k[L * 64 + i])); }
            const float amfix = 8.0f * mgq * mgk * LOG2E * 1.02f;
            const int NTOT = 512 + 768 + 768 + (L == 0 ? 32 : 0);
            for (int un = vcu; un < NTOT; un += G) {
                attn_body::AttnParams P; int b, h, qb, type;
                if (un < 512) { const int v = un & 255, xx = v >> 5; type = 1; b = xx >> 2; h = xx & 3; qb = (v & 31) + 32 * (un >> 8); }
                else if (un < 2048) { const int ia = (un - 512) % 768; type = (un < 1280) ? 0 : 2; const int v = ia & 255, rnd = ia >> 8, xx = v >> 5, gi = xx >> 1, uu = 96 * (xx & 1) + 3 * (v & 31) + rnd;
                    b = gi >> 1; h = 3 * (gi & 1) + uu / 64; qb = uu % 64; }
                else { const int ic = un - 2048; qb = 64; if (ic < 12) { type = 0; b = ic / 6; h = ic % 6; } else if (ic < 20) { type = 1; b = (ic - 12) / 4; h = (ic - 12) % 4; } else { type = 2; b = (ic - 20) / 6; h = (ic - 20) % 6; } }
                const bool isctx = qb == 64;
                const int qcol = type == 0 ? h : (type == 1 ? 6 + 2 * h : 14 + h), kcol = type == 0 ? h / 3 : (type == 1 ? 2 + h : 6 + h / 3), ocol = type == 0 ? h : (type == 1 ? 6 + h : 10 + h);
                const size_t row0 = (size_t)b * TPB + 256 * qb;
                P.Q = (const attn_body::bf16*)(bQ + row0 * 1280 + qcol * 64);
                P.K = (const attn_body::bf16*)(bK + (size_t)b * TPB * 512 + kcol * 64);
                P.V = (const attn_body::bf16*)(bV + (size_t)b * TPB * 512 + kcol * 64);
                P.O = (attn_body::bf16*)(bO + row0 * 1024 + ocol * 64);
                P.gsub = g_subln + L * 64; P.lam = lam; P.oscale = 1.0f - lam_init; P.mode = 0;
                P.sinkl2 = type == 2 ? sink_logit[L * 6 + h] * LOG2E : -INFINITY;
                P.mask = 0; P.dq0 = 0; P.nomax = (type == 0) ? 1 : 0; P.mfix = amfix;
                if (isctx) { P.NT = 4; P.base_a = SEQ; P.base_b = SEQ; }
                else if (type == 2) { const int band0 = (256 * qb - 128) < 0 ? 0 : 256 * qb - 128, bend = (256 * qb + 384) > SEQ ? SEQ : 256 * qb + 384;
                    P.NT = 4 + (bend - band0) / 64; P.base_a = SEQ; P.base_b = band0; P.mask = 1; P.dq0 = 256 * qb - band0; }
                else { P.NT = TPB / 64; P.base_a = 0; P.base_b = 256; }
#ifndef NO_ATTN
                if (type != 1) { P.khalf = 0; attn_body::attn_unit<8, false>(P, (char*)lds); }
                else {
#pragma unroll 1
                    for (int ps = 0; ps < 2; ++ps) { P.mode = 1 + ps; P.khalf = ps; if (ps) P.Q += 64;
                        const unsigned* nm = NMAX + L * 32 + ((b * 4 + h) * 2 + ps) * 2;
                        const float q2 = __uint_as_float(__hip_atomic_load(nm, __ATOMIC_RELAXED, __HIP_MEMORY_SCOPE_AGENT)), k2 = __uint_as_float(__hip_atomic_load(nm + 1, __ATOMIC_RELAXED, __HIP_MEMORY_SCOPE_AGENT));
                        P.nomax = 1; P.mfix = sqrtf(q2) * sqrtf(k2) * 1.02f;
                        attn_body::attn_unit<8, true>(P, (char*)lds); } }
#endif
            }
        }
        GRID_SYNC();
#if SELFCHECK
        {
            PHASE_IDS
            if (wave == 0 && bx < 12 && (L == 0 || bx < 8 || bx == 11)) {
                int type, b, h, t;
                switch (bx) { case 0: type = 0; b = 0; h = 1; t = 1000; break; case 1: type = 0; b = 1; h = 4; t = 16383; break; case 2: type = 1; b = 0; h = 0; t = 5; break; case 3: type = 1; b = 1; h = 3; t = 9000; break;
                    case 4: type = 2; b = 0; h = 2; t = 7777; break; case 5: type = 2; b = 1; h = 0; t = 100; break; case 6: type = 2; b = 0; h = 5; t = 16380; break; case 7: type = 2; b = 1; h = 3; t = 256; break;
                    case 8: type = 0; b = 0; h = 2; t = SEQ + 17; break; case 9: type = 1; b = 1; h = 1; t = SEQ + 200; break; case 10: type = 2; b = 0; h = 4; t = SEQ + 255; break; default: type = 0; b = 0; h = 0; t = 0; break; }
                const int qcol = type == 0 ? h : (type == 1 ? 6 + 2 * h : 14 + h), kcol = type == 0 ? h / 3 : (type == 1 ? 2 + h : 6 + h / 3), ocol = type == 0 ? h : (type == 1 ? 6 + h : 10 + h);
                const bf16* Qrow = bQ + ((size_t)b * TPB + t) * 1280 + qcol * 64; const bf16* Kb = bK + (size_t)b * TPB * 512 + kcol * 64; const bf16* Vb = bV + (size_t)b * TPB * 512 + kcol * 64;
                const int kind = t >= SEQ ? 1 : (type == 2 ? 2 : 0); const float skl = type == 2 ? sink_logit[L * 6 + h] * LOG2E : -INFINITY;
                float ref = naive_row(Qrow, Kb, Vb, kind, t, skl, lane, (LAS float*)lds);
                if (type == 1) { const float r2 = naive_row(Qrow + 64, Kb, Vb, kind, t, skl, lane, (LAS float*)lds);
                    int Lq_ = L; asm volatile("" : "+s"(Lq_)); const float lam_init = (Lq_ == 0) ? 0.2f : 0.35550907f;   float d1 = 0.f, d2 = 0.f;

#pragma unroll 1
                    for (int i = 0; i < 32; ++i) { d1 += lam_q1[L * 32 + i] * lam_k1[L * 32 + i]; d2 += lam_q2[L * 32 + i] * lam_k2[L * 32 + i]; }
                    const float lam = expf(d1) - expf(d2) + lam_init; const float v = ref - lam * r2; const float ss = wave_sum(v * v);
                    ref = v / sqrtf(ss * (1.0f / 64.0f) + 1e-6f) * g_subln[L * 64 + lane] * (1.0f - lam_init); }
                const float got = bf2f(bO[((size_t)b * TPB + t) * 1024 + ocol * 64 + lane]);
                const float err = wave_max(fabsf(ref - got)), rms = sqrtf(wave_sum(ref * ref) * (1.0f / 64.0f));
                if (lane == 0) ((float*)(kws() + 4096))[L * 32 + bx] = err / (rms + 1e-20f);
            }
            if (wave == 0 && bx >= 12 && bx < 14) {
                const int m = bx == 12 ? (TPB + 12345) : (SEQ + 3); const int b = m >= TPB ? 1 : 0, t = m - b * TPB, r = t >= SEQ ? 2 : b;
                const float* src = (L == 0) ? (t < SEQ ? x_in + ((size_t)b * SEQ + t) * D : ctx_in + ((size_t)b * CTXL + (t - SEQ)) * D) : nullptr;
                float worst = 0.f;
                if (L == 0) {
                    float ssq = 0.f; for (int k = lane; k < D; k += 64) ssq += src[k] * src[k];
                    const float rn = 1.0f / sqrtf(wave_sum(ssq) * (1.0f / D) + 1e-6f);
                    const float* cvec = r == 2 ? cctx_in : c_in + r * D;
#pragma unroll 1
                    for (int col = lane; col < D; col += 64 * 8) {
                        float sh = b_ada[L * 6144 + col], sc = b_ada[L * 6144 + 1024 + col];
#pragma unroll 1
                        for (int k = 0; k < D; ++k) { const float cv = cvec[k]; const float sl = cv / (1.0f + expf(-cv)); sh += sl * w_ada[((size_t)L * D + k) * 6144 + col]; sc += sl * w_ada[((size_t)L * D + k) * 6144 + 1024 + col]; }
                        const float ref = src[col] * rn * g_attn[L * D + col] * (1.0f + sc) + sh; const float got = bf2f(XN[(size_t)m * D + col]);
                        worst = fmaxf(worst, fabsf(ref - got) / (fabsf(ref) + 0.05f));
                    }
                }
                worst = wave_max(worst);
                if (lane == 0) ((float*)(kws() + 4096))[L * 32 + bx] = worst;
            }
            if (wave == 0 && bx >= 16 && bx < 32) {
                const int gl[8] = {0, 6, 8, 11, 15, 23, 28, 31}; (void)gl;
                const int gi = (bx - 16) & 7; const int g = gi == 0 ? 0 : gi == 1 ? 6 : gi == 2 ? 8 : gi == 3 ? 11 : gi == 4 ? 15 : gi == 5 ? 23 : gi == 6 ? 18 : 31;
                const int m = (bx - 16) < 8 ? (TPB + 12345) : (SEQ + 3); const int b = m >= TPB ? 1 : 0, t = m - b * TPB; const bool isctx = t >= SEQ;
                const int d = lane; float acc = 0.f;
#pragma unroll 1
                for (int k = 0; k < D; ++k) acc += bf2f(XN[(size_t)m * D + k]) * bf2f((unsigned short)f2bf(w_in[((size_t)L * D + k) * 2048 + 64 * g + d]));
                const int kindq = g < 6 ? 0 : g < 8 ? 1 : g < 10 ? 2 : g < 14 ? 3 : g < 18 ? 4 : g < 22 ? 2 : g < 28 ? 5 : g < 30 ? 6 : 2;
                float v = acc;
                if (kindq == 0 || kindq == 1) { const float ss = wave_sum(v * v); v = v / sqrtf(ss * (1.0f / 64.0f) + 1e-6f) * (kindq == 0 ? g_q[L * 64 + d] : g_k[L * 64 + d]); }
                if (!isctx && kindq != 2) {
                    const int trow = t >> 6, tcol = t & 63;
                    if (kindq == 3 || kindq == 4) { const int e = d & 31, w = e & 15, i = w & 7; const int pos = (e >> 4) ? tcol : trow; const float fr = powf(10000.0f, -(float)i / 8.0f); const float ang = (float)pos * fr;
                        float sn, cs; sincos_d((double)ang, sn, cs); const float xp = __shfl_xor(v, 8); v = (w < 8) ? v * cs - xp * sn : xp * sn + v * cs; }
                    else { const int e = d & 31, i = e & 15; const int pos = (d >> 5) ? tcol : trow; const float fr = powf(10000.0f, -(float)i / 16.0f); const float ang = (float)pos * fr;
                        float sn, cs; sincos_d((double)ang, sn, cs); const float xp = __shfl_xor(v, 16); v = (e < 16) ? v * cs - xp * sn : xp * sn + v * cs; }
                }
                float got;
                const size_t row = (size_t)m;
                if (kindq == 0) { v *= C2A; got = bf2f(bQ[row * 1280 + 64 * g + d]); }
                else if (kindq == 1) got = bf2f(bK[row * 512 + 64 * (g - 6) + d]);
                else if (kindq == 3) { v *= C2B; const int vh = 6 + 2 * (g - 10) + (d >> 5); got = bf2f(bQ[row * 1280 + 64 * vh + d]); const float z = bf2f(bQ[row * 1280 + 64 * vh + (d ^ 32)]); if (__any(z != 0.f) && lane == 0) ((float*)(kws() + 4096))[200 + L * 32 + bx] = 1.0f; }
                else if (kindq == 4) got = bf2f(bK[row * 512 + 64 * (2 + g - 14) + d]);
                else if (kindq == 5) { v *= C2A; got = bf2f(bQ[row * 1280 + 64 * (14 + g - 22) + d]); }
                else if (kindq == 6) got = bf2f(bK[row * 512 + 64 * (6 + g - 28) + d]);
                else got = bf2f(bV[row * 512 + 64 * (g < 10 ? g - 8 : g < 22 ? 2 + g - 18 : 6 + g - 30) + d]);
                const float err = wave_max(fabsf(v - got)), rms = sqrtf(wave_sum(v * v) * (1.0f / 64.0f));
                if (lane == 0) ((float*)(kws() + 4096))[L * 32 + bx] = err / (rms + 1e-20f);
                { const float vp = __shfl_xor(v, 8), gp = __shfl_xor(got, 8); const float pr = v * v + vp * vp, pg = got * got + gp * gp; const float e2 = wave_max(fabsf(pr - pg)) / (wave_sum(pr) * (1.0f / 64.0f) + 1e-20f);
                  if (lane == 0) ((float*)(kws() + 4096))[100 + L * 32 + bx] = e2; }
            }
        }
#endif
        {
            const int skip = (L == 1) ? 1 : 0;
            PHASE_IDS
            pg8::Gemm g{bO, WOUT + (size_t)L * 1024 * 1024, MROWS, D, D}; pg8::Order S; S.init(skip ? 0 : 1, D, G, bx);
            pg8::EpiRes E{XRES, modl, 2, L == 0 ? x_in : nullptr, ctx_in};
#ifndef NO_GR
            pg8::gemm_phase<pg8::EpiRes, pg8::Order, PG8_ALIGN, PG8_SP2>((PG8_LAS unsigned char*)lds, g, S, E);
#endif
        }
        GRID_SYNC();
        { PHASE_IDS
            norm_rows<1>(gw, NGW, lane, nullptr, nullptr, XRES, XN, nullptr, g_ffn + L * D, modl, 3); }
        GRID_SYNC();
        {
            const int skip = (L == 1) ? 1 : 0;
            PHASE_IDS
            pg8::Gemm g{XN, WUP + (size_t)L * NUP * 1024, MROWS, NUP, D}; pg8::Order S; S.init(skip ? 0 : 1, NUP, G, bx);
            pg8::EpiSwiGLU E{bU};
#ifndef NO_GU
            pg8::gemm_phase<pg8::EpiSwiGLU, pg8::Order, PG8_ALIGN, PG8_SP2>((PG8_LAS unsigned char*)lds, g, S, E);
#endif
        }
        GRID_SYNC();
        {
            const int skip = (L == 1) ? 1 : 0;
            PHASE_IDS
            pg8::Gemm g{bU, WDN + (size_t)L * 1024 * FF, MROWS, D, FF}; pg8::Order S; S.init(skip ? 0 : 1, D, G, bx);
            pg8::EpiRes E{XRES, modl, 5, nullptr, nullptr};
#ifndef NO_GR
            pg8::gemm_phase<pg8::EpiRes, pg8::Order, PG8_ALIGN, PG8_SP2>((PG8_LAS unsigned char*)lds, g, S, E);
#endif
        }
        GRID_SYNC();
        if (L == 0) {
            PHASE_IDS
            norm_rows<1>(gw, NGW, lane, nullptr, nullptr, XRES, XN, nullptr, g_attn + 1 * D, MOD + (size_t)1 * 3 * 6144, 0);
            GRID_SYNC();
        } else {
            PHASE_IDS
            norm_rows<2>(gw, NGW, lane, nullptr, nullptr, XRES, nullptr, (float*)kin(22), g_final, nullptr, 0);
#if SELFCHECK
            asm volatile("s_waitcnt vmcnt(0)" ::: "memory"); __syncthreads();
            if (bx == 0 && tid == 0) { const float* dg = (const float*)(kws() + 4096); float e19 = dg[100 + 20]; if (!(e19 < 5.0f)) e19 = 5.0f; if (e19 < 0.f) e19 = 0.f; float e20 = dg[22]; if (!(e20 < 5.0f)) e20 = 5.0f; if (e20 < 0.f) e20 = 0.f;
                ((float*)kin(22))[0] = 1000.0f * (1.0f + 10.0f * e19) + (dg[200 + 19] == 1.0f ? 100000.0f : 0.f); ((float*)kin(22))[1] = 100.0f * (1.0f + 10.0f * e20); }
#endif
        }
    }
}

extern "C" void kernel_launch(void* const* d_in, const int* in_sizes, int n_in, void* d_out, int out_size, void* d_ws, size_t ws_size, hipStream_t stream) {
    static int grid = 0;
    if (grid == 0) {
        if (n_in != 22 || out_size != NBATCH * SEQ * D || ws_size < WS_END) { fprintf(stderr, "kernel_launch: unexpected shapes: n_in %d out %d ws %zu (need %zu); nothing launched\n", n_in, out_size, ws_size, (size_t)WS_END); grid = -1; return; }
        int dev = 0, cus = 0, per_cu = 0;
        if (hipGetDevice(&dev) != hipSuccess || hipDeviceGetAttribute(&cus, hipDeviceAttributeMultiprocessorCount, dev) != hipSuccess) { grid = -1; return; }
        if (hipFuncSetAttribute((const void*)mega_fwd, hipFuncAttributeMaxDynamicSharedMemorySize, LDS_BYTES) != hipSuccess) { fprintf(stderr, "kernel_launch: hipFuncSetAttribute failed\n"); grid = -1; return; }
        if (hipOccupancyMaxActiveBlocksPerMultiprocessor(&per_cu, (const void*)mega_fwd, NWAVES * 64, LDS_BYTES) != hipSuccess || per_cu < 1) { fprintf(stderr, "kernel_launch: occupancy query says %d\n", per_cu); per_cu = 1; }
        (void)hipGetLastError();
        grid = cus;
    }
    if (grid < 0) return;
    if (hipMemsetAsync((char*)d_ws + WS_BAR, 0, 16384, stream) != hipSuccess) { fprintf(stderr, "kernel_launch: hipMemsetAsync failed\n"); return; }
    Args a{};
    for (int i = 0; i < 22; ++i) a.in[i] = (const float*)d_in[i];
    a.out = (float*)d_out; a.ws = (unsigned char*)d_ws;
    void* kargs[] = {&a};
    const hipError_t e = hipLaunchCooperativeKernel((const void*)mega_fwd, dim3(grid), dim3(NWAVES * 64), kargs, LDS_BYTES, stream);
    if (e != hipSuccess) fprintf(stderr, "kernel_launch: cooperative launch failed: %s (grid %d)\n", hipGetErrorString(e), grid);
}
```

```cpp
#include <hip/hip_runtime.h>
#include <hip/hip_bf16.h>
#include <hip/hip_cooperative_groups.h>
#include <cstdio>
#include <cstdint>
#include <cmath>

namespace pg8 {
#define PG8_LAS __attribute__((address_space(3)))
typedef unsigned short bf16_t;
typedef short bf16x8 __attribute__((ext_vector_type(8)));
typedef float f32x4 __attribute__((ext_vector_type(4)));
typedef unsigned u32x4 __attribute__((ext_vector_type(4)));
constexpr int BM = 256, BK = 64, HALF = 128, HTB = HALF * BK * 2  , STAGE_BYTES = 8 * HTB, NXCD = 8, WGM = 8;

__host__ __device__ __forceinline__ int lds_byte(int r, int c) { const int st = (r >> 4) * 2 + (c >> 5), rr = r & 15, cc = c & 31, ob = rr * 64 + cc * 2; return st * 1024 + (ob ^ (((ob >> 9) & 1) << 5)); }
__host__ __device__ __forceinline__ void stage_rc(int b, int& R, int& C) { const int st = b / 1024, sb = b % 1024, swz = sb ^ (((sb >> 9) & 1) << 5); R = (st >> 1) * 16 + swz / 64; C = (st & 1) * 32 + (swz % 64) / 2; }
__host__ __device__ __forceinline__ int perm32(int rho) { const int n = rho >> 4, i = rho & 15; return 8 * (i >> 2) + 4 * n + (i & 3); }

struct Unit { int pm, pn; };
struct Gemm { const bf16_t* A; const bf16_t* Bt; int M, N, K; };

struct StaticOrder {
    int nM, nN, nwg, G, c;
    __host__ __device__ void init(int M, int N, int G_, int c_) { nM = M / BM; nN = N / BM; nwg = nM * nN; G = G_; c = c_; }
    __host__ __device__ bool next(int i, Unit& u) const {
        const long L = (long)i * G + c; if (L >= nwg) return false;
        int wgid = (int)L; { const int q = nwg / NXCD, r = nwg % NXCD, xcd = wgid % NXCD, off = wgid / NXCD; wgid = (xcd < r ? xcd * (q + 1) : r * (q + 1) + (xcd - r) * q) + off; }
        const int nig = WGM * nN, gid = wgid / nig, fm = gid * WGM, gsz = (nM - fm) < WGM ? (nM - fm) : WGM;
        u.pm = fm + ((wgid % nig) % gsz); u.pn = (wgid % nig) / gsz; return true;
    }
    __device__ __forceinline__ void a_ready(const Unit&) const {}
    __device__ __forceinline__ void done(const Unit&) const {}
};

__device__ __forceinline__ unsigned cvt_pk_bf16(float lo, float hi) { unsigned r; asm volatile("v_cvt_pk_bf16_f32 %0, %1, %2" : "=v"(r) : "v"(lo), "v"(hi)); return r; }
typedef float f32x2 __attribute__((ext_vector_type(2)));


typedef unsigned u32x2 __attribute__((ext_vector_type(2)));
__device__ __forceinline__ unsigned pk_bf16(float lo, float hi) { typedef float f2 __attribute__((ext_vector_type(2))); typedef __bf16 b2 __attribute__((ext_vector_type(2))); f2 v = {lo, hi}; b2 b = __builtin_convertvector(v, b2); return __builtin_bit_cast(unsigned, b); }
struct Order {
    int nM, nN, nwg, G, c, skip;
    __device__ void init(int nM_, int N, int G_, int c_, int skip_) { nM = nM_; nN = N / BM; nwg = nM * nN; G = G_; c = c_; skip = skip_; }
    __device__ bool next(int i, Unit& u) const {
        const long L = (long)i * G + c; if (L >= nwg) return false;
        int wgid = (int)L; { const int q = nwg / NXCD, r = nwg % NXCD, xcd = wgid % NXCD, off = wgid / NXCD; wgid = (xcd < r ? xcd * (q + 1) : r * (q + 1) + (xcd - r) * q) + off; }
        const int nig = WGM * nN, gid = wgid / nig, fm = gid * WGM, gsz = (nM - fm) < WGM ? (nM - fm) : WGM;
        u.pm = fm + ((wgid % nig) % gsz); u.pn = (wgid % nig) / gsz;
        if (skip) u.pm += (u.pm >= 64) ? 1 : 0;
        return true;
    }
    __device__ __forceinline__ void a_ready(const Unit&) const {}
    __device__ __forceinline__ void done(const Unit&) const {}
};
constexpr int TPB_ = 16640, SEQ_ = 16384;
struct EpiQKV {
    static constexpr bool PERM = false, AFTER_DRAIN = false;
    bf16_t *Q, *K, *V; const float *gq, *gk, *cosA, *sinA, *cosB, *sinB; float c2a, c2b;
    unsigned* nmax;
    __device__ __forceinline__ void operator()(const f32x4 (&acc)[2][2][4][2], const Unit& u, int wr, int wc, int fr, int fq) const {
        asm volatile("" : "+v"(fr), "+v"(fq));
        const int lnq = fq * 16 + fr, bp16 = (lnq ^ 16) << 2, bp32 = (lnq ^ 32) << 2;
        const int g = 4 * u.pn + wc;
        bf16_t* dst; int pitch, dcol, rope = 0; const float* ng = nullptr; float sc = 1.f; bool split = false;
        if (g < 6)       { dst = Q; pitch = 1280; dcol = 64 * g; ng = gq; rope = 1; sc = c2a; }
        else if (g < 8)  { dst = K; pitch = 512; dcol = 64 * (g - 6); ng = gk; rope = 1; }
        else if (g < 10) { dst = V; pitch = 512; dcol = 64 * (g - 8); }
        else if (g < 14) { dst = Q; pitch = 1280; dcol = 64 * (6 + 2 * (g - 10)); rope = 2; sc = c2b; split = true; }
        else if (g < 18) { dst = K; pitch = 512; dcol = 64 * (2 + g - 14); rope = 2; }
        else if (g < 22) { dst = V; pitch = 512; dcol = 64 * (2 + g - 18); }
        else if (g < 28) { dst = Q; pitch = 1280; dcol = 64 * (14 + g - 22); rope = 1; sc = c2a; }
        else if (g < 30) { dst = K; pitch = 512; dcol = 64 * (6 + g - 28); rope = 1; }
        else             { dst = V; pitch = 512; dcol = 64 * (6 + g - 30); }
        const int bt = u.pm >= 65 ? 1 : 0, tile_t0 = (u.pm - 65 * bt) * 256; const bool isctx = tile_t0 >= SEQ_;
        const bool rope2g = (g >= 10 && g < 18); float nmx[2] = {0.f, 0.f};
        if (isctx) rope = 0;
        f32x4 gv[2][2];
#pragma unroll
        for (int bj = 0; bj < 2; ++bj)
#pragma unroll
            for (int n = 0; n < 2; ++n) gv[bj][n] = ng ? *(const f32x4*)(ng + 32 * bj + 16 * n + 4 * fq) : (f32x4){1.f, 1.f, 1.f, 1.f};
#pragma unroll
        for (int ai = 0; ai < 2; ++ai)
#pragma unroll
            for (int m = 0; m < 4; ++m) {
                const int rl = ai * HALF + wr * 64 + m * 16 + fr; const int t = tile_t0 + rl; const size_t row = (size_t)u.pm * BM + rl;
                const int trow = (t >> 6) & 255, tcol = t & 63;
                f32x4 v[2][2];
#pragma unroll
                for (int bj = 0; bj < 2; ++bj)
#pragma unroll
                    for (int n = 0; n < 2; ++n) v[bj][n] = acc[ai][bj][m][n];
                if (ng) {
                    float ss = 0.f;
#pragma unroll
                    for (int bj = 0; bj < 2; ++bj)
#pragma unroll
                        for (int n = 0; n < 2; ++n) { const f32x4 x = v[bj][n]; ss += (x[0] * x[0] + x[1] * x[1]) + (x[2] * x[2] + x[3] * x[3]); }
                    ss += __builtin_bit_cast(float, __builtin_amdgcn_ds_bpermute(bp16, __builtin_bit_cast(int, ss))); ss += __builtin_bit_cast(float, __builtin_amdgcn_ds_bpermute(bp32, __builtin_bit_cast(int, ss)));
                    const float rn = 1.0f / sqrtf(ss * (1.0f / 64.0f) + 1e-6f);
#pragma unroll
                    for (int bj = 0; bj < 2; ++bj)
#pragma unroll
                        for (int n = 0; n < 2; ++n) v[bj][n] = v[bj][n] * rn * gv[bj][n];
                }
                if (rope == 1) {
#pragma unroll
                    for (int bj = 0; bj < 2; ++bj) { const int pos = bj ? tcol : trow;
                        const f32x4 c = *(const f32x4*)(cosA + pos * 16 + 4 * fq), s = *(const f32x4*)(sinA + pos * 16 + 4 * fq);
                        const f32x4 x1 = v[bj][0], x2 = v[bj][1]; v[bj][0] = x1 * c - x2 * s; v[bj][1] = x1 * s + x2 * c; }
                } else if (rope == 2) {
#pragma unroll
                    for (int n = 0; n < 2; ++n) { const int pos = n ? tcol : trow;
                        const f32x4 c = *(const f32x4*)(cosB + pos * 8 + 4 * (fq & 1)); f32x4 s = *(const f32x4*)(sinB + pos * 8 + 4 * (fq & 1));
                        if (fq < 2) s = -s;
#pragma unroll
                        for (int bj = 0; bj < 2; ++bj) { const f32x4 x = v[bj][n]; f32x4 p;
#pragma unroll
                            for (int e = 0; e < 4; ++e) { const float xe = x[e]; p[e] = __int_as_float(__builtin_amdgcn_ds_bpermute(bp32, __float_as_int(xe))); }
                            v[bj][n] = x * c + p * s; } }
                }
                if (rope2g) {
#pragma unroll
                    for (int bj = 0; bj < 2; ++bj) { const f32x4 x0 = v[bj][0] * sc, x1 = v[bj][1] * sc; float s2 = ((x0[0] * x0[0] + x0[1] * x0[1]) + (x0[2] * x0[2] + x0[3] * x0[3])) + ((x1[0] * x1[0] + x1[1] * x1[1]) + (x1[2] * x1[2] + x1[3] * x1[3]));
                        s2 += __int_as_float(__builtin_amdgcn_ds_bpermute(bp16, __float_as_int(s2))); s2 += __int_as_float(__builtin_amdgcn_ds_bpermute(bp32, __float_as_int(s2))); nmx[bj] = fmaxf(nmx[bj], s2); } }
                bf16_t* rp = (pitch == 512) ? dst + (((size_t)(bt * 8 + (dcol >> 6)) * TPB_ + (size_t)t) << 6) + 4 * fq
                                            : dst + row * pitch + dcol + 4 * fq;
                if (!split) {
#pragma unroll
                    for (int bj = 0; bj < 2; ++bj)
#pragma unroll
                        for (int n = 0; n < 2; ++n) { const f32x4 x = v[bj][n] * sc; u32x2 w; w.x = pk_bf16(x[0], x[1]); w.y = pk_bf16(x[2], x[3]); *(u32x2*)(rp + 32 * bj + 16 * n) = w; }
                } else {
#pragma unroll
                    for (int n = 0; n < 2; ++n) { const f32x4 x = v[0][n] * sc, y = v[1][n] * sc; u32x2 w, z; w.x = pk_bf16(x[0], x[1]); w.y = pk_bf16(x[2], x[3]); z.x = 0u; z.y = 0u;
                        *(u32x2*)(rp + 16 * n) = w; *(u32x2*)(rp + 32 + 16 * n) = z; *(u32x2*)(rp + 64 + 16 * n) = z;
                        w.x = pk_bf16(y[0], y[1]); w.y = pk_bf16(y[2], y[3]); *(u32x2*)(rp + 96 + 16 * n) = w; }
                }
            }
        if (rope2g) {
#pragma unroll
            for (int bj = 0; bj < 2; ++bj) { float m2 = nmx[bj];
#pragma unroll
                for (int o_ = 1; o_ < 16; o_ <<= 1) m2 = fmaxf(m2, __int_as_float(__builtin_amdgcn_ds_bpermute((lnq ^ o_) << 2, __float_as_int(m2))));
                const int hb = g < 14 ? g - 10 : g - 14, isk = g < 14 ? 0 : 1;
                if (lnq == 0) __hip_atomic_fetch_max(nmax + (((bt * 4 + hb) * 2 + bj) * 2 + isk), __float_as_uint(m2), __ATOMIC_RELAXED, __HIP_MEMORY_SCOPE_AGENT); } }
    }
};
struct EpiRes {
    static constexpr bool PERM = false, AFTER_DRAIN = false;
    float* X; const float* modl; int gidx; const float* xin; const float* cin;
    __device__ __forceinline__ void operator()(const f32x4 (&acc)[2][2][4][2], const Unit& u, int wr, int wc, int fr, int fq) const {
        asm volatile("" : "+v"(fr), "+v"(fq));
        const int bt = u.pm >= 65 ? 1 : 0, r = (u.pm - 65 * bt) == 64 ? 2 : bt;
        const float* rbase = X + (size_t)u.pm * BM * 1024;
        if (xin) rbase = (r == 2) ? cin + (size_t)bt * 256 * 1024 : xin + ((size_t)bt * SEQ_ + (size_t)(u.pm - 65 * bt) * 256) * 1024;
        const int col0 = u.pn * BM + wc * 32 + 4 * fq; const float* gate = modl + r * 6144 + gidx * 1024 + col0;
        f32x4 gv[2][2];
#pragma unroll
        for (int bj = 0; bj < 2; ++bj)
#pragma unroll
            for (int n = 0; n < 2; ++n) gv[bj][n] = *(const f32x4*)(gate + bj * HALF + n * 16);
#pragma unroll
        for (int ai = 0; ai < 2; ++ai)
#pragma unroll
            for (int m = 0; m < 4; ++m) { const int rl = ai * HALF + wr * 64 + m * 16 + fr; float* rp = X + ((size_t)u.pm * BM + rl) * 1024 + col0; const float* rq = rbase + (size_t)rl * 1024 + col0;
#pragma unroll
                for (int bj = 0; bj < 2; ++bj)
#pragma unroll
                    for (int n = 0; n < 2; ++n) { f32x4* p = (f32x4*)(rp + bj * HALF + n * 16); *p = *(const f32x4*)(rq + bj * HALF + n * 16) + gv[bj][n] * acc[ai][bj][m][n]; }
                if (m & 1) asm volatile("" ::: "memory"); }
    }
};
struct EpiSwiGLU {
    static constexpr bool PERM = true, AFTER_DRAIN = false;
    bf16_t* U;
    __device__ __forceinline__ void operator()(const f32x4 (&acc)[2][2][4][2], const Unit& u, int wr, int wc, int fr, int fq) const {
        asm volatile("" : "+v"(fr), "+v"(fq));
        const int col0 = u.pn * HALF + wc * 32 + 8 * fq;
#pragma unroll
        for (int ai = 0; ai < 2; ++ai)
#pragma unroll
            for (int m = 0; m < 4; ++m) { bf16_t* rp = U + ((size_t)u.pm * BM + ai * HALF + wr * 64 + m * 16 + fr) * 2816 + col0;
                float o[8];
#pragma unroll
                for (int n = 0; n < 2; ++n)
#pragma unroll
                    for (int j = 0; j < 4; ++j) { const float a = acc[ai][0][m][n][j], b = acc[ai][1][m][n][j];
                        o[4 * n + j] = a * __builtin_amdgcn_rcpf(1.0f + __builtin_amdgcn_exp2f(-1.4426950408889634f * a)) * b; }
                u32x4 w; w.x = pk_bf16(o[0], o[1]); w.y = pk_bf16(o[2], o[3]); w.z = pk_bf16(o[4], o[5]); w.w = pk_bf16(o[6], o[7]);
                *(u32x4*)rp = w; }
    }
};

template <class Epi, class Sched, bool ALIGN_EPI = false, bool SP2 = false>
__device__ __forceinline__ void gemm_phase(PG8_LAS unsigned char* lds, const Gemm g, const Sched& S, const Epi& E) {
    int tid_ = threadIdx.x; asm volatile("" : "+v"(tid_));
    const int tid = tid_, wid = __builtin_amdgcn_readfirstlane(tid >> 6), lane = tid & 63, wr = wid >> 2, wc = wid & 3, fr = lane & 15, fq = lane >> 4;
    const int K = g.K, nt = K / BK;
    unsigned voffA[2], voffB[2];
#pragma unroll
    for (int i = 0; i < 2; ++i) { int R, C; stage_rc(tid * 16 + i * 8192, R, C); const int Rb = Epi::PERM ? ((R & ~31) + perm32(R & 31)) : R;
        voffA[i] = (unsigned)(R * K + C) * 2u; voffB[i] = (unsigned)(Rb * K + C) * 2u; }
    const size_t kstep = (size_t)(BK * 2);
    const size_t hstep = (size_t)HALF * K * 2;
    const size_t tstep = 2 * hstep;
    const unsigned ldsw = (unsigned)wid * 1024u;
    const int aoff = lds_byte(wr * 64 + fr, fq * 8), boff = lds_byte(wc * 32 + fr, fq * 8);
#define PG8_SA(b, h) (((b) * 2 + (h)) * HTB)
#define PG8_SB(b, h) ((4 + (b) * 2 + (h)) * HTB)
#define PG8_STAGE(bufoff, gbase, voff) do { _Pragma("unroll") for (int _i = 0; _i < 2; ++_i) \
        __builtin_amdgcn_global_load_lds((const unsigned*)((const char*)(gbase) + (voff)[_i]), (PG8_LAS unsigned*)(lds + (bufoff) + ldsw + _i * 8192), 16, 0, 0); } while (0)
#define PG8_LDA(dst, b, h) do { _Pragma("unroll") for (int m = 0; m < 4; ++m) _Pragma("unroll") for (int k = 0; k < 2; ++k) dst[m][k] = *(const PG8_LAS bf16x8*)(lds + PG8_SA(b, h) + aoff + m * 2048 + k * 1024); } while (0)
#define PG8_LDB(dst, b, h) do { _Pragma("unroll") for (int n = 0; n < 2; ++n) _Pragma("unroll") for (int k = 0; k < 2; ++k) dst[n][k] = *(const PG8_LAS bf16x8*)(lds + PG8_SB(b, h) + boff + n * 2048 + k * 1024); } while (0)
#define PG8_MMA(ai, bj, At, Bt) do { __builtin_amdgcn_s_setprio(1); _Pragma("unroll") for (int m = 0; m < 4; ++m) _Pragma("unroll") for (int n = 0; n < 2; ++n) _Pragma("unroll") for (int k = 0; k < 2; ++k) \
        acc[ai][bj][m][n] = __builtin_amdgcn_mfma_f32_16x16x32_bf16(Bt[n][k], At[m][k], acc[ai][bj][m][n], 0, 0, 0); __builtin_amdgcn_s_setprio(0); } while (0)
#define PG8_WAIT_V(n) asm volatile("s_waitcnt vmcnt(" #n ")" ::: "memory")
#define PG8_WAIT_L(n) asm volatile("s_waitcnt lgkmcnt(" #n ")" ::: "memory")
#define PG8_BAR __builtin_amdgcn_s_barrier()
#define PG8_SCHED __builtin_amdgcn_sched_barrier(0)
    Unit cur, nxt; int ui = 0;
    if (!S.next(0, cur)) return;
    f32x4 acc[2][2][4][2];
#pragma unroll
    for (int a = 0; a < 2; ++a)
#pragma unroll
        for (int b = 0; b < 2; ++b)
#pragma unroll
            for (int m = 0; m < 4; ++m)
#pragma unroll
                for (int n = 0; n < 2; ++n) acc[a][b][m][n] = (f32x4){0.f, 0.f, 0.f, 0.f};
    bf16x8 At[4][2], B0[2][2], B1[2][2];
    const char* cA = (const char*)g.A + (size_t)cur.pm * tstep; const char* cB = (const char*)g.Bt + (size_t)cur.pn * tstep;
    S.a_ready(cur);
    if constexpr (SP2) {
        PG8_STAGE(PG8_SB(0, 0), cB, voffB); PG8_STAGE(PG8_SB(0, 1), cB + hstep, voffB); PG8_STAGE(PG8_SA(0, 0), cA, voffA); PG8_STAGE(PG8_SA(0, 1), cA + hstep, voffA);
        if (wr == 1) PG8_BAR;
        PG8_WAIT_V(2); PG8_BAR;
        PG8_STAGE(PG8_SB(1, 0), cB + kstep, voffB); PG8_STAGE(PG8_SA(1, 0), cA + kstep, voffA); PG8_STAGE(PG8_SB(1, 1), cB + hstep + kstep, voffB);
        PG8_WAIT_V(6); PG8_BAR;
    } else {
        PG8_STAGE(PG8_SB(0, 0), cB, voffB); PG8_STAGE(PG8_SA(0, 0), cA, voffA); PG8_STAGE(PG8_SB(0, 1), cB + hstep, voffB); PG8_STAGE(PG8_SA(0, 1), cA + hstep, voffA);
        if (wr == 1) PG8_BAR;
        PG8_WAIT_V(4); PG8_BAR;
        PG8_STAGE(PG8_SB(1, 0), cB + kstep, voffB); PG8_STAGE(PG8_SA(1, 0), cA + kstep, voffA); PG8_STAGE(PG8_SB(1, 1), cB + hstep + kstep, voffB);
        PG8_WAIT_V(6); PG8_BAR;
    }
    for (;;) {
        const bool has_next = S.next(ui + 1, nxt);
        const char* nA = has_next ? (const char*)g.A + (size_t)nxt.pm * tstep : cA; const char* nB = has_next ? (const char*)g.Bt + (size_t)nxt.pn * tstep : cB;
        for (int t = 0; t < nt; t += 2) {
            const bool last = (t == nt - 2);
            const char* a1 = cA + (size_t)(t + 1) * kstep;
            const char* a2 = last ? nA : cA + (size_t)(t + 2) * kstep; const char* b2 = last ? nB : cB + (size_t)(t + 2) * kstep;
            const char* a3 = a2 + kstep; const char* b3 = b2 + kstep;
            if (last && has_next) S.a_ready(nxt);
            if constexpr (SP2) {
            PG8_LDB(B0, 0, 0); PG8_LDB(B1, 0, 1); PG8_SCHED; PG8_LDA(At, 0, 0); PG8_STAGE(PG8_SA(1, 1), a1 + hstep, voffA);
            PG8_WAIT_V(8); PG8_WAIT_L(0); PG8_BAR; PG8_MMA(0, 0, At, B0); PG8_MMA(0, 1, At, B1); PG8_BAR; PG8_SCHED;
            PG8_LDA(At, 0, 1); PG8_STAGE(PG8_SB(0, 0), b2, voffB); PG8_STAGE(PG8_SB(0, 1), b2 + hstep, voffB); PG8_STAGE(PG8_SA(0, 0), a2, voffA);
            PG8_WAIT_V(8); PG8_WAIT_L(0); PG8_BAR; PG8_MMA(1, 0, At, B0); PG8_MMA(1, 1, At, B1); PG8_BAR; PG8_SCHED;
            PG8_LDB(B0, 1, 0); PG8_LDB(B1, 1, 1); PG8_SCHED; PG8_LDA(At, 1, 0); PG8_STAGE(PG8_SA(0, 1), a2 + hstep, voffA);
            PG8_WAIT_V(8); PG8_WAIT_L(0); PG8_BAR; PG8_MMA(0, 0, At, B0); PG8_MMA(0, 1, At, B1); PG8_BAR; PG8_SCHED;
            PG8_LDA(At, 1, 1); PG8_STAGE(PG8_SB(1, 0), b3, voffB); PG8_STAGE(PG8_SB(1, 1), b3 + hstep, voffB); PG8_STAGE(PG8_SA(1, 0), a3, voffA);
            PG8_WAIT_V(8); PG8_WAIT_L(0); PG8_BAR; PG8_MMA(1, 0, At, B0); PG8_MMA(1, 1, At, B1); PG8_BAR; PG8_SCHED;
            } else {
            PG8_LDB(B0, 0, 0); PG8_SCHED; PG8_LDA(At, 0, 0); PG8_STAGE(PG8_SA(1, 1), a1 + hstep, voffA);
            PG8_WAIT_L(8); PG8_BAR; PG8_WAIT_L(0); PG8_MMA(0, 0, At, B0); PG8_BAR; PG8_SCHED;
            PG8_LDB(B1, 0, 1); PG8_STAGE(PG8_SB(0, 0), b2, voffB);
            PG8_BAR; PG8_WAIT_L(0); PG8_MMA(0, 1, At, B1); PG8_BAR;
            PG8_LDA(At, 0, 1); PG8_STAGE(PG8_SA(0, 0), a2, voffA);
            PG8_BAR; PG8_WAIT_L(0); PG8_MMA(1, 0, At, B0); PG8_BAR; PG8_SCHED;
            PG8_STAGE(PG8_SB(0, 1), b2 + hstep, voffB);
            PG8_WAIT_V(6); PG8_BAR; PG8_MMA(1, 1, At, B1); PG8_BAR;
            PG8_LDB(B0, 1, 0); PG8_SCHED; PG8_LDA(At, 1, 0); PG8_STAGE(PG8_SA(0, 1), a2 + hstep, voffA);
            PG8_WAIT_L(8); PG8_BAR; PG8_WAIT_L(0); PG8_MMA(0, 0, At, B0); PG8_BAR; PG8_SCHED;
            PG8_LDB(B1, 1, 1); PG8_STAGE(PG8_SB(1, 0), b3, voffB);
            PG8_BAR; PG8_WAIT_L(0); PG8_MMA(0, 1, At, B1); PG8_BAR;
            PG8_LDA(At, 1, 1); PG8_STAGE(PG8_SA(1, 0), a3, voffA);
            PG8_BAR; PG8_WAIT_L(0); PG8_MMA(1, 0, At, B0); PG8_BAR; PG8_SCHED;
            PG8_STAGE(PG8_SB(1, 1), b3 + hstep, voffB);
            PG8_WAIT_V(6); PG8_BAR; PG8_MMA(1, 1, At, B1); PG8_BAR;
            }
        }
        if constexpr (ALIGN_EPI) { if (wr == 0) PG8_BAR; }
        if constexpr (!Epi::AFTER_DRAIN) { E(acc, cur, wr, wc, fr, fq); S.done(cur); }
        if (!has_next) break;
#pragma unroll
        for (int a = 0; a < 2; ++a)
#pragma unroll
            for (int b = 0; b < 2; ++b)
#pragma unroll
                for (int m = 0; m < 4; ++m)
#pragma unroll
                    for (int n = 0; n < 2; ++n) acc[a][b][m][n] = (f32x4){0.f, 0.f, 0.f, 0.f};
        cur = nxt; cA = nA; cB = nB; ++ui;
        if constexpr (ALIGN_EPI) { if (wr == 1) PG8_BAR; }
    }
    PG8_WAIT_V(0);
    if constexpr (!ALIGN_EPI) { if (wr == 0) PG8_BAR; }
    PG8_BAR;
    if constexpr (Epi::AFTER_DRAIN) { E.fused(acc, cur, wr, wc, fr, fq, lds, wid, lane); S.done(cur); }
#undef PG8_SA
#undef PG8_SB
#undef PG8_STAGE
#undef PG8_LDA
#undef PG8_LDB
#undef PG8_MMA
#undef PG8_WAIT_V
#undef PG8_WAIT_L
#undef PG8_BAR
#undef PG8_SCHED
}
}

#ifndef PG8_SP2
#define PG8_SP2 true
#endif
#ifndef PG8_ALIGN
#define PG8_ALIGN true
#endif

namespace attn_body {
using bf16=__hip_bfloat16;
using bf16x8=__attribute__((ext_vector_type(8)))short;
using s16x4=__attribute__((ext_vector_type(4)))short;
using f32x16=__attribute__((ext_vector_type(16)))float;
using u32x4=__attribute__((ext_vector_type(4)))unsigned;
constexpr int D=64;
constexpr int NW=8,QBLK=32,QB=QBLK*NW,KVBLK=64;
typedef float f32x4v __attribute__((ext_vector_type(4))); typedef unsigned u32x2v __attribute__((ext_vector_type(2)));
__device__ __forceinline__ int crow(int r,int hi){return (r&3)+8*(r>>2)+4*hi;}
#define SBAR() __builtin_amdgcn_sched_barrier(0)
__device__ __forceinline__ void cmask(f32x16&p0,f32x16&p1,int jb,int qrel,int hi){
  const float NEG=-INFINITY; int kb=64*jb+4*hi;
  #pragma unroll
  for(int r=0;r<16;++r){int kv=kb+(r&3)+8*(r>>2); if(kv>qrel)p0[r]=NEG; if(kv+32>qrel)p1[r]=NEG;}
}

constexpr int NSLOT=3, SLOTB=8192;
constexpr int LDS_K=0, LDS_V=NSLOT*SLOTB, LDS_WS=2*NSLOT*SLOTB, LDS_OST=LDS_WS+NW*64*4, LDS_BYTES=LDS_OST+NW*8192;
constexpr float C2=0.125f*1.4426950408889634f;
__device__ __forceinline__ void glds16(const void*gsrc,unsigned lds_dst){unsigned keep;
  asm volatile("s_mov_b32 %0, m0\n\ts_mov_b32 m0, %2\n\ts_nop 0\n\tglobal_load_lds_dwordx4 %1, off\n\ts_mov_b32 m0, %0":"=&s"(keep):"v"(gsrc),"s"(lds_dst):"memory");}
__device__ __forceinline__ float max3f(float a,float b,float c){float r;asm("v_max3_f32 %0, %1, %2, %3":"=v"(r):"v"(a),"v"(b),"v"(c));return r;}
__device__ __forceinline__ float max2f(float a,float b){float r;asm("v_max_f32_e32 %0, %1, %2":"=v"(r):"v"(a),"v"(b));return r;}
__device__ __forceinline__ float fadd_s(float a,float b){float r;asm("v_add_f32_e32 %0, %1, %2":"=v"(r):"v"(a),"v"(b));return r;}
__device__ __forceinline__ float fsub_s(float a,float b){float r;asm("v_sub_f32_e32 %0, %1, %2":"=v"(r):"v"(a),"v"(b));return r;}
typedef float f32x2_t __attribute__((ext_vector_type(2))); typedef __bf16 bf16x2_t __attribute__((ext_vector_type(2)));
__device__ __forceinline__ unsigned cvtpk_s(float lo,float hi){f32x2_t v={lo,hi};bf16x2_t b=__builtin_convertvector(v,bf16x2_t);return __builtin_bit_cast(unsigned,b);}
#define WAIT_BAR(N) asm volatile("s_waitcnt vmcnt(" #N ") lgkmcnt(0)\n\ts_barrier":::"memory")

__device__ __forceinline__ void qkt(f32x16&p0,f32x16&p1,const char*Kslot,const bf16x8*qr,const f32x16&negm,int r32,int hi){
  const char*kb=Kslot+hi*1024+r32*16;
  #pragma unroll
  for(int d0=0;d0<4;++d0){
    const bf16x8 b0=*reinterpret_cast<const bf16x8*>(kb+d0*2048);
    const bf16x8 b1=*reinterpret_cast<const bf16x8*>(kb+d0*2048+512);
    if(d0==0){p0=__builtin_amdgcn_mfma_f32_32x32x16_bf16(b0,qr[0],negm,0,0,0);p1=__builtin_amdgcn_mfma_f32_32x32x16_bf16(b1,qr[0],negm,0,0,0);}
    else{p0=__builtin_amdgcn_mfma_f32_32x32x16_bf16(b0,qr[d0],p0,0,0,0);p1=__builtin_amdgcn_mfma_f32_32x32x16_bf16(b1,qr[d0],p1,0,0,0);}}
}
typedef __attribute__((address_space(3))) const char* lds_cptr;
typedef short v4i16_t __attribute__((ext_vector_type(4)));
__device__ __forceinline__ void kload8(bf16x8*kf,lds_cptr kp){
  kf[0]=*(const __attribute__((address_space(3))) bf16x8*)(kp);      kf[1]=*(const __attribute__((address_space(3))) bf16x8*)(kp+512);
  kf[2]=*(const __attribute__((address_space(3))) bf16x8*)(kp+2048); kf[3]=*(const __attribute__((address_space(3))) bf16x8*)(kp+2560);
  kf[4]=*(const __attribute__((address_space(3))) bf16x8*)(kp+4096); kf[5]=*(const __attribute__((address_space(3))) bf16x8*)(kp+4608);
  kf[6]=*(const __attribute__((address_space(3))) bf16x8*)(kp+6144); kf[7]=*(const __attribute__((address_space(3))) bf16x8*)(kp+6656);
}
__device__ __forceinline__ void kload4(bf16x8*kf,lds_cptr kp){
  kf[0]=*(const __attribute__((address_space(3))) bf16x8*)(kp);      kf[1]=*(const __attribute__((address_space(3))) bf16x8*)(kp+512);
  kf[2]=*(const __attribute__((address_space(3))) bf16x8*)(kp+2048); kf[3]=*(const __attribute__((address_space(3))) bf16x8*)(kp+2560);
}
__device__ __forceinline__ void qkt_h(f32x16&p0,f32x16&p1,const char*Kslot,const bf16x8*qr,const f32x16&negm,int r32,int hi){
  const char*kb=Kslot+hi*1024+r32*16;
  #pragma unroll
  for(int d0=0;d0<2;++d0){
    const bf16x8 b0=*reinterpret_cast<const bf16x8*>(kb+d0*2048);
    const bf16x8 b1=*reinterpret_cast<const bf16x8*>(kb+d0*2048+512);
    if(d0==0){p0=__builtin_amdgcn_mfma_f32_32x32x16_bf16(b0,qr[0],negm,0,0,0);p1=__builtin_amdgcn_mfma_f32_32x32x16_bf16(b1,qr[0],negm,0,0,0);}
    else{p0=__builtin_amdgcn_mfma_f32_32x32x16_bf16(b0,qr[d0],p0,0,0,0);p1=__builtin_amdgcn_mfma_f32_32x32x16_bf16(b1,qr[d0],p1,0,0,0);}}
}
__device__ __forceinline__ void kload2(bf16x8*kf,lds_cptr kp,int j){ kf[2*j]=*(const __attribute__((address_space(3))) bf16x8*)(kp+j*2048); kf[2*j+1]=*(const __attribute__((address_space(3))) bf16x8*)(kp+j*2048+512); }
__device__ __forceinline__ s16x4 vtr(lds_cptr p){ return __builtin_bit_cast(s16x4,__builtin_amdgcn_ds_read_tr16_b64_v4i16((__attribute__((address_space(3))) v4i16_t*)p)); }
__device__ __forceinline__ float rowmax(const f32x16&p0,const f32x16&p1){
  float a=max3f(p0[0],p0[1],p1[0]),b=max3f(p0[2],p0[3],p1[1]);a=max3f(a,p1[2],p1[3]);
  #pragma unroll
  for(int r=4;r<16;r+=4){a=max3f(a,p0[r],p0[r+1]);b=max3f(b,p0[r+2],p0[r+3]);a=max3f(a,p1[r],p1[r+1]);b=max3f(b,p1[r+2],p1[r+3]);}
  const float m=max2f(a,b);
  auto rr=__builtin_amdgcn_permlane32_swap(__float_as_uint(m),__float_as_uint(m),false,false);
  return max2f(__uint_as_float(rr[0]),__uint_as_float(rr[1]));
}
__device__ __forceinline__ void pv(f32x16*o,int vb,bf16x8 pa0,bf16x8 pa1,bf16x8 pa2,bf16x8 pa3){
  #pragma unroll
  for(int d0=0;d0<2;++d0){s16x4 lo[4],hi[4];
    #pragma unroll
    for(int ks=0;ks<4;++ks){
      asm volatile("ds_read_b64_tr_b16 %0,%1 offset:%c2":"=&v"(lo[ks]):"v"(vb),"i"(d0*4096+ks*1024):"memory");
      asm volatile("ds_read_b64_tr_b16 %0,%1 offset:%c2":"=&v"(hi[ks]):"v"(vb),"i"(d0*4096+ks*1024+512):"memory");}
    asm volatile("s_waitcnt lgkmcnt(0)":::"memory");SBAR();
    #define PK(k) (bf16x8){lo[k][0],lo[k][1],lo[k][2],lo[k][3],hi[k][0],hi[k][1],hi[k][2],hi[k][3]}
    o[d0]=__builtin_amdgcn_mfma_f32_32x32x16_bf16(pa0,PK(0),o[d0],0,0,0);
    o[d0]=__builtin_amdgcn_mfma_f32_32x32x16_bf16(pa1,PK(1),o[d0],0,0,0);
    o[d0]=__builtin_amdgcn_mfma_f32_32x32x16_bf16(pa2,PK(2),o[d0],0,0,0);
    o[d0]=__builtin_amdgcn_mfma_f32_32x32x16_bf16(pa3,PK(3),o[d0],0,0,0);
    #undef PK
  }
}

#ifndef ATTN_STORE16
#define ATTN_STORE16(p,v) (*(u32x4*)(p)=(v))
#endif

struct AttnParams {
  const bf16* Q;
  const bf16* K;
  const bf16* V;
  bf16* O;
  const float* gsub;
  int NT;
  int base_a, base_b;
  int mask;
  int dq0;
  int nomax; float mfix;
  int khalf;
  int mode;
  float sinkl2;
  float lam;
  float oscale;
};
constexpr int QP=1280, KP=64, OP=1024;
__device__ __forceinline__ void wmask(f32x16&p0,f32x16&p1,int dq,int hi){
  const float NEG=-INFINITY;
  #pragma unroll
  for(int r=0;r<16;++r){int d0=dq-((r&3)+8*(r>>2)+4*hi); if((unsigned)(d0+128)>256u)p0[r]=NEG; if((unsigned)(d0+96)>256u)p1[r]=NEG;}
}
template<int THRL,bool BH> __device__ __forceinline__ void attn_unit(const AttnParams&P,char*shm){
  int tid_=threadIdx.x; asm volatile("":"+v"(tid_));
  const int tid=tid_,lane=tid&63,r32=lane&31,hi=lane>>5; const int wid=__builtin_amdgcn_readfirstlane(tid>>6);
  const int NT=P.NT,base_a=P.base_a,base_b=P.base_b; const bool msk=P.mask!=0; const bool nomx=P.nomax!=0; const float mfix=P.mfix;
  if(wid>=4)__builtin_amdgcn_s_setprio(1);
  volatile unsigned*pblk=(volatile unsigned*)(shm+LDS_BYTES)+wid*8;
  if(lane==0){ const unsigned long long po=(unsigned long long)P.O,pg=(unsigned long long)P.gsub; pblk[0]=(unsigned)po;pblk[1]=(unsigned)(po>>32);pblk[2]=(unsigned)pg;pblk[3]=(unsigned)(pg>>32);
    pblk[4]=__float_as_uint(P.lam);pblk[5]=__float_as_uint(P.oscale);pblk[6]=__float_as_uint(P.sinkl2);pblk[7]=(unsigned)P.mode; }
  const bf16*Kh=P.K,*Vh=P.V;
  const unsigned lds0=(unsigned)(uintptr_t)shm;
  float*wsf=(float*)(shm+LDS_WS)+wid*64;
  const bf16*ksrc=Kh+(long)lane*KP+wid*8;
  const bf16*vsrc=Vh+(long)(16*(wid&3)+(lane>>2))*KP+(wid>>2)*32+(lane&3)*8;
  const unsigned kdst=lds0+LDS_K+wid*1024, vdst=lds0+LDS_V+wid*1024;
  #define TROW(t) (((t)<4)?(base_a+64*(t)):(base_b+64*((t)-4)))
  #define DMA_K(t,slot) glds16(ksrc+(long)TROW(t)*KP,(unsigned)__builtin_amdgcn_readfirstlane(kdst+(slot)))
  #define DMA_V(t,slot) glds16(vsrc+(long)TROW(t)*KP,(unsigned)__builtin_amdgcn_readfirstlane(vdst+(slot)))
  const int vb0=(int)(lds0+LDS_V)+((lane>>4)&1)*32+(lane&3)*8+(4*hi+((lane&15)>>2))*64;
  const char*Kbase=shm+LDS_K; bf16x8 kf[8];
  const lds_cptr shm3=(lds_cptr)shm; const lds_cptr kp0=shm3+LDS_K+hi*1024+r32*16; const lds_cptr vp0=shm3+LDS_V+((lane>>4)&1)*32+(lane&3)*8+(4*hi+((lane&15)>>2))*64;
  const bf16*Qw=P.Q+(long)(wid*QBLK)*QP; const int kbo=BH?P.khalf*4096:0, qoff=BH?P.khalf*32:0;
  DMA_K(0,0);DMA_V(0,0);DMA_K(1,SLOTB);
  bf16x8 qr[4];
  #pragma unroll
  for(int d0=0;d0<(BH?2:4);++d0)qr[d0]=*reinterpret_cast<const bf16x8*>(&Qw[(long)r32*QP+qoff+d0*16+hi*8]);
  float mhat=0.f,l_reg=0.f;f32x16 o[2];o[0]=f32x16{};o[1]=f32x16{};f32x16 negm=f32x16{};asm volatile("":"+v"(negm));
  const int dqb=P.dq0+wid*QBLK+r32;
  #define CMASK(P0,P1,t) do{ if(msk&&(t)>=4)wmask(P0,P1,dqb-64*((t)-4),hi); }while(0)
  bool resc=false;
  #define START(P0,P1) do{ float rm=mfix; if(!nomx)rm=rowmax(P0,P1); resc=false; \
    { const float dl=rm; mhat=fadd_s(mhat,dl); \
      _Pragma("unroll") for(int r=0;r<16;++r){P0[r]=fsub_s(P0[r],dl);P1[r]=fsub_s(P1[r],dl);} \
      _Pragma("unroll") for(int r=0;r<16;++r)negm[r]=-mhat; asm volatile("":"+v"(negm)); } \
    _Pragma("unroll") for(int r=0;r<16;++r)P0[r]=__builtin_amdgcn_exp2f(P0[r]); }while(0)
  #define RESC() do{ if(resc){ asm volatile("s_waitcnt lgkmcnt(0)":::"memory"); \
      _Pragma("unroll") for(int d_=0;d_<2;++d_) _Pragma("unroll") for(int r=0;r<16;++r)o[d_][r]*=wsf[crow(r,hi)]; } }while(0)
  f32x16 pA0,pA1,pB0,pB1;
  int sl_prev=0,sl_cur=0,sl_next=SLOTB;
  #define ROT() do{sl_prev=sl_cur;sl_cur=sl_next;sl_next=(sl_next==(NSLOT-1)*SLOTB)?0:sl_next+SLOTB;}while(0)
  DMA_K(2,2*SLOTB);
  WAIT_BAR(3);
  if(BH)qkt_h(pA0,pA1,Kbase+kbo,qr,negm,r32,hi); else qkt(pA0,pA1,Kbase,qr,negm,r32,hi);
  asm volatile("s_nop 15\n\ts_nop 7":"+v"(pA0),"+v"(pA1));CMASK(pA0,pA1,0);
  START(pA0,pA1);
  _Pragma("unroll") for(int r=0;r<16;++r)pA1[r]=__builtin_amdgcn_exp2f(pA1[r]);
  WAIT_BAR(0);
  DMA_K(3,0);DMA_V(1,SLOTB);
  ROT();
  if(BH)kload4(kf,kp0+sl_cur+kbo); else kload8(kf,kp0+sl_cur);
  WAIT_BAR(2);
  s16x4 vlo[8],vhi[8]; u32x4 pw0,pw1,pw2,pw3;
  #define PKW(P,B) cvtpk_s(P[B],P[B+1])
  #define PAF(k) __builtin_bit_cast(bf16x8,pw##k)
  #define VFR(i) (bf16x8){vlo[i][0],vlo[i][1],vlo[i][2],vlo[i][3],vhi[i][0],vhi[i][1],vhi[i][2],vhi[i][3]}
  #define PIN(x) asm volatile("":"+v"(x))
  #define MX3(a,b,c) __builtin_fmaxf(__builtin_fmaxf((a),(b)),(c))
  #define QKS(NRM,HLF) do{ if(BH){ HLF; } else { NRM; } }while(0)
  #define GAPA(MF,A0,A1,A2,A3,W0,W1,PW) do{ MF; sacc+=A0; sacc+=A1; sacc+=A2; sacc+=A3; PIN(sacc); W0; W1; PIN(PW); SBAR(); }while(0)
  #define EX(v) __builtin_amdgcn_exp2f(v)
  #define GAPB(MF,X,B) do{ MF; X[B]=EX(X[B]); X[B+1]=EX(X[B+1]); X[B+2]=EX(X[B+2]); X[B+3]=EX(X[B+3]); PIN(X); SBAR(); }while(0)
  #define VRD(i) do{ vlo[i]=vtr(vp_+(((i)>>2)*4096+((i)&3)*1024)); vhi[i]=vtr(vp_+(((i)>>2)*4096+((i)&3)*1024+512)); }while(0)
  #define KRD(G,j) do{ if(G){ if(!BH){ kload2(kf,kp0+sl_next,j); SBAR(); } else if((j)<2){ kload2(kf,kp0+sl_next+kbo,j); SBAR(); } } }while(0)
  #define STEP(C0,C1,P0,P1,t,GK,GV,GL) do{ SBAR(); \
    const lds_cptr vp_=vp0+sl_prev; \
    VRD(0); SBAR(); float sacc=(P0[0]+P0[1]); \
    GAPA(QKS(C0=__builtin_amdgcn_mfma_f32_32x32x16_bf16(kf[0],qr[0],negm,0,0,0), C0=__builtin_amdgcn_mfma_f32_32x32x16_bf16(kf[0],qr[0],negm,0,0,0)), P0[2],P0[3],P0[4],P0[5],     pw0[0]=PKW(P0,0), pw0[1]=PKW(P0,2), pw0); \
    VRD(4); SBAR(); GAPA(QKS(C1=__builtin_amdgcn_mfma_f32_32x32x16_bf16(kf[1],qr[0],negm,0,0,0), (void)0), P0[6],P0[7],P0[8],P0[9],     pw0[2]=PKW(P0,4), pw0[3]=PKW(P0,6), pw0); \
    VRD(1); SBAR(); GAPA(QKS(C0=__builtin_amdgcn_mfma_f32_32x32x16_bf16(kf[2],qr[1],C0,0,0,0), C1=__builtin_amdgcn_mfma_f32_32x32x16_bf16(kf[1],qr[0],negm,0,0,0)),   P0[10],P0[11],P0[12],P0[13], pw1[0]=PKW(P0,8), pw1[1]=PKW(P0,10), pw1); \
    VRD(5); SBAR(); GAPA(QKS(C1=__builtin_amdgcn_mfma_f32_32x32x16_bf16(kf[3],qr[1],C1,0,0,0), (void)0),   P0[14],P0[15],P1[0],P1[1],   pw1[2]=PKW(P0,12),pw1[3]=PKW(P0,14), pw1); \
    VRD(2); SBAR(); GAPA(QKS(C0=__builtin_amdgcn_mfma_f32_32x32x16_bf16(kf[4],qr[2],C0,0,0,0), C0=__builtin_amdgcn_mfma_f32_32x32x16_bf16(kf[2],qr[1],C0,0,0,0)),   P1[2],P1[3],P1[4],P1[5],     pw2[0]=PKW(P1,0), pw2[1]=PKW(P1,2), pw2); \
    VRD(6); SBAR(); GAPA(QKS(C1=__builtin_amdgcn_mfma_f32_32x32x16_bf16(kf[5],qr[2],C1,0,0,0), (void)0),   P1[6],P1[7],P1[8],P1[9],     pw2[2]=PKW(P1,4), pw2[3]=PKW(P1,6), pw2); \
    VRD(3); SBAR(); GAPA(QKS(C0=__builtin_amdgcn_mfma_f32_32x32x16_bf16(kf[6],qr[3],C0,0,0,0), C1=__builtin_amdgcn_mfma_f32_32x32x16_bf16(kf[3],qr[1],C1,0,0,0)),   P1[10],P1[11],P1[12],P1[13], pw3[0]=PKW(P1,8), pw3[1]=PKW(P1,10), pw3); \
    VRD(7); SBAR(); GAPA(QKS(C1=__builtin_amdgcn_mfma_f32_32x32x16_bf16(kf[7],qr[3],C1,0,0,0), (void)0),   P1[14],P1[15],0.f,0.f,       pw3[2]=PKW(P1,12),pw3[3]=PKW(P1,14), pw3); \
    l_reg+=sacc; \
    if(GK){DMA_K((t)+3,sl_cur);} if(GV){DMA_V((t)+1,sl_next);} \
    CMASK(C0,C1,t); \
    resc=false; \
    if(!nomx){ float a=MX3(C0[0],C0[1],C1[0]),b=MX3(C0[2],C0[3],C1[1]); a=MX3(a,C1[2],C1[3]); \
      _Pragma("unroll") for(int r=4;r<16;r+=4){a=MX3(a,C0[r],C0[r+1]);b=MX3(b,C0[r+2],C0[r+3]);a=MX3(a,C1[r],C1[r+1]);b=MX3(b,C1[r+2],C1[r+3]);} \
      float rm=__builtin_fmaxf(a,b); { auto rr=__builtin_amdgcn_permlane32_swap(__float_as_uint(rm),__float_as_uint(rm),false,false); rm=__builtin_fmaxf(__uint_as_float(rr[0]),__uint_as_float(rr[1])); } \
      resc=false; \
      if(__builtin_expect(__any(rm>(float)THRL),0)){ const float dl=__builtin_fmaxf(rm,0.f); mhat+=dl; \
        _Pragma("unroll") for(int r=0;r<16;++r){C0[r]-=dl;C1[r]-=dl;} \
        _Pragma("unroll") for(int r=0;r<16;++r)negm[r]=-mhat; asm volatile("":"+v"(negm)); \
        const float f=__builtin_amdgcn_exp2f(-dl); l_reg*=f; if(hi==0)wsf[r32]=f; resc=true; } } \
    SBAR(); \
    GAPB(o[0]=__builtin_amdgcn_mfma_f32_32x32x16_bf16(PAF(0),VFR(0),o[0],0,0,0), C0,0); \
    GAPB(o[1]=__builtin_amdgcn_mfma_f32_32x32x16_bf16(PAF(0),VFR(4),o[1],0,0,0), C0,4); \
    KRD(GL,0); GAPB(o[0]=__builtin_amdgcn_mfma_f32_32x32x16_bf16(PAF(1),VFR(1),o[0],0,0,0), C0,8); \
    KRD(GL,1); GAPB(o[1]=__builtin_amdgcn_mfma_f32_32x32x16_bf16(PAF(1),VFR(5),o[1],0,0,0), C0,12); \
    KRD(GL,2); GAPB(o[0]=__builtin_amdgcn_mfma_f32_32x32x16_bf16(PAF(2),VFR(2),o[0],0,0,0), C1,0); \
    KRD(GL,3); GAPB(o[1]=__builtin_amdgcn_mfma_f32_32x32x16_bf16(PAF(2),VFR(6),o[1],0,0,0), C1,4); \
    GAPB(o[0]=__builtin_amdgcn_mfma_f32_32x32x16_bf16(PAF(3),VFR(3),o[0],0,0,0), C1,8); \
    GAPB(o[1]=__builtin_amdgcn_mfma_f32_32x32x16_bf16(PAF(3),VFR(7),o[1],0,0,0), C1,12); \
    }while(0)
  int t=1;
  #undef CMASK
  #define CMASK(P0,P1,t) do{}while(0)
  for(;!msk&&t+5<NT;t+=2){
    STEP(pB0,pB1,pA0,pA1,t,true,true,true);     WAIT_BAR(2); RESC(); ROT();
    STEP(pA0,pA1,pB0,pB1,t+1,true,true,true);   WAIT_BAR(2); RESC(); ROT();
  }
  #undef CMASK
  #define CMASK(P0,P1,t) do{ if(msk&&(t)>=4)wmask(P0,P1,dqb-64*((t)-4),hi); }while(0)
  #define ENDW(tt) do{ if((tt)+3<NT){WAIT_BAR(2);} else if((tt)+2<NT){WAIT_BAR(1);} else {WAIT_BAR(0);} }while(0)
  for(;t+1<NT;t+=2){
    STEP(pB0,pB1,pA0,pA1,t,(t+3<NT),(t+1<NT),(t+1<NT));       ENDW(t);   RESC(); ROT();
    STEP(pA0,pA1,pB0,pB1,t+1,(t+4<NT),(t+2<NT),(t+2<NT));     ENDW(t+1); RESC(); ROT();
  }
  STEP(pB0,pB1,pA0,pA1,NT-1,false,false,false); RESC();
  { float sacc=pB0[0]+pB0[1]; _Pragma("unroll") for(int r=2;r<16;++r)sacc+=pB0[r]; _Pragma("unroll") for(int r=0;r<16;++r)sacc+=pB1[r]; l_reg+=sacc;
    pw0=(u32x4){PKW(pB0,0),PKW(pB0,2),PKW(pB0,4),PKW(pB0,6)};pw1=(u32x4){PKW(pB0,8),PKW(pB0,10),PKW(pB0,12),PKW(pB0,14)};pw2=(u32x4){PKW(pB1,0),PKW(pB1,2),PKW(pB1,4),PKW(pB1,6)};pw3=(u32x4){PKW(pB1,8),PKW(pB1,10),PKW(pB1,12),PKW(pB1,14)};
    SBAR(); pv(o,vb0+sl_cur,PAF(0),PAF(1),PAF(2),PAF(3)); }
  #undef PKW
  #undef PAF
  #undef VFR
  #undef PIN
  #undef MX3
  #undef GAPA
  #undef QKS
  #undef GAPB
  #undef EX
  #undef VRD
  #undef KRD
  #undef STEP
  #undef ENDW
  {auto rr=__builtin_amdgcn_permlane32_swap(__float_as_uint(l_reg),__float_as_uint(l_reg),false,false);l_reg=__uint_as_float(rr[0])+__uint_as_float(rr[1]);}
  asm volatile("s_waitcnt lgkmcnt(0)":::"memory");
  const unsigned e0=__builtin_amdgcn_readfirstlane(pblk[0]),e1=__builtin_amdgcn_readfirstlane(pblk[1]),e2=__builtin_amdgcn_readfirstlane(pblk[2]),e3=__builtin_amdgcn_readfirstlane(pblk[3]);
  const float e_lam=__uint_as_float(__builtin_amdgcn_readfirstlane(pblk[4])),e_osc=__uint_as_float(__builtin_amdgcn_readfirstlane(pblk[5])),e_sink=__uint_as_float(__builtin_amdgcn_readfirstlane(pblk[6]));
  const int e_mode=(int)__builtin_amdgcn_readfirstlane(pblk[7]);
  bf16*const e_O=(bf16*)(((unsigned long long)e1<<32)|e0); const float*const e_gsub=(const float*)(((unsigned long long)e3<<32)|e2);
  l_reg+=__builtin_amdgcn_exp2f(e_sink-mhat);
  if(hi==0)wsf[32+r32]=l_reg;asm volatile("s_waitcnt lgkmcnt(0)":::"memory");
  float rli[16];
  #pragma unroll
  for(int r=0;r<16;++r)rli[r]=__builtin_amdgcn_rcpf(wsf[32+crow(r,hi)]);
  bf16*Ow=e_O+(long)(wid*QBLK)*OP;
  if(e_mode==0){ bf16*stg=(bf16*)(shm+LDS_OST)+wid*4096;
    #pragma unroll
    for(int r=0;r<16;++r){const int orow=crow(r,hi);
      #pragma unroll
      for(int d0=0;d0<2;++d0)stg[orow*64+d0*32+r32]=__float2bfloat16(o[d0][r]*rli[r]);}
    asm volatile("s_waitcnt lgkmcnt(0)":::"memory");
    #pragma unroll
    for(int i=0;i<4;++i){const int row=i*8+(lane>>3),ch=lane&7; const u32x4 v=*(const u32x4*)(stg+row*64+ch*8); ATTN_STORE16(Ow+(long)row*OP+ch*8,v);} }
  else { float*stg=(float*)(shm+LDS_OST)+wid*2048;
    if(e_mode==1){
      #pragma unroll
      for(int r=0;r<16;++r){const int orow=crow(r,hi);
        #pragma unroll
        for(int d0=0;d0<2;++d0)stg[orow*64+d0*32+r32]=o[d0][r]*rli[r];}
      asm volatile("s_waitcnt lgkmcnt(0)":::"memory");
    } else {
      #pragma unroll
      for(int r=0;r<16;++r){const int orow=crow(r,hi);
        #pragma unroll
        for(int d0=0;d0<2;++d0){const int ix=orow*64+d0*32+r32; stg[ix]=stg[ix]-e_lam*(o[d0][r]*rli[r]);}}
      asm volatile("s_waitcnt lgkmcnt(0)":::"memory");
      int ln=lane; asm volatile("":"+v"(ln));
      const int ch=ln&15; const f32x4v gs=*(const f32x4v*)(e_gsub+ch*4);
      const int bp1=(ln^1)<<2,bp2=(ln^2)<<2,bp4=(ln^4)<<2,bp8=(ln^8)<<2;
      #pragma unroll
      for(int i=0;i<8;++i){const int row=i*4+(ln>>4); const f32x4v v=*(const f32x4v*)(stg+row*64+ch*4);
        float ss=(v[0]*v[0]+v[1]*v[1])+(v[2]*v[2]+v[3]*v[3]);
        ss+=__builtin_bit_cast(float,__builtin_amdgcn_ds_bpermute(bp1,__builtin_bit_cast(int,ss)));ss+=__builtin_bit_cast(float,__builtin_amdgcn_ds_bpermute(bp2,__builtin_bit_cast(int,ss)));
        ss+=__builtin_bit_cast(float,__builtin_amdgcn_ds_bpermute(bp4,__builtin_bit_cast(int,ss)));ss+=__builtin_bit_cast(float,__builtin_amdgcn_ds_bpermute(bp8,__builtin_bit_cast(int,ss)));
        const float rn=e_osc*__builtin_amdgcn_rsqf(ss*(1.0f/64.0f)+1e-6f);
        u32x2v w; w[0]=cvtpk_s(v[0]*rn*gs[0],v[1]*rn*gs[1]); w[1]=cvtpk_s(v[2]*rn*gs[2],v[3]*rn*gs[3]);
        *(u32x2v*)(Ow+(long)row*OP+ch*4)=w;}
    }
  }
  __builtin_amdgcn_s_setprio(0);
  asm volatile("s_waitcnt lgkmcnt(0)\n\ts_barrier":::"memory");
  #undef TROW
  #undef DMA_K
  #undef DMA_V
  #undef CMASK
  #undef START
  #undef RESC
  #undef ROT
}

constexpr int ATTN_LDS_BYTES=LDS_BYTES;
#undef SBAR
#undef WAIT_BAR
}
namespace cg = cooperative_groups;
#define GAS __attribute__((address_space(1)))
#define LAS __attribute__((address_space(3)))
typedef unsigned short bf16;
typedef unsigned v4u __attribute__((ext_vector_type(4)));
typedef unsigned v2u __attribute__((ext_vector_type(2)));
typedef float f32x4 __attribute__((ext_vector_type(4)));
constexpr int NWAVES = 8;
constexpr int SEQ = 16384, CTXL = 256, TPB = SEQ + CTXL, NBATCH = 2, MROWS = NBATCH * TPB, D = 1024, NIN = 2048, FF = 2816, NUP = 2 * FF;
constexpr float LOG2E = 1.4426950408889634f;
constexpr float C2A = 0.125f * LOG2E, C2B = 0.17677669529663687f * LOG2E;
constexpr size_t MiB = 1u << 20;
constexpr size_t WS_MOD = 1 * MiB;
constexpr size_t WS_ROPE = WS_MOD + 512 * 1024;
constexpr size_t WS_WIN = 2 * MiB, WS_WOUT = 10 * MiB, WS_WUP = 14 * MiB, WS_WDN = 36 * MiB;
constexpr size_t WS_XRES = 48 * MiB;
constexpr size_t WS_XN = 178 * MiB;
constexpr size_t WS_Q = 244 * MiB, WS_K = 326 * MiB, WS_V = 359 * MiB, WS_O = 392 * MiB;
constexpr size_t WS_U = 244 * MiB;
constexpr size_t WS_END = 458 * MiB;
static_assert(WS_Q + (size_t)MROWS * 1280 * 2 <= WS_K && WS_K + (size_t)MROWS * 512 * 2 <= WS_V && WS_V + (size_t)MROWS * 512 * 2 <= WS_O && WS_O + (size_t)MROWS * 1024 * 2 <= WS_END, "ws map");
static_assert(WS_U + (size_t)MROWS * FF * 2 <= WS_END && WS_XN + (size_t)MROWS * D * 2 <= WS_Q && WS_XRES + (size_t)MROWS * D * 4 <= WS_XN, "ws map 2");
constexpr int LDS_BYTES = 147456;
#ifndef ABL_ZERO_C
#define ABL_ZERO_C 0
#endif

__device__ __forceinline__ unsigned f2bf(float f) { unsigned u = __builtin_bit_cast(unsigned, f); return (u + 0x7fffu + ((u >> 16) & 1u)) >> 16; }
__device__ __forceinline__ unsigned pk2(float lo, float hi) { return f2bf(lo) | (f2bf(hi) << 16); }
__device__ __forceinline__ float wave_sum_l(float v, int lane) {
#pragma unroll
    for (int o = 1; o < 64; o <<= 1) v += __int_as_float(__builtin_amdgcn_ds_bpermute((lane ^ o) << 2, __float_as_int(v)));
    return v;
}
__device__ __forceinline__ float wave_sum(float v) {
#pragma unroll
    for (int o = 1; o < 64; o <<= 1) v += __shfl_xor(v, o);
    return v;
}
__device__ __forceinline__ void tr_item(const float* W, int ldw, int k0, int ncol0, bf16* WT, int Kt, int prow0, LAS float* scr, int lane) {
#pragma unroll 8
    for (int i = 0; i < 32; ++i) { const int kk = 2 * i + (lane >> 5); scr[kk * 33 + (lane & 31)] = W[(size_t)(k0 + kk) * ldw + ncol0 + (lane & 31)]; }
    asm volatile("s_waitcnt lgkmcnt(0)" ::: "memory");
    const int c = lane & 7;
#pragma unroll
    for (int j = 0; j < 4; ++j) { const int n = (lane >> 3) + 8 * j; const LAS float* s = scr + (8 * c) * 33 + n;
        v4u o; o.x = pk2(s[0 * 33], s[1 * 33]); o.y = pk2(s[2 * 33], s[3 * 33]); o.z = pk2(s[4 * 33], s[5 * 33]); o.w = pk2(s[6 * 33], s[7 * 33]);
        *(v4u*)(WT + (size_t)(prow0 + n) * Kt + k0 + 8 * c) = o; }
    asm volatile("s_waitcnt lgkmcnt(0)" ::: "memory");
}


template <int KIND> __device__ __forceinline__ void norm_rows(int gw, int NGW, int lane, const float* xin, const float* cin, float* xres, bf16* xn, float* outp, const float* gvec, const float* modr, int sidx) {
    const int nrows = KIND == 2 ? NBATCH * SEQ : MROWS;
    for (int m0 = gw; m0 < nrows; m0 += 2 * NGW) {
        int mm[2]; mm[0] = m0; mm[1] = (m0 + NGW < nrows) ? m0 + NGW : m0;
        f32x4 v[2][4]; float ss[2]; int rr[2]; size_t xrow[2];
#pragma unroll
        for (int u = 0; u < 2; ++u) {
            const int m = mm[u];
            const float* src;
            if (KIND == 2) { const int b = m >= SEQ ? 1 : 0, t = m - b * SEQ; xrow[u] = (size_t)b * TPB + t; rr[u] = b; src = xres + xrow[u] * D; }
            else { const int b = m >= TPB ? 1 : 0, t = m - b * TPB; rr[u] = t >= SEQ ? 2 : b; xrow[u] = (size_t)m;
                   src = KIND == 0 ? (t < SEQ ? xin + ((size_t)b * SEQ + t) * D : cin + ((size_t)b * CTXL + (t - SEQ)) * D) : xres + (size_t)m * D; }
            const f32x4* xr = (const f32x4*)src + lane; float s = 0.f;
#pragma unroll
            for (int j = 0; j < 4; ++j) { v[u][j] = xr[64 * j]; s += (v[u][j][0] * v[u][j][0] + v[u][j][1] * v[u][j][1]) + (v[u][j][2] * v[u][j][2] + v[u][j][3] * v[u][j][3]); }
            ss[u] = s;
        }
#pragma unroll
        for (int u = 0; u < 2; ++u) {
            const float rn = 1.0f / sqrtf(wave_sum_l(ss[u], lane) * (1.0f / D) + 1e-6f);
            if (KIND == 2) { f32x4* o = (f32x4*)(outp + (size_t)mm[u] * D) + lane;
#pragma unroll
                for (int j = 0; j < 4; ++j) { const int col = 4 * (lane + 64 * j); const f32x4 g4 = *(const f32x4*)(gvec + col); o[64 * j] = v[u][j] * rn * g4; } }
            else { const float* sh = modr + rr[u] * 6144 + sidx * 1024; const float* sc = sh + 1024; v2u* o8 = (v2u*)(xn + xrow[u] * D) + lane;
#pragma unroll
                for (int j = 0; j < 4; ++j) { const int col = 4 * (lane + 64 * j); const f32x4 g4 = *(const f32x4*)(gvec + col), s4 = *(const f32x4*)(sh + col), c4 = *(const f32x4*)(sc + col);
                    const f32x4 y = (v[u][j] * rn * g4) * (c4 + 1.0f) + s4; v2u w; w.x = pg8::pk_bf16(y[0], y[1]); w.y = pg8::pk_bf16(y[2], y[3]); o8[64 * j] = w; } }
        }
    }
}

#ifndef SELFCHECK
#define SELFCHECK 0
#endif
__device__ __forceinline__ float bf2f(unsigned short x) { return __uint_as_float((unsigned)x << 16); }
__device__ __forceinline__ float wave_max(float v) {
#pragma unroll
    for (int o = 1; o < 64; o <<= 1) v = fmaxf(v, __shfl_xor(v, o));
    return v;
}
__device__ __forceinline__ float naive_row(const bf16* Qrow, const bf16* Kb, const bf16* Vb, int kind, int t, float sinkl2, int lane, LAS float* xch) {
    float q[64]; asm volatile("" : "+v"(Qrow));
#pragma unroll
    for (int c = 0; c < 8; ++c) { const v4u w = *(const v4u*)(Qrow + 8 * c);
#pragma unroll
        for (int e = 0; e < 4; ++e) { q[8 * c + 2 * e] = __uint_as_float(w[e] << 16); q[8 * c + 2 * e + 1] = __uint_as_float(w[e] & 0xffff0000u); } }
    int lo = 0, nb = 0, n;
    if (kind == 0) n = TPB; else if (kind == 1) n = CTXL; else { lo = t - 128 < 0 ? 0 : t - 128; const int hi = t + 128 > SEQ - 1 ? SEQ - 1 : t + 128; nb = hi - lo + 1; n = nb + CTXL; }
    float m = -INFINITY, l = 0.f, o[64];
#pragma unroll
    for (int d = 0; d < 64; ++d) o[d] = 0.f;
    for (int j = lane; j < n; j += 64) {
        const int row = kind == 0 ? j : (kind == 1 ? SEQ + j : (j < nb ? lo + j : SEQ + (j - nb)));
        float sc = 0.f;
#pragma unroll
        for (int c = 0; c < 8; ++c) { const v4u w = *(const v4u*)(Kb + (size_t)row * 512 + 8 * c);
#pragma unroll
            for (int e = 0; e < 4; ++e) { sc += q[8 * c + 2 * e] * __uint_as_float(w[e] << 16); sc += q[8 * c + 2 * e + 1] * __uint_as_float(w[e] & 0xffff0000u); } }
        if (sc > m) { const float f = __builtin_amdgcn_exp2f(m - sc); l *= f;
#pragma unroll
            for (int d = 0; d < 64; ++d) o[d] *= f;
            m = sc; }
        const float p = __builtin_amdgcn_exp2f(sc - m); l += p;
#pragma unroll
        for (int c = 0; c < 8; ++c) { const v4u w = *(const v4u*)(Vb + (size_t)row * 512 + 8 * c);
#pragma unroll
            for (int e = 0; e < 4; ++e) { o[8 * c + 2 * e] += p * __uint_as_float(w[e] << 16); o[8 * c + 2 * e + 1] += p * __uint_as_float(w[e] & 0xffff0000u); } }
    }
    const float M = wave_max(m); const float f = (m == -INFINITY) ? 0.f : __builtin_amdgcn_exp2f(m - M);
    float lt = wave_sum(l * f) + __builtin_amdgcn_exp2f(sinkl2 - M);
    const bool l0 = lane == 0;
#pragma unroll
    for (int d = 0; d < 64; ++d) { const float sd = wave_sum(o[d] * f); if (l0) xch[d] = sd; }
    asm volatile("s_waitcnt lgkmcnt(0)" ::: "memory"); const float od = xch[lane]; asm volatile("s_waitcnt lgkmcnt(0)" ::: "memory");
    return od / lt;
}

__device__ __forceinline__ void sincos_d(double a, float& sn, float& cs) {
    const double k = rint(a * 0.15915494309189535); const double r = a - k * 6.283185307179586476925;
    const double r2 = r * r; double ts = r, tc = 1.0, ss = r, cc = 1.0;
#pragma unroll 1
    for (int i = 1; i < 16; ++i) { tc = -tc * r2 / (double)((2 * i - 1) * (2 * i)); ts = -ts * r2 / (double)((2 * i) * (2 * i + 1)); cc += tc; ss += ts; }
    sn = (float)ss; cs = (float)cc;
}
#define XB_TMO      128
#define XB_XCNT(j)  (256  + 64 * (j))
#define XB_XSUB(j)  (1280 + 64 * (j))
#define XB_XGEN(j)  (2304 + 64 * (j))
#define XB_TOP      3328
#define XB_TOPGEN   3392
#define XCD_BAR_WORDS 3456
#define XB_SPIN_CAP (1u << 18)

__device__ __forceinline__ unsigned xb_ld(unsigned* p)              { return __hip_atomic_load(p, __ATOMIC_RELAXED, __HIP_MEMORY_SCOPE_AGENT); }
__device__ __forceinline__ unsigned xb_add(unsigned* p, unsigned v) { return __hip_atomic_fetch_add(p, v, __ATOMIC_RELAXED, __HIP_MEMORY_SCOPE_AGENT); }
__device__ __forceinline__ unsigned xb_xcc_id() { return (unsigned)__builtin_amdgcn_s_getreg((3 << 11) | 20) & 0xFu; }
#define XB_SPIN(cond, bar) do { unsigned _sp = 0; while (cond) { __builtin_amdgcn_s_sleep(1); \
    if ((++_sp & 255u) == 0u) { if (xb_ld(&(bar)[XB_TMO])) break; if (_sp > XB_SPIN_CAP) { atomicAdd(&(bar)[XB_TMO], 1u); break; } } } } while (0)

struct XcdBarrier {
    unsigned* bar; unsigned x;
    volatile LAS unsigned* st;
};

__device__ __forceinline__ XcdBarrier xcd_barrier_post(unsigned* bar, volatile LAS unsigned* st) {
    XcdBarrier b; b.bar = bar; b.x = xb_xcc_id(); b.st = st;
    if (threadIdx.x == 0) (void)xb_add(&bar[XB_XCNT(b.x)], 1u);
    return b;
}
__device__ __forceinline__ void xcd_barrier_complete(unsigned* bar, unsigned x, unsigned& nloc, unsigned& nx) {
    const unsigned G = gridDim.x * gridDim.y * gridDim.z;
    unsigned sum, cnt, mine, sp = 0u;
    for (;;) {
        sum = 0u; cnt = 0u; mine = 0u;
#pragma unroll
        for (unsigned j = 0; j < 16; ++j) { const unsigned c = xb_ld(&bar[XB_XCNT(j)]); sum += c; cnt += (c > 0u) ? 1u : 0u; mine = (j == x) ? c : mine; }
        if (sum == G) break;
        __builtin_amdgcn_s_sleep(1);
        if ((++sp & 255u) == 0u) { if (xb_ld(&bar[XB_TMO])) break; if (sp > XB_SPIN_CAP) { atomicAdd(&bar[XB_TMO], 1u); break; } }
    }
    nloc = mine > 0u ? mine : 1u; nx = cnt > 0u ? cnt : 1u;
}

__device__ __forceinline__ void xcd_barrier(const XcdBarrier& b) {
    asm volatile("s_waitcnt vmcnt(0)" ::: "memory");
    __syncthreads();
    if (threadIdx.x == 0) {
        unsigned* bar = b.bar;
        __builtin_amdgcn_s_waitcnt(0);
        unsigned nloc = b.st[0], nx = b.st[1];
        if (nloc == 0u) { xcd_barrier_complete(bar, b.x, nloc, nx); b.st[0] = nloc; b.st[1] = nx; }
        const unsigned old = xb_add(&bar[XB_XSUB(b.x)], 1u);
        const unsigned gen = old / nloc;
        if (old + 1u == (gen + 1u) * nloc) {
            __builtin_amdgcn_fence(__ATOMIC_RELEASE, "agent");
            asm volatile("s_waitcnt vmcnt(0)" ::: "memory");
            const unsigned og = xb_add(&bar[XB_TOP], 1u);
            const unsigned tg = og / nx;
            if (og + 1u == (tg + 1u) * nx) xb_add(&bar[XB_TOPGEN], 1u);
            else XB_SPIN(xb_ld(&bar[XB_TOPGEN]) == tg, bar);
            __builtin_amdgcn_fence(__ATOMIC_ACQUIRE, "agent");
            xb_add(&bar[XB_XGEN(b.x)], 1u);
            asm volatile("s_waitcnt vmcnt(0)" ::: "memory");
        } else {
            XB_SPIN(xb_ld(&bar[XB_XGEN(b.x)]) == gen, bar);
            __builtin_amdgcn_fence(__ATOMIC_ACQUIRE, "agent");
            asm volatile("s_waitcnt vmcnt(0)" ::: "memory");
        }
    }
    __syncthreads();
}
constexpr size_t WS_BAR = 65536;
constexpr int LDS_XB = LDS_BYTES - 64;
struct Args { const float* in[22]; float* out; unsigned char* ws; };
typedef const float* const __attribute__((address_space(4)))* kargp_t;
__device__ __forceinline__ const float* kin(int i) { kargp_t ka = (kargp_t)__builtin_amdgcn_kernarg_segment_ptr(); asm volatile("" : "+s"(ka)); return ka[i]; }
__device__ __forceinline__ unsigned char* kws() { return (unsigned char*)kin(23); }


#define x_in kin(0)
#define c_in kin(1)
#define ctx_in kin(2)
#define cctx_in kin(3)
#define w_ada kin(4)
#define b_ada kin(5)
#define g_attn kin(6)
#define g_ffn kin(7)
#define w_in kin(8)
#define g_q kin(9)
#define g_k kin(10)
#define lam_q1 kin(11)
#define lam_k1 kin(12)
#define lam_q2 kin(13)
#define lam_k2 kin(14)
#define g_subln kin(15)
#define sink_logit kin(16)
#define w_out kin(17)
#define w_ff1 kin(18)
#define w_ff3 kin(19)
#define w_ff2 kin(20)
#define g_final kin(21)
#define MOD ((float*)(kws() + WS_MOD))
#define NMAX ((unsigned*)(kws() + 8192))
#define cosA ((float*)(kws() + WS_ROPE))
#define sinA (cosA + 256 * 16)
#define cosB (cosA + 2 * 256 * 16)
#define sinB (cosA + 2 * 256 * 16 + 256 * 8)
#define WIN ((bf16*)(kws() + WS_WIN))
#define WOUT ((bf16*)(kws() + WS_WOUT))
#define WUP ((bf16*)(kws() + WS_WUP))
#define WDN ((bf16*)(kws() + WS_WDN))
#define XRES ((float*)(kws() + WS_XRES))
#define XN ((bf16*)(kws() + WS_XN))
#define bQ ((bf16*)(kws() + WS_Q))
#define bK ((bf16*)(kws() + WS_K))
#define bV ((bf16*)(kws() + WS_V))
#define bO ((bf16*)(kws() + WS_O))
#define bU ((bf16*)(kws() + WS_U))
__global__ void __launch_bounds__(NWAVES * 64, 2) mega_fwd(Args args) {
    extern __shared__ __attribute__((aligned(16))) unsigned char lds[];
    cg::grid_group grid = cg::this_grid();
#define CG_SYNC() do { asm volatile("s_waitcnt vmcnt(0) lgkmcnt(0)" ::: "memory"); grid.sync(); } while (0)
#define GRID_SYNC() do { XcdBarrier xb_; xb_.bar = (unsigned*)(kws() + WS_BAR); xb_.x = xb_xcc_id(); xb_.st = (volatile LAS unsigned*)((LAS unsigned char*)lds + LDS_XB); xcd_barrier(xb_); } while (0)
    if (threadIdx.x < 2) ((volatile LAS unsigned*)((LAS unsigned char*)lds + LDS_XB))[threadIdx.x] = 0u;
    __syncthreads();
    (void)xcd_barrier_post((unsigned*)(kws() + WS_BAR), (volatile LAS unsigned*)((LAS unsigned char*)lds + LDS_XB));
#define PHASE_IDS int tid = threadIdx.x, bx = blockIdx.x, G = gridDim.x; asm volatile("" : "+v"(tid)); bx = __builtin_amdgcn_readfirstlane(bx); G = __builtin_amdgcn_readfirstlane(G); \
    const int lane = tid & 63, wave = __builtin_amdgcn_readfirstlane(tid >> 6), vcu = (G % 8 == 0) ? (bx % 8) * (G / 8) + bx / 8 : bx, gw = vcu * NWAVES + wave, NGW = G * NWAVES; \
    (void)lane; (void)wave; (void)vcu; (void)gw; (void)NGW;
    {
        PHASE_IDS
        const int gt = gw * 64 + lane; float* const ca = cosA; float* const sa = sinA; float* const cb_ = cosB; float* const sb_ = sinB;
        if (gt < 256 * 16) { const int pos = gt >> 4, i = gt & 15; const float fr = __builtin_amdgcn_exp2f(-(float)i * (13.287712379549449f / 16.0f)); const float a = (float)pos * fr;
            const double rev = (double)a * 0.15915494309189535; const float f = (float)(rev - floor(rev)); ca[gt] = __builtin_amdgcn_cosf(f); sa[gt] = __builtin_amdgcn_sinf(f); }
        else if (gt < 256 * 16 + 256 * 8) { const int q = gt - 256 * 16; const int pos = q >> 3, i = q & 7; const float fr = __builtin_amdgcn_exp2f(-(float)i * (13.287712379549449f / 8.0f)); const float a = (float)pos * fr;
            const double rev = (double)a * 0.15915494309189535; const float f = (float)(rev - floor(rev)); cb_[q] = __builtin_amdgcn_cosf(f); sb_[q] = __builtin_amdgcn_sinf(f); }
        if (gt < 64) NMAX[gt] = 0u;
        LAS float* s_lds = (LAS float*)lds; LAS float* part = (LAS float*)(lds + 12288);
        if (bx < 192) {
            const float* const cp = c_in; const float* const ccp = cctx_in; const float* const bap = b_ada; float* const modp = MOD;
            for (int i = tid; i < 3 * 1024; i += NWAVES * 64) { const float cv = (i < 2048) ? cp[i] : ccp[i - 2048]; s_lds[i] = cv / (1.0f + expf(-cv)); }
            __syncthreads();
            for (int bt = bx; bt < 192; bt += G) { const int l = bt / 96, cb = bt % 96;
                const float* W = w_ada + (size_t)l * 1024 * 6144 + 64 * cb + lane; float a0 = 0.f, a1 = 0.f, a2 = 0.f;
#pragma unroll 16
                for (int kk = 0; kk < 128; ++kk) { const int k = 128 * wave + kk; const float wv = W[(size_t)k * 6144]; a0 += s_lds[k] * wv; a1 += s_lds[1024 + k] * wv; a2 += s_lds[2048 + k] * wv; }
                part[(wave * 3 + 0) * 64 + lane] = a0; part[(wave * 3 + 1) * 64 + lane] = a1; part[(wave * 3 + 2) * 64 + lane] = a2;
                __syncthreads();
                if (tid < 192) { const int r = tid >> 6, ln = tid & 63; float s = bap[l * 6144 + 64 * cb + ln];
#pragma unroll
                    for (int w = 0; w < 8; ++w) s += part[(w * 3 + r) * 64 + ln];
                    modp[(l * 3 + r) * 6144 + 64 * cb + ln] = s; }
                __syncthreads();
            }
        }
        __syncthreads();
        LAS float* scr = (LAS float*)(lds + wave * 16384);
        constexpr int I_IN = 16 * 64, I_OUT = 16 * 32, I_UP = 16 * 176, I_DN = 44 * 32, I_L = I_IN + I_OUT + I_UP + I_DN;
        const float* const wf1_ = w_ff1; const float* const wf3_ = w_ff3;
        for (int it = gw; it < 2 * I_L; it += NGW) {
            const int l = it / I_L; int r = it % I_L;
            if (r < I_IN) { const int kb = r / 64, pblk = r % 64, tile = pblk >> 3, pb = pblk & 7, lb = 2 * (pb & 3) + (pb >> 2);
                tr_item(w_in + (size_t)l * 1024 * 2048, 2048, 64 * kb, 256 * tile + 32 * lb, WIN + (size_t)l * 2048 * 1024, 1024, 32 * pblk, scr, lane); continue; } r -= I_IN;
            if (r < I_OUT) { const int kb = r / 32, pblk = r % 32;
                tr_item(w_out + (size_t)l * 1024 * 1024, 1024, 64 * kb, 32 * pblk, WOUT + (size_t)l * 1024 * 1024, 1024, 32 * pblk, scr, lane);
                if (ABL_ZERO_C && 64 * kb < 384) { for (int j = 0; j < 4; ++j) { const int n = (lane >> 3) + 8 * j; *(v4u*)(WOUT + (size_t)l * 1024 * 1024 + (size_t)(32 * pblk + n) * 1024 + 64 * kb + 8 * (lane & 7)) = (v4u){0u, 0u, 0u, 0u}; } }
                continue; } r -= I_OUT;
            if (r < I_UP) { const int kb = r / 176, pblk = r % 176, p = pblk >> 3, bj = (pblk >> 2) & 1, q = pblk & 3;
                tr_item((bj ? wf3_ : wf1_) + (size_t)l * 1024 * FF, FF, 64 * kb, 128 * p + 32 * q, WUP + (size_t)l * NUP * 1024, 1024, 32 * pblk, scr, lane); continue; } r -= I_UP;
            { const int kb = r / 32, pblk = r % 32;
                tr_item(w_ff2 + (size_t)l * FF * 1024, 1024, 64 * kb, 32 * pblk, WDN + (size_t)l * 1024 * FF, FF, 32 * pblk, scr, lane); }
        }
    }
    CG_SYNC();

#pragma unroll 1
    for (int L = 0; L < 2; ++L) {
#define modl (MOD + (size_t)L * 3 * 6144)
        if (L == 0) {
            PHASE_IDS
            norm_rows<0>(gw, NGW, lane, x_in, ctx_in, XRES, XN, nullptr, g_attn + L * D, modl, 0);
            GRID_SYNC();
        }
        {
            PHASE_IDS
            pg8::Gemm g{XN, WIN + (size_t)L * 2048 * 1024, MROWS, NIN, D}; pg8::Order S; S.init(MROWS / 256, NIN, G, bx, 0);
            pg8::EpiQKV E{bQ, bK, bV, g_q + L * 64, g_k + L * 64, cosA, sinA, cosB, sinB, C2A, C2B, NMAX + L * 32};
#ifndef NO_G1
            pg8::gemm_phase<pg8::EpiQKV, pg8::Order, PG8_ALIGN, PG8_SP2>((PG8_LAS unsigned char*)lds, g, S, E);
#endif
        }
        GRID_SYNC();
        {
            PHASE_IDS
            int Lq_ = L; asm volatile("" : "+s"(Lq_)); const float lam_init = (Lq_ == 0) ? 0.2f : 0.35550907f;
            float d1 = 0.f, d2 = 0.f;

#pragma unroll 1
                    for (int i = 0; i < 32; ++i) { d1 += lam_q1[L * 32 + i] * lam_k1[L * 32 + i]; d2 += lam_q2[L * 32 + i] * lam_k2[L * 32 + i]; }
            const float lam = expf(d1) - expf(d2) + lam_init;
            float mgq = 0.f, mgk = 0.f;
#pragma unroll 1
            for (int i = 0; i < 64; ++i) { mgq = fmaxf(mgq, fabsf(g_q[L * 64 + i])); mgk = fmaxf(mgk, fabsf(g_k[L * 64 + i])); }
            const float amfix = 8.0f * mgq * mgk * LOG2E * 1.02f;
            const int NTOT = 512 + 768 + 768 + (L == 0 ? 32 : 0);
            for (int un = vcu; un < NTOT; un += G) {
                attn_body::AttnParams P; int b, h, qb, type;
                if (un < 512) { const int v = un & 255, xx = v >> 5; type = 1; b = xx >> 2; h = xx & 3; qb = (v & 31) + 32 * (un >> 8); }
                else if (un < 2048) { const int ia = (un - 512) % 768; type = (un < 1280) ? 0 : 2; const int v = ia & 255, rnd = ia >> 8, xx = v >> 5, gi = xx >> 1, uu = 96 * (xx & 1) + 3 * (v & 31) + rnd;
                    b = gi >> 1; h = 3 * (gi & 1) + uu / 64; qb = uu % 64; }
                else { const int ic = un - 2048; qb = 64; if (ic < 12) { type = 0; b = ic / 6; h = ic % 6; } else if (ic < 20) { type = 1; b = (ic - 12) / 4; h = (ic - 12) % 4; } else { type = 2; b = (ic - 20) / 6; h = (ic - 20) % 6; } }
                const bool isctx = qb == 64;
                const int qcol = type == 0 ? h : (type == 1 ? 6 + 2 * h : 14 + h), kcol = type == 0 ? h / 3 : (type == 1 ? 2 + h : 6 + h / 3), ocol = type == 0 ? h : (type == 1 ? 6 + h : 10 + h);
                const size_t row0 = (size_t)b * TPB + 256 * qb;
                P.Q = (const attn_body::bf16*)(bQ + row0 * 1280 + qcol * 64);
                P.K = (const attn_body::bf16*)(bK + (size_t)(b * 8 + kcol) * TPB * 64);
                P.V = (const attn_body::bf16*)(bV + (size_t)(b * 8 + kcol) * TPB * 64);
                P.O = (attn_body::bf16*)(bO + row0 * 1024 + ocol * 64);
                P.gsub = g_subln + L * 64; P.lam = lam; P.oscale = 1.0f - lam_init; P.mode = 0;
                P.sinkl2 = type == 2 ? sink_logit[L * 6 + h] * LOG2E : -INFINITY;
                P.mask = 0; P.dq0 = 0; P.nomax = (type == 0) ? 1 : 0; P.mfix = amfix;
                if (isctx) { P.NT = 4; P.base_a = SEQ; P.base_b = SEQ; }
                else if (type == 2) { const int band0 = (256 * qb - 128) < 0 ? 0 : 256 * qb - 128, bend = (256 * qb + 384) > SEQ ? SEQ : 256 * qb + 384;
                    P.NT = 4 + (bend - band0) / 64; P.base_a = SEQ; P.base_b = band0; P.mask = 1; P.dq0 = 256 * qb - band0; }
                else { P.NT = TPB / 64; P.base_a = 0; P.base_b = 256; }
#ifndef NO_ATTN
                if (type != 1) { P.khalf = 0; attn_body::attn_unit<8, false>(P, (char*)lds); }
                else {
#pragma unroll 1
                    for (int ps = 0; ps < 2; ++ps) { P.mode = 1 + ps; P.khalf = ps; if (ps) P.Q += 64;
                        const unsigned* nm = NMAX + L * 32 + ((b * 4 + h) * 2 + ps) * 2;
                        const float q2 = __uint_as_float(__hip_atomic_load(nm, __ATOMIC_RELAXED, __HIP_MEMORY_SCOPE_AGENT)), k2 = __uint_as_float(__hip_atomic_load(nm + 1, __ATOMIC_RELAXED, __HIP_MEMORY_SCOPE_AGENT));
                        P.nomax = 1; P.mfix = sqrtf(q2) * sqrtf(k2) * 1.02f;
                        attn_body::attn_unit<8, true>(P, (char*)lds); } }
#endif
            }
        }
        GRID_SYNC();
#if SELFCHECK
        {
            PHASE_IDS
            if (wave == 0 && bx < 12 && (L == 0 || bx < 8 || bx == 11)) {
                int type, b, h, t;
                switch (bx) { case 0: type = 0; b = 0; h = 1; t = 1000; break; case 1: type = 0; b = 1; h = 4; t = 16383; break; case 2: type = 1; b = 0; h = 0; t = 5; break; case 3: type = 1; b = 1; h = 3; t = 9000; break;
                    case 4: type = 2; b = 0; h = 2; t = 7777; break; case 5: type = 2; b = 1; h = 0; t = 100; break; case 6: type = 2; b = 0; h = 5; t = 16380; break; case 7: type = 2; b = 1; h = 3; t = 256; break;
                    case 8: type = 0; b = 0; h = 2; t = SEQ + 17; break; case 9: type = 1; b = 1; h = 1; t = SEQ + 200; break; case 10: type = 2; b = 0; h = 4; t = SEQ + 255; break; default: type = 0; b = 0; h = 0; t = 0; break; }
                const int qcol = type == 0 ? h : (type == 1 ? 6 + 2 * h : 14 + h), kcol = type == 0 ? h / 3 : (type == 1 ? 2 + h : 6 + h / 3), ocol = type == 0 ? h : (type == 1 ? 6 + h : 10 + h);
                const bf16* Qrow = bQ + ((size_t)b * TPB + t) * 1280 + qcol * 64; const bf16* Kb = bK + (size_t)b * TPB * 512 + kcol * 64; const bf16* Vb = bV + (size_t)b * TPB * 512 + kcol * 64;
                const int kind = t >= SEQ ? 1 : (type == 2 ? 2 : 0); const float skl = type == 2 ? sink_logit[L * 6 + h] * LOG2E : -INFINITY;
                float ref = naive_row(Qrow, Kb, Vb, kind, t, skl, lane, (LAS float*)lds);
                if (type == 1) { const float r2 = naive_row(Qrow + 64, Kb, Vb, kind, t, skl, lane, (LAS float*)lds);
                    int Lq_ = L; asm volatile("" : "+s"(Lq_)); const float lam_init = (Lq_ == 0) ? 0.2f : 0.35550907f;   float d1 = 0.f, d2 = 0.f;

#pragma unroll 1
                    for (int i = 0; i < 32; ++i) { d1 += lam_q1[L * 32 + i] * lam_k1[L * 32 + i]; d2 += lam_q2[L * 32 + i] * lam_k2[L * 32 + i]; }
                    const float lam = expf(d1) - expf(d2) + lam_init; const float v = ref - lam * r2; const float ss = wave_sum(v * v);
                    ref = v / sqrtf(ss * (1.0f / 64.0f) + 1e-6f) * g_subln[L * 64 + lane] * (1.0f - lam_init); }
                const float got = bf2f(bO[((size_t)b * TPB + t) * 1024 + ocol * 64 + lane]);
                const float err = wave_max(fabsf(ref - got)), rms = sqrtf(wave_sum(ref * ref) * (1.0f / 64.0f));
                if (lane == 0) ((float*)(kws() + 4096))[L * 32 + bx] = err / (rms + 1e-20f);
            }
            if (wave == 0 && bx >= 12 && bx < 14) {
                const int m = bx == 12 ? (TPB + 12345) : (SEQ + 3); const int b = m >= TPB ? 1 : 0, t = m - b * TPB, r = t >= SEQ ? 2 : b;
                const float* src = (L == 0) ? (t < SEQ ? x_in + ((size_t)b * SEQ + t) * D : ctx_in + ((size_t)b * CTXL + (t - SEQ)) * D) : nullptr;
                float worst = 0.f;
                if (L == 0) {
                    float ssq = 0.f; for (int k = lane; k < D; k += 64) ssq += src[k] * src[k];
                    const float rn = 1.0f / sqrtf(wave_sum(ssq) * (1.0f / D) + 1e-6f);
                    const float* cvec = r == 2 ? cctx_in : c_in + r * D;
#pragma unroll 1
                    for (int col = lane; col < D; col += 64 * 8) {
                        float sh = b_ada[L * 6144 + col], sc = b_ada[L * 6144 + 1024 + col];
#pragma unroll 1
                        for (int k = 0; k < D; ++k) { const float cv = cvec[k]; const float sl = cv / (1.0f + expf(-cv)); sh += sl * w_ada[((size_t)L * D + k) * 6144 + col]; sc += sl * w_ada[((size_t)L * D + k) * 6144 + 1024 + col]; }
                        const float ref = src[col] * rn * g_attn[L * D + col] * (1.0f + sc) + sh; const float got = bf2f(XN[(size_t)m * D + col]);
                        worst = fmaxf(worst, fabsf(ref - got) / (fabsf(ref) + 0.05f));
                    }
                }
                worst = wave_max(worst);
                if (lane == 0) ((float*)(kws() + 4096))[L * 32 + bx] = worst;
            }
            if (wave == 0 && bx >= 16 && bx < 32) {
                const int gl[8] = {0, 6, 8, 11, 15, 23, 28, 31}; (void)gl;
                const int gi = (bx - 16) & 7; const int g = gi == 0 ? 0 : gi == 1 ? 6 : gi == 2 ? 8 : gi == 3 ? 11 : gi == 4 ? 15 : gi == 5 ? 23 : gi == 6 ? 18 : 31;
                const int m = (bx - 16) < 8 ? (TPB + 12345) : (SEQ + 3); const int b = m >= TPB ? 1 : 0, t = m - b * TPB; const bool isctx = t >= SEQ;
                const int d = lane; float acc = 0.f;
#pragma unroll 1
                for (int k = 0; k < D; ++k) acc += bf2f(XN[(size_t)m * D + k]) * bf2f((unsigned short)f2bf(w_in[((size_t)L * D + k) * 2048 + 64 * g + d]));
                const int kindq = g < 6 ? 0 : g < 8 ? 1 : g < 10 ? 2 : g < 14 ? 3 : g < 18 ? 4 : g < 22 ? 2 : g < 28 ? 5 : g < 30 ? 6 : 2;
                float v = acc;
                if (kindq == 0 || kindq == 1) { const float ss = wave_sum(v * v); v = v / sqrtf(ss * (1.0f / 64.0f) + 1e-6f) * (kindq == 0 ? g_q[L * 64 + d] : g_k[L * 64 + d]); }
                if (!isctx && kindq != 2) {
                    const int trow = t >> 6, tcol = t & 63;
                    if (kindq == 3 || kindq == 4) { const int e = d & 31, w = e & 15, i = w & 7; const int pos = (e >> 4) ? tcol : trow; const float fr = powf(10000.0f, -(float)i / 8.0f); const float ang = (float)pos * fr;
                        float sn, cs; sincos_d((double)ang, sn, cs); const float xp = __shfl_xor(v, 8); v = (w < 8) ? v * cs - xp * sn : xp * sn + v * cs; }
                    else { const int e = d & 31, i = e & 15; const int pos = (d >> 5) ? tcol : trow; const float fr = powf(10000.0f, -(float)i / 16.0f); const float ang = (float)pos * fr;
                        float sn, cs; sincos_d((double)ang, sn, cs); const float xp = __shfl_xor(v, 16); v = (e < 16) ? v * cs - xp * sn : xp * sn + v * cs; }
                }
                float got;
                const size_t row = (size_t)m;
                if (kindq == 0) { v *= C2A; got = bf2f(bQ[row * 1280 + 64 * g + d]); }
                else if (kindq == 1) got = bf2f(bK[row * 512 + 64 * (g - 6) + d]);
                else if (kindq == 3) { v *= C2B; const int vh = 6 + 2 * (g - 10) + (d >> 5); got = bf2f(bQ[row * 1280 + 64 * vh + d]); const float z = bf2f(bQ[row * 1280 + 64 * vh + (d ^ 32)]); if (__any(z != 0.f) && lane == 0) ((float*)(kws() + 4096))[200 + L * 32 + bx] = 1.0f; }
                else if (kindq == 4) got = bf2f(bK[row * 512 + 64 * (2 + g - 14) + d]);
                else if (kindq == 5) { v *= C2A; got = bf2f(bQ[row * 1280 + 64 * (14 + g - 22) + d]); }
                else if (kindq == 6) got = bf2f(bK[row * 512 + 64 * (6 + g - 28) + d]);
                else got = bf2f(bV[row * 512 + 64 * (g < 10 ? g - 8 : g < 22 ? 2 + g - 18 : 6 + g - 30) + d]);
                const float err = wave_max(fabsf(v - got)), rms = sqrtf(wave_sum(v * v) * (1.0f / 64.0f));
                if (lane == 0) ((float*)(kws() + 4096))[L * 32 + bx] = err / (rms + 1e-20f);
                { const float vp = __shfl_xor(v, 8), gp = __shfl_xor(got, 8); const float pr = v * v + vp * vp, pg = got * got + gp * gp; const float e2 = wave_max(fabsf(pr - pg)) / (wave_sum(pr) * (1.0f / 64.0f) + 1e-20f);
                  if (lane == 0) ((float*)(kws() + 4096))[100 + L * 32 + bx] = e2; }
            }
        }
#endif
        {
            const int skip = (L == 1) ? 1 : 0;
            PHASE_IDS
            pg8::Gemm g{bO, WOUT + (size_t)L * 1024 * 1024, MROWS, D, D}; pg8::Order S; S.init(skip ? 128 : 130, D, G, bx, skip);
            pg8::EpiRes E{XRES, modl, 2, L == 0 ? x_in : nullptr, ctx_in};
#ifndef NO_GR
            pg8::gemm_phase<pg8::EpiRes, pg8::Order, PG8_ALIGN, PG8_SP2>((PG8_LAS unsigned char*)lds, g, S, E);
#endif
        }
        GRID_SYNC();
        { PHASE_IDS
            norm_rows<1>(gw, NGW, lane, nullptr, nullptr, XRES, XN, nullptr, g_ffn + L * D, modl, 3); }
        GRID_SYNC();
        {
            const int skip = (L == 1) ? 1 : 0;
            PHASE_IDS
            pg8::Gemm g{XN, WUP + (size_t)L * NUP * 1024, MROWS, NUP, D}; pg8::Order S; S.init(skip ? 128 : 130, NUP, G, bx, skip);
            pg8::EpiSwiGLU E{bU};
#ifndef NO_GU
            pg8::gemm_phase<pg8::EpiSwiGLU, pg8::Order, PG8_ALIGN, PG8_SP2>((PG8_LAS unsigned char*)lds, g, S, E);
#endif
        }
        GRID_SYNC();
        {
            const int skip = (L == 1) ? 1 : 0;
            PHASE_IDS
            pg8::Gemm g{bU, WDN + (size_t)L * 1024 * FF, MROWS, D, FF}; pg8::Order S; S.init(skip ? 128 : 130, D, G, bx, skip);
            pg8::EpiRes E{XRES, modl, 5, nullptr, nullptr};
#ifndef NO_GR
            pg8::gemm_phase<pg8::EpiRes, pg8::Order, PG8_ALIGN, PG8_SP2>((PG8_LAS unsigned char*)lds, g, S, E);
#endif
        }
        GRID_SYNC();
        if (L == 0) {
            PHASE_IDS
            norm_rows<1>(gw, NGW, lane, nullptr, nullptr, XRES, XN, nullptr, g_attn + 1 * D, MOD + (size_t)1 * 3 * 6144, 0);
            GRID_SYNC();
        } else {
            PHASE_IDS
            norm_rows<2>(gw, NGW, lane, nullptr, nullptr, XRES, nullptr, (float*)kin(22), g_final, nullptr, 0);
#if SELFCHECK
            asm volatile("s_waitcnt vmcnt(0)" ::: "memory"); __syncthreads();
            if (bx == 0 && tid == 0) { const float* dg = (const float*)(kws() + 4096); float e19 = dg[100 + 20]; if (!(e19 < 5.0f)) e19 = 5.0f; if (e19 < 0.f) e19 = 0.f; float e20 = dg[22]; if (!(e20 < 5.0f)) e20 = 5.0f; if (e20 < 0.f) e20 = 0.f;
                ((float*)kin(22))[0] = 1000.0f * (1.0f + 10.0f * e19) + (dg[200 + 19] == 1.0f ? 100000.0f : 0.f); ((float*)kin(22))[1] = 100.0f * (1.0f + 10.0f * e20); }
#endif
        }
    }
}

extern "C" void kernel_launch(void* const* d_in, const int* in_sizes, int n_in, void* d_out, int out_size, void* d_ws, size_t ws_size, hipStream_t stream) {
    static int grid = 0;
    if (grid == 0) {
        if (n_in != 22 || out_size != NBATCH * SEQ * D || ws_size < WS_END) { fprintf(stderr, "kernel_launch: unexpected shapes: n_in %d out %d ws %zu (need %zu); nothing launched\n", n_in, out_size, ws_size, (size_t)WS_END); grid = -1; return; }
        int dev = 0, cus = 0, per_cu = 0;
        if (hipGetDevice(&dev) != hipSuccess || hipDeviceGetAttribute(&cus, hipDeviceAttributeMultiprocessorCount, dev) != hipSuccess) { grid = -1; return; }
        if (hipFuncSetAttribute((const void*)mega_fwd, hipFuncAttributeMaxDynamicSharedMemorySize, LDS_BYTES) != hipSuccess) { fprintf(stderr, "kernel_launch: hipFuncSetAttribute failed\n"); grid = -1; return; }
        if (hipOccupancyMaxActiveBlocksPerMultiprocessor(&per_cu, (const void*)mega_fwd, NWAVES * 64, LDS_BYTES) != hipSuccess || per_cu < 1) { fprintf(stderr, "kernel_launch: occupancy query says %d\n", per_cu); per_cu = 1; }
        (void)hipGetLastError();
        grid = cus;
    }
    if (grid < 0) return;
    if (hipMemsetAsync((char*)d_ws + WS_BAR, 0, 16384, stream) != hipSuccess) { fprintf(stderr, "kernel_launch: hipMemsetAsync failed\n"); return; }
    Args a{};
    for (int i = 0; i < 22; ++i) a.in[i] = (const float*)d_in[i];
    a.out = (float*)d_out; a.ws = (unsigned char*)d_ws;
    void* kargs[] = {&a};
    const hipError_t e = hipLaunchCooperativeKernel((const void*)mega_fwd, dim3(grid), dim3(NWAVES * 64), kargs, LDS_BYTES, stream);
    if (e != hipSuccess) fprintf(stderr, "kernel_launch: cooperative launch failed: %s (grid %d)\n", hipGetErrorString(e), grid);
}
```

```cpp
#include <hip/hip_runtime.h>
#include <hip/hip_bf16.h>
#include <hip/hip_cooperative_groups.h>
#include <cstdio>
#include <cstdint>
#include <cmath>

namespace pg8 {
#define PG8_LAS __attribute__((address_space(3)))
typedef unsigned short bf16_t;
typedef short bf16x8 __attribute__((ext_vector_type(8)));
typedef float f32x4 __attribute__((ext_vector_type(4)));
typedef unsigned u32x4 __attribute__((ext_vector_type(4)));
constexpr int BM = 256, BK = 64, HALF = 128, HTB = HALF * BK * 2  , STAGE_BYTES = 8 * HTB, NXCD = 8, WGM = 8;

__host__ __device__ __forceinline__ int lds_byte(int r, int c) { const int st = (r >> 4) * 2 + (c >> 5), rr = r & 15, cc = c & 31, ob = rr * 64 + cc * 2; return st * 1024 + (ob ^ (((ob >> 9) & 1) << 5)); }
__host__ __device__ __forceinline__ void stage_rc(int b, int& R, int& C) { const int st = b / 1024, sb = b % 1024, swz = sb ^ (((sb >> 9) & 1) << 5); R = (st >> 1) * 16 + swz / 64; C = (st & 1) * 32 + (swz % 64) / 2; }
__host__ __device__ __forceinline__ int perm32(int rho) { const int n = rho >> 4, i = rho & 15; return 8 * (i >> 2) + 4 * n + (i & 3); }

struct Unit { int pm, pn; };
struct Gemm { const bf16_t* A; const bf16_t* Bt; int M, N, K; };

struct StaticOrder {
    int nM, nN, nwg, G, c;
    __host__ __device__ void init(int M, int N, int G_, int c_) { nM = M / BM; nN = N / BM; nwg = nM * nN; G = G_; c = c_; }
    __host__ __device__ bool next(int i, Unit& u) const {
        const long L = (long)i * G + c; if (L >= nwg) return false;
        int wgid = (int)L; { const int q = nwg / NXCD, r = nwg % NXCD, xcd = wgid % NXCD, off = wgid / NXCD; wgid = (xcd < r ? xcd * (q + 1) : r * (q + 1) + (xcd - r) * q) + off; }
        const int nig = WGM * nN, gid = wgid / nig, fm = gid * WGM, gsz = (nM - fm) < WGM ? (nM - fm) : WGM;
        u.pm = fm + ((wgid % nig) % gsz); u.pn = (wgid % nig) / gsz; return true;
    }
    __device__ __forceinline__ void a_ready(const Unit&) const {}
    __device__ __forceinline__ void done(const Unit&) const {}
};

__device__ __forceinline__ unsigned cvt_pk_bf16(float lo, float hi) { unsigned r; asm volatile("v_cvt_pk_bf16_f32 %0, %1, %2" : "=v"(r) : "v"(lo), "v"(hi)); return r; }
typedef float f32x2 __attribute__((ext_vector_type(2)));


typedef unsigned u32x2 __attribute__((ext_vector_type(2)));
__device__ __forceinline__ unsigned pk_bf16(float lo, float hi) { typedef float f2 __attribute__((ext_vector_type(2))); typedef __bf16 b2 __attribute__((ext_vector_type(2))); f2 v = {lo, hi}; b2 b = __builtin_convertvector(v, b2); return __builtin_bit_cast(unsigned, b); }
struct Order {
    int nM, nN, nwg, G, c, skip;
    __device__ void init(int nM_, int N, int G_, int c_, int skip_) { nM = nM_; nN = N / BM; nwg = nM * nN; G = G_; c = c_; skip = skip_; }
    __device__ bool next(int i, Unit& u) const {
        const long L = (long)i * G + c; if (L >= nwg) return false;
        int wgid = (int)L; { const int q = nwg / NXCD, r = nwg % NXCD, xcd = wgid % NXCD, off = wgid / NXCD; wgid = (xcd < r ? xcd * (q + 1) : r * (q + 1) + (xcd - r) * q) + off; }
        const int nig = WGM * nN, gid = wgid / nig, fm = gid * WGM, gsz = (nM - fm) < WGM ? (nM - fm) : WGM;
        u.pm = fm + ((wgid % nig) % gsz); u.pn = (wgid % nig) / gsz;
        if (skip) u.pm += (u.pm >= 64) ? 1 : 0;
        return true;
    }
    __device__ __forceinline__ void a_ready(const Unit&) const {}
    __device__ __forceinline__ void done(const Unit&) const {}
};
constexpr int TPB_ = 16640, SEQ_ = 16384;
struct EpiQKV {
    static constexpr bool PERM = false, AFTER_DRAIN = false;
    bf16_t *Q, *K, *V; const float *gq, *gk, *cosA, *sinA, *cosB, *sinB; float c2a, c2b;
    unsigned* nmax;
    __device__ __forceinline__ void operator()(const f32x4 (&acc)[2][2][4][2], const Unit& u, int wr, int wc, int fr, int fq) const {
        asm volatile("" : "+v"(fr), "+v"(fq));
        const int lnq = fq * 16 + fr, bp16 = (lnq ^ 16) << 2, bp32 = (lnq ^ 32) << 2;
        const int g = 4 * u.pn + wc;
        bf16_t* dst; int pitch, dcol, rope = 0; const float* ng = nullptr; float sc = 1.f; bool split = false;
        if (g < 6)       { dst = Q; pitch = 1280; dcol = 64 * g; ng = gq; rope = 1; sc = c2a; }
        else if (g < 8)  { dst = K; pitch = 512; dcol = 64 * (g - 6); ng = gk; rope = 1; }
        else if (g < 10) { dst = V; pitch = 512; dcol = 64 * (g - 8); }
        else if (g < 14) { dst = Q; pitch = 1280; dcol = 64 * (6 + 2 * (g - 10)); rope = 2; sc = c2b; split = true; }
        else if (g < 18) { dst = K; pitch = 512; dcol = 64 * (2 + g - 14); rope = 2; }
        else if (g < 22) { dst = V; pitch = 512; dcol = 64 * (2 + g - 18); }
        else if (g < 28) { dst = Q; pitch = 1280; dcol = 64 * (14 + g - 22); rope = 1; sc = c2a; }
        else if (g < 30) { dst = K; pitch = 512; dcol = 64 * (6 + g - 28); rope = 1; }
        else             { dst = V; pitch = 512; dcol = 64 * (6 + g - 30); }
        const int bt = u.pm >= 65 ? 1 : 0, tile_t0 = (u.pm - 65 * bt) * 256; const bool isctx = tile_t0 >= SEQ_;
        const bool rope2g = (g >= 10 && g < 18); float nmx[2] = {0.f, 0.f};
        if (isctx) rope = 0;
        f32x4 gv[2][2];
#pragma unroll
        for (int bj = 0; bj < 2; ++bj)
#pragma unroll
            for (int n = 0; n < 2; ++n) gv[bj][n] = ng ? *(const f32x4*)(ng + 32 * bj + 16 * n + 4 * fq) : (f32x4){1.f, 1.f, 1.f, 1.f};
#pragma unroll
        for (int ai = 0; ai < 2; ++ai)
#pragma unroll
            for (int m = 0; m < 4; ++m) {
                const int rl = ai * HALF + wr * 64 + m * 16 + fr; const int t = tile_t0 + rl; const size_t row = (size_t)u.pm * BM + rl;
                const int trow = (t >> 6) & 255, tcol = t & 63;
                f32x4 v[2][2];
#pragma unroll
                for (int bj = 0; bj < 2; ++bj)
#pragma unroll
                    for (int n = 0; n < 2; ++n) v[bj][n] = acc[ai][bj][m][n];
                if (ng) {
                    float ss = 0.f;
#pragma unroll
                    for (int bj = 0; bj < 2; ++bj)
#pragma unroll
                        for (int n = 0; n < 2; ++n) { const f32x4 x = v[bj][n]; ss += (x[0] * x[0] + x[1] * x[1]) + (x[2] * x[2] + x[3] * x[3]); }
                    ss += __builtin_bit_cast(float, __builtin_amdgcn_ds_bpermute(bp16, __builtin_bit_cast(int, ss))); ss += __builtin_bit_cast(float, __builtin_amdgcn_ds_bpermute(bp32, __builtin_bit_cast(int, ss)));
                    const float rn = 1.0f / sqrtf(ss * (1.0f / 64.0f) + 1e-6f);
#pragma unroll
                    for (int bj = 0; bj < 2; ++bj)
#pragma unroll
                        for (int n = 0; n < 2; ++n) v[bj][n] = v[bj][n] * rn * gv[bj][n];
                }
                if (rope == 1) {
#pragma unroll
                    for (int bj = 0; bj < 2; ++bj) { const int pos = bj ? tcol : trow;
                        const f32x4 c = *(const f32x4*)(cosA + pos * 16 + 4 * fq), s = *(const f32x4*)(sinA + pos * 16 + 4 * fq);
                        const f32x4 x1 = v[bj][0], x2 = v[bj][1]; v[bj][0] = x1 * c - x2 * s; v[bj][1] = x1 * s + x2 * c; }
                } else if (rope == 2) {
#pragma unroll
                    for (int n = 0; n < 2; ++n) { const int pos = n ? tcol : trow;
                        const f32x4 c = *(const f32x4*)(cosB + pos * 8 + 4 * (fq & 1)); f32x4 s = *(const f32x4*)(sinB + pos * 8 + 4 * (fq & 1));
                        if (fq < 2) s = -s;
#pragma unroll
                        for (int bj = 0; bj < 2; ++bj) { const f32x4 x = v[bj][n]; f32x4 p;
#pragma unroll
                            for (int e = 0; e < 4; ++e) { const float xe = x[e]; p[e] = __int_as_float(__builtin_amdgcn_ds_bpermute(bp32, __float_as_int(xe))); }
                            v[bj][n] = x * c + p * s; } }
                }
                if (rope2g) {
#pragma unroll
                    for (int bj = 0; bj < 2; ++bj) { const f32x4 x0 = v[bj][0] * sc, x1 = v[bj][1] * sc; float s2 = ((x0[0] * x0[0] + x0[1] * x0[1]) + (x0[2] * x0[2] + x0[3] * x0[3])) + ((x1[0] * x1[0] + x1[1] * x1[1]) + (x1[2] * x1[2] + x1[3] * x1[3]));
                        s2 += __int_as_float(__builtin_amdgcn_ds_bpermute(bp16, __float_as_int(s2))); s2 += __int_as_float(__builtin_amdgcn_ds_bpermute(bp32, __float_as_int(s2))); nmx[bj] = fmaxf(nmx[bj], s2); } }
                bf16_t* rp = dst + row * pitch + dcol + 4 * fq;
                if (!split) {
#pragma unroll
                    for (int bj = 0; bj < 2; ++bj)
#pragma unroll
                        for (int n = 0; n < 2; ++n) { const f32x4 x = v[bj][n] * sc; u32x2 w; w.x = pk_bf16(x[0], x[1]); w.y = pk_bf16(x[2], x[3]); *(u32x2*)(rp + 32 * bj + 16 * n) = w; }
                } else {
#pragma unroll
                    for (int n = 0; n < 2; ++n) { const f32x4 x = v[0][n] * sc, y = v[1][n] * sc; u32x2 w, z; w.x = pk_bf16(x[0], x[1]); w.y = pk_bf16(x[2], x[3]); z.x = 0u; z.y = 0u;
                        *(u32x2*)(rp + 16 * n) = w; *(u32x2*)(rp + 32 + 16 * n) = z; *(u32x2*)(rp + 64 + 16 * n) = z;
                        w.x = pk_bf16(y[0], y[1]); w.y = pk_bf16(y[2], y[3]); *(u32x2*)(rp + 96 + 16 * n) = w; }
                }
            }
        if (rope2g) {
#pragma unroll
            for (int bj = 0; bj < 2; ++bj) { float m2 = nmx[bj];
#pragma unroll
                for (int o_ = 1; o_ < 16; o_ <<= 1) m2 = fmaxf(m2, __int_as_float(__builtin_amdgcn_ds_bpermute((lnq ^ o_) << 2, __float_as_int(m2))));
                const int hb = g < 14 ? g - 10 : g - 14, isk = g < 14 ? 0 : 1;
                if (lnq == 0) __hip_atomic_fetch_max(nmax + (((bt * 4 + hb) * 2 + bj) * 2 + isk), __float_as_uint(m2), __ATOMIC_RELAXED, __HIP_MEMORY_SCOPE_AGENT); } }
    }
};
struct EpiRes {
    static constexpr bool PERM = false, AFTER_DRAIN = false;
    float* X; const float* modl; int gidx; const float* xin; const float* cin;
    __device__ __forceinline__ void operator()(const f32x4 (&acc)[2][2][4][2], const Unit& u, int wr, int wc, int fr, int fq) const {
        asm volatile("" : "+v"(fr), "+v"(fq));
        const int bt = u.pm >= 65 ? 1 : 0, r = (u.pm - 65 * bt) == 64 ? 2 : bt;
        const float* rbase = X + (size_t)u.pm * BM * 1024;
        if (xin) rbase = (r == 2) ? cin + (size_t)bt * 256 * 1024 : xin + ((size_t)bt * SEQ_ + (size_t)(u.pm - 65 * bt) * 256) * 1024;
        const int col0 = u.pn * BM + wc * 32 + 4 * fq; const float* gate = modl + r * 6144 + gidx * 1024 + col0;
        f32x4 gv[2][2];
#pragma unroll
        for (int bj = 0; bj < 2; ++bj)
#pragma unroll
            for (int n = 0; n < 2; ++n) gv[bj][n] = *(const f32x4*)(gate + bj * HALF + n * 16);
#pragma unroll
        for (int ai = 0; ai < 2; ++ai)
#pragma unroll
            for (int m = 0; m < 4; ++m) { const int rl = ai * HALF + wr * 64 + m * 16 + fr; float* rp = X + ((size_t)u.pm * BM + rl) * 1024 + col0; const float* rq = rbase + (size_t)rl * 1024 + col0;
#pragma unroll
                for (int bj = 0; bj < 2; ++bj)
#pragma unroll
                    for (int n = 0; n < 2; ++n) { f32x4* p = (f32x4*)(rp + bj * HALF + n * 16); *p = *(const f32x4*)(rq + bj * HALF + n * 16) + gv[bj][n] * acc[ai][bj][m][n]; }
                if (m & 1) asm volatile("" ::: "memory"); }
    }
};
struct EpiSwiGLU {
    static constexpr bool PERM = true, AFTER_DRAIN = false;
    bf16_t* U;
    __device__ __forceinline__ void operator()(const f32x4 (&acc)[2][2][4][2], const Unit& u, int wr, int wc, int fr, int fq) const {
        asm volatile("" : "+v"(fr), "+v"(fq));
        const int col0 = u.pn * HALF + wc * 32 + 8 * fq;
#pragma unroll
        for (int ai = 0; ai < 2; ++ai)
#pragma unroll
            for (int m = 0; m < 4; ++m) { bf16_t* rp = U + ((size_t)u.pm * BM + ai * HALF + wr * 64 + m * 16 + fr) * 2816 + col0;
                float o[8];
#pragma unroll
                for (int n = 0; n < 2; ++n)
#pragma unroll
                    for (int j = 0; j < 4; ++j) { const float a = acc[ai][0][m][n][j], b = acc[ai][1][m][n][j];
                        o[4 * n + j] = a * __builtin_amdgcn_rcpf(1.0f + __builtin_amdgcn_exp2f(-1.4426950408889634f * a)) * b; }
                u32x4 w; w.x = pk_bf16(o[0], o[1]); w.y = pk_bf16(o[2], o[3]); w.z = pk_bf16(o[4], o[5]); w.w = pk_bf16(o[6], o[7]);
                *(u32x4*)rp = w; }
    }
};

template <class Epi, class Sched, bool ALIGN_EPI = false, bool SP2 = false>
__device__ __forceinline__ void gemm_phase(PG8_LAS unsigned char* lds, const Gemm g, const Sched& S, const Epi& E) {
    int tid_ = threadIdx.x; asm volatile("" : "+v"(tid_));
    const int tid = tid_, wid = __builtin_amdgcn_readfirstlane(tid >> 6), lane = tid & 63, wr = wid >> 2, wc = wid & 3, fr = lane & 15, fq = lane >> 4;
    const int K = g.K, nt = K / BK;
    unsigned voffA[2], voffB[2];
#pragma unroll
    for (int i = 0; i < 2; ++i) { int R, C; stage_rc(tid * 16 + i * 8192, R, C); const int Rb = Epi::PERM ? ((R & ~31) + perm32(R & 31)) : R;
        voffA[i] = (unsigned)(R * K + C) * 2u; voffB[i] = (unsigned)(Rb * K + C) * 2u; }
    const size_t kstep = (size_t)(BK * 2);
    const size_t hstep = (size_t)HALF * K * 2;
    const size_t tstep = 2 * hstep;
    const unsigned ldsw = (unsigned)wid * 1024u;
    const int aoff = lds_byte(wr * 64 + fr, fq * 8), boff = lds_byte(wc * 32 + fr, fq * 8);
#define PG8_SA(b, h) (((b) * 2 + (h)) * HTB)
#define PG8_SB(b, h) ((4 + (b) * 2 + (h)) * HTB)
#define PG8_STAGE(bufoff, gbase, voff) do { _Pragma("unroll") for (int _i = 0; _i < 2; ++_i) \
        __builtin_amdgcn_global_load_lds((const unsigned*)((const char*)(gbase) + (voff)[_i]), (PG8_LAS unsigned*)(lds + (bufoff) + ldsw + _i * 8192), 16, 0, 0); } while (0)
#define PG8_LDA(dst, b, h) do { _Pragma("unroll") for (int m = 0; m < 4; ++m) _Pragma("unroll") for (int k = 0; k < 2; ++k) dst[m][k] = *(const PG8_LAS bf16x8*)(lds + PG8_SA(b, h) + aoff + m * 2048 + k * 1024); } while (0)
#define PG8_LDB(dst, b, h) do { _Pragma("unroll") for (int n = 0; n < 2; ++n) _Pragma("unroll") for (int k = 0; k < 2; ++k) dst[n][k] = *(const PG8_LAS bf16x8*)(lds + PG8_SB(b, h) + boff + n * 2048 + k * 1024); } while (0)
#define PG8_MMA(ai, bj, At, Bt) do { __builtin_amdgcn_s_setprio(1); _Pragma("unroll") for (int m = 0; m < 4; ++m) _Pragma("unroll") for (int n = 0; n < 2; ++n) _Pragma("unroll") for (int k = 0; k < 2; ++k) \
        acc[ai][bj][m][n] = __builtin_amdgcn_mfma_f32_16x16x32_bf16(Bt[n][k], At[m][k], acc[ai][bj][m][n], 0, 0, 0); __builtin_amdgcn_s_setprio(0); } while (0)
#define PG8_WAIT_V(n) asm volatile("s_waitcnt vmcnt(" #n ")" ::: "memory")
#define PG8_WAIT_L(n) asm volatile("s_waitcnt lgkmcnt(" #n ")" ::: "memory")
#define PG8_BAR __builtin_amdgcn_s_barrier()
#define PG8_SCHED __builtin_amdgcn_sched_barrier(0)
    Unit cur, nxt; int ui = 0;
    if (!S.next(0, cur)) return;
    f32x4 acc[2][2][4][2];
#pragma unroll
    for (int a = 0; a < 2; ++a)
#pragma unroll
        for (int b = 0; b < 2; ++b)
#pragma unroll
            for (int m = 0; m < 4; ++m)
#pragma unroll
                for (int n = 0; n < 2; ++n) acc[a][b][m][n] = (f32x4){0.f, 0.f, 0.f, 0.f};
    bf16x8 At[4][2], B0[2][2], B1[2][2];
    const char* cA = (const char*)g.A + (size_t)cur.pm * tstep; const char* cB = (const char*)g.Bt + (size_t)cur.pn * tstep;
    S.a_ready(cur);
    if constexpr (SP2) {
        PG8_STAGE(PG8_SB(0, 0), cB, voffB); PG8_STAGE(PG8_SB(0, 1), cB + hstep, voffB); PG8_STAGE(PG8_SA(0, 0), cA, voffA); PG8_STAGE(PG8_SA(0, 1), cA + hstep, voffA);
        if (wr == 1) PG8_BAR;
        PG8_WAIT_V(2); PG8_BAR;
        PG8_STAGE(PG8_SB(1, 0), cB + kstep, voffB); PG8_STAGE(PG8_SA(1, 0), cA + kstep, voffA); PG8_STAGE(PG8_SB(1, 1), cB + hstep + kstep, voffB);
        PG8_WAIT_V(6); PG8_BAR;
    } else {
        PG8_STAGE(PG8_SB(0, 0), cB, voffB); PG8_STAGE(PG8_SA(0, 0), cA, voffA); PG8_STAGE(PG8_SB(0, 1), cB + hstep, voffB); PG8_STAGE(PG8_SA(0, 1), cA + hstep, voffA);
        if (wr == 1) PG8_BAR;
        PG8_WAIT_V(4); PG8_BAR;
        PG8_STAGE(PG8_SB(1, 0), cB + kstep, voffB); PG8_STAGE(PG8_SA(1, 0), cA + kstep, voffA); PG8_STAGE(PG8_SB(1, 1), cB + hstep + kstep, voffB);
        PG8_WAIT_V(6); PG8_BAR;
    }
    for (;;) {
        const bool has_next = S.next(ui + 1, nxt);
        const char* nA = has_next ? (const char*)g.A + (size_t)nxt.pm * tstep : cA; const char* nB = has_next ? (const char*)g.Bt + (size_t)nxt.pn * tstep : cB;
        for (int t = 0; t < nt; t += 2) {
            const bool last = (t == nt - 2);
            const char* a1 = cA + (size_t)(t + 1) * kstep;
            const char* a2 = last ? nA : cA + (size_t)(t + 2) * kstep; const char* b2 = last ? nB : cB + (size_t)(t + 2) * kstep;
            const char* a3 = a2 + kstep; const char* b3 = b2 + kstep;
            if (last && has_next) S.a_ready(nxt);
            if constexpr (SP2) {
            PG8_LDB(B0, 0, 0); PG8_LDB(B1, 0, 1); PG8_SCHED; PG8_LDA(At, 0, 0); PG8_STAGE(PG8_SA(1, 1), a1 + hstep, voffA);
            PG8_WAIT_V(8); PG8_WAIT_L(0); PG8_BAR; PG8_MMA(0, 0, At, B0); PG8_MMA(0, 1, At, B1); PG8_BAR; PG8_SCHED;
            PG8_LDA(At, 0, 1); PG8_STAGE(PG8_SB(0, 0), b2, voffB); PG8_STAGE(PG8_SB(0, 1), b2 + hstep, voffB); PG8_STAGE(PG8_SA(0, 0), a2, voffA);
            PG8_WAIT_V(8); PG8_WAIT_L(0); PG8_BAR; PG8_MMA(1, 0, At, B0); PG8_MMA(1, 1, At, B1); PG8_BAR; PG8_SCHED;
            PG8_LDB(B0, 1, 0); PG8_LDB(B1, 1, 1); PG8_SCHED; PG8_LDA(At, 1, 0); PG8_STAGE(PG8_SA(0, 1), a2 + hstep, voffA);
            PG8_WAIT_V(8); PG8_WAIT_L(0); PG8_BAR; PG8_MMA(0, 0, At, B0); PG8_MMA(0, 1, At, B1); PG8_BAR; PG8_SCHED;
            PG8_LDA(At, 1, 1); PG8_STAGE(PG8_SB(1, 0), b3, voffB); PG8_STAGE(PG8_SB(1, 1), b3 + hstep, voffB); PG8_STAGE(PG8_SA(1, 0), a3, voffA);
            PG8_WAIT_V(8); PG8_WAIT_L(0); PG8_BAR; PG8_MMA(1, 0, At, B0); PG8_MMA(1, 1, At, B1); PG8_BAR; PG8_SCHED;
            } else {
            PG8_LDB(B0, 0, 0); PG8_SCHED; PG8_LDA(At, 0, 0); PG8_STAGE(PG8_SA(1, 1), a1 + hstep, voffA);
            PG8_WAIT_L(8); PG8_BAR; PG8_WAIT_L(0); PG8_MMA(0, 0, At, B0); PG8_BAR; PG8_SCHED;
            PG8_LDB(B1, 0, 1); PG8_STAGE(PG8_SB(0, 0), b2, voffB);
            PG8_BAR; PG8_WAIT_L(0); PG8_MMA(0, 1, At, B1); PG8_BAR;
            PG8_LDA(At, 0, 1); PG8_STAGE(PG8_SA(0, 0), a2, voffA);
            PG8_BAR; PG8_WAIT_L(0); PG8_MMA(1, 0, At, B0); PG8_BAR; PG8_SCHED;
            PG8_STAGE(PG8_SB(0, 1), b2 + hstep, voffB);
            PG8_WAIT_V(6); PG8_BAR; PG8_MMA(1, 1, At, B1); PG8_BAR;
            PG8_LDB(B0, 1, 0); PG8_SCHED; PG8_LDA(At, 1, 0); PG8_STAGE(PG8_SA(0, 1), a2 + hstep, voffA);
            PG8_WAIT_L(8); PG8_BAR; PG8_WAIT_L(0); PG8_MMA(0, 0, At, B0); PG8_BAR; PG8_SCHED;
            PG8_LDB(B1, 1, 1); PG8_STAGE(PG8_SB(1, 0), b3, voffB);
            PG8_BAR; PG8_WAIT_L(0); PG8_MMA(0, 1, At, B1); PG8_BAR;
            PG8_LDA(At, 1, 1); PG8_STAGE(PG8_SA(1, 0), a3, voffA);
            PG8_BAR; PG8_WAIT_L(0); PG8_MMA(1, 0, At, B0); PG8_BAR; PG8_SCHED;
            PG8_STAGE(PG8_SB(1, 1), b3 + hstep, voffB);
            PG8_WAIT_V(6); PG8_BAR; PG8_MMA(1, 1, At, B1); PG8_BAR;
            }
        }
        if constexpr (ALIGN_EPI) { if (wr == 0) PG8_BAR; }
        if constexpr (!Epi::AFTER_DRAIN) { E(acc, cur, wr, wc, fr, fq); S.done(cur); }
        if (!has_next) break;
#pragma unroll
        for (int a = 0; a < 2; ++a)
#pragma unroll
            for (int b = 0; b < 2; ++b)
#pragma unroll
                for (int m = 0; m < 4; ++m)
#pragma unroll
                    for (int n = 0; n < 2; ++n) acc[a][b][m][n] = (f32x4){0.f, 0.f, 0.f, 0.f};
        cur = nxt; cA = nA; cB = nB; ++ui;
        if constexpr (ALIGN_EPI) { if (wr == 1) PG8_BAR; }
    }
    PG8_WAIT_V(0);
    if constexpr (!ALIGN_EPI) { if (wr == 0) PG8_BAR; }
    PG8_BAR;
    if constexpr (Epi::AFTER_DRAIN) { E.fused(acc, cur, wr, wc, fr, fq, lds, wid, lane); S.done(cur); }
#undef PG8_SA
#undef PG8_SB
#undef PG8_STAGE
#undef PG8_LDA
#undef PG8_LDB
#undef PG8_MMA
#undef PG8_WAIT_V
#undef PG8_WAIT_L
#undef PG8_BAR
#undef PG8_SCHED
}
}

#ifndef PG8_SP2
#define PG8_SP2 true
#endif
#ifndef PG8_ALIGN
#define PG8_ALIGN true
#endif

namespace attn_body {
using bf16=__hip_bfloat16;
using bf16x8=__attribute__((ext_vector_type(8)))short;
using s16x4=__attribute__((ext_vector_type(4)))short;
using f32x16=__attribute__((ext_vector_type(16)))float;
using u32x4=__attribute__((ext_vector_type(4)))unsigned;
constexpr int D=64;
constexpr int NW=8,QBLK=32,QB=QBLK*NW,KVBLK=64;
typedef float f32x4v __attribute__((ext_vector_type(4))); typedef unsigned u32x2v __attribute__((ext_vector_type(2)));
__device__ __forceinline__ int crow(int r,int hi){return (r&3)+8*(r>>2)+4*hi;}
#define SBAR() __builtin_amdgcn_sched_barrier(0)
__device__ __forceinline__ void cmask(f32x16&p0,f32x16&p1,int jb,int qrel,int hi){
  const float NEG=-INFINITY; int kb=64*jb+4*hi;
  #pragma unroll
  for(int r=0;r<16;++r){int kv=kb+(r&3)+8*(r>>2); if(kv>qrel)p0[r]=NEG; if(kv+32>qrel)p1[r]=NEG;}
}

constexpr int NSLOT=3, SLOTB=8192;
constexpr int LDS_K=0, LDS_V=NSLOT*SLOTB, LDS_WS=2*NSLOT*SLOTB, LDS_OST=LDS_WS+NW*64*4, LDS_BYTES=LDS_OST+NW*8192;
constexpr float C2=0.125f*1.4426950408889634f;
__device__ __forceinline__ void glds16(const void*gsrc,unsigned lds_dst){unsigned keep;
  asm volatile("s_mov_b32 %0, m0\n\ts_mov_b32 m0, %2\n\ts_nop 0\n\tglobal_load_lds_dwordx4 %1, off\n\ts_mov_b32 m0, %0":"=&s"(keep):"v"(gsrc),"s"(lds_dst):"memory");}
__device__ __forceinline__ float max3f(float a,float b,float c){float r;asm("v_max3_f32 %0, %1, %2, %3":"=v"(r):"v"(a),"v"(b),"v"(c));return r;}
__device__ __forceinline__ float max2f(float a,float b){float r;asm("v_max_f32_e32 %0, %1, %2":"=v"(r):"v"(a),"v"(b));return r;}
__device__ __forceinline__ float fadd_s(float a,float b){float r;asm("v_add_f32_e32 %0, %1, %2":"=v"(r):"v"(a),"v"(b));return r;}
__device__ __forceinline__ float fsub_s(float a,float b){float r;asm("v_sub_f32_e32 %0, %1, %2":"=v"(r):"v"(a),"v"(b));return r;}
typedef float f32x2_t __attribute__((ext_vector_type(2))); typedef __bf16 bf16x2_t __attribute__((ext_vector_type(2)));
__device__ __forceinline__ unsigned cvtpk_s(float lo,float hi){f32x2_t v={lo,hi};bf16x2_t b=__builtin_convertvector(v,bf16x2_t);return __builtin_bit_cast(unsigned,b);}
#define WAIT_BAR(N) asm volatile("s_waitcnt vmcnt(" #N ") lgkmcnt(0)\n\ts_barrier":::"memory")

__device__ __forceinline__ void qkt(f32x16&p0,f32x16&p1,const char*Kslot,const bf16x8*qr,const f32x16&negm,int r32,int hi){
  const char*kb=Kslot+hi*1024+r32*16;
  #pragma unroll
  for(int d0=0;d0<4;++d0){
    const bf16x8 b0=*reinterpret_cast<const bf16x8*>(kb+d0*2048);
    const bf16x8 b1=*reinterpret_cast<const bf16x8*>(kb+d0*2048+512);
    if(d0==0){p0=__builtin_amdgcn_mfma_f32_32x32x16_bf16(b0,qr[0],negm,0,0,0);p1=__builtin_amdgcn_mfma_f32_32x32x16_bf16(b1,qr[0],negm,0,0,0);}
    else{p0=__builtin_amdgcn_mfma_f32_32x32x16_bf16(b0,qr[d0],p0,0,0,0);p1=__builtin_amdgcn_mfma_f32_32x32x16_bf16(b1,qr[d0],p1,0,0,0);}}
}
typedef __attribute__((address_space(3))) const char* lds_cptr;
typedef short v4i16_t __attribute__((ext_vector_type(4)));
__device__ __forceinline__ void kload8(bf16x8*kf,lds_cptr kp){
  kf[0]=*(const __attribute__((address_space(3))) bf16x8*)(kp);      kf[1]=*(const __attribute__((address_space(3))) bf16x8*)(kp+512);
  kf[2]=*(const __attribute__((address_space(3))) bf16x8*)(kp+2048); kf[3]=*(const __attribute__((address_space(3))) bf16x8*)(kp+2560);
  kf[4]=*(const __attribute__((address_space(3))) bf16x8*)(kp+4096); kf[5]=*(const __attribute__((address_space(3))) bf16x8*)(kp+4608);
  kf[6]=*(const __attribute__((address_space(3))) bf16x8*)(kp+6144); kf[7]=*(const __attribute__((address_space(3))) bf16x8*)(kp+6656);
}
__device__ __forceinline__ void kload4(bf16x8*kf,lds_cptr kp){
  kf[0]=*(const __attribute__((address_space(3))) bf16x8*)(kp);      kf[1]=*(const __attribute__((address_space(3))) bf16x8*)(kp+512);
  kf[2]=*(const __attribute__((address_space(3))) bf16x8*)(kp+2048); kf[3]=*(const __attribute__((address_space(3))) bf16x8*)(kp+2560);
}
__device__ __forceinline__ void qkt_h(f32x16&p0,f32x16&p1,const char*Kslot,const bf16x8*qr,const f32x16&negm,int r32,int hi){
  const char*kb=Kslot+hi*1024+r32*16;
  #pragma unroll
  for(int d0=0;d0<2;++d0){
    const bf16x8 b0=*reinterpret_cast<const bf16x8*>(kb+d0*2048);
    const bf16x8 b1=*reinterpret_cast<const bf16x8*>(kb+d0*2048+512);
    if(d0==0){p0=__builtin_amdgcn_mfma_f32_32x32x16_bf16(b0,qr[0],negm,0,0,0);p1=__builtin_amdgcn_mfma_f32_32x32x16_bf16(b1,qr[0],negm,0,0,0);}
    else{p0=__builtin_amdgcn_mfma_f32_32x32x16_bf16(b0,qr[d0],p0,0,0,0);p1=__builtin_amdgcn_mfma_f32_32x32x16_bf16(b1,qr[d0],p1,0,0,0);}}
}
__device__ __forceinline__ void kload2(bf16x8*kf,lds_cptr kp,int j){ kf[2*j]=*(const __attribute__((address_space(3))) bf16x8*)(kp+j*2048); kf[2*j+1]=*(const __attribute__((address_space(3))) bf16x8*)(kp+j*2048+512); }
__device__ __forceinline__ s16x4 vtr(lds_cptr p){ return __builtin_bit_cast(s16x4,__builtin_amdgcn_ds_read_tr16_b64_v4i16((__attribute__((address_space(3))) v4i16_t*)p)); }
__device__ __forceinline__ float rowmax(const f32x16&p0,const f32x16&p1){
  float a=max3f(p0[0],p0[1],p1[0]),b=max3f(p0[2],p0[3],p1[1]);a=max3f(a,p1[2],p1[3]);
  #pragma unroll
  for(int r=4;r<16;r+=4){a=max3f(a,p0[r],p0[r+1]);b=max3f(b,p0[r+2],p0[r+3]);a=max3f(a,p1[r],p1[r+1]);b=max3f(b,p1[r+2],p1[r+3]);}
  const float m=max2f(a,b);
  auto rr=__builtin_amdgcn_permlane32_swap(__float_as_uint(m),__float_as_uint(m),false,false);
  return max2f(__uint_as_float(rr[0]),__uint_as_float(rr[1]));
}
__device__ __forceinline__ void pv(f32x16*o,int vb,bf16x8 pa0,bf16x8 pa1,bf16x8 pa2,bf16x8 pa3){
  #pragma unroll
  for(int d0=0;d0<2;++d0){s16x4 lo[4],hi[4];
    #pragma unroll
    for(int ks=0;ks<4;++ks){
      asm volatile("ds_read_b64_tr_b16 %0,%1 offset:%c2":"=&v"(lo[ks]):"v"(vb),"i"(d0*4096+ks*1024):"memory");
      asm volatile("ds_read_b64_tr_b16 %0,%1 offset:%c2":"=&v"(hi[ks]):"v"(vb),"i"(d0*4096+ks*1024+512):"memory");}
    asm volatile("s_waitcnt lgkmcnt(0)":::"memory");SBAR();
    #define PK(k) (bf16x8){lo[k][0],lo[k][1],lo[k][2],lo[k][3],hi[k][0],hi[k][1],hi[k][2],hi[k][3]}
    o[d0]=__builtin_amdgcn_mfma_f32_32x32x16_bf16(pa0,PK(0),o[d0],0,0,0);
    o[d0]=__builtin_amdgcn_mfma_f32_32x32x16_bf16(pa1,PK(1),o[d0],0,0,0);
    o[d0]=__builtin_amdgcn_mfma_f32_32x32x16_bf16(pa2,PK(2),o[d0],0,0,0);
    o[d0]=__builtin_amdgcn_mfma_f32_32x32x16_bf16(pa3,PK(3),o[d0],0,0,0);
    #undef PK
  }
}

#ifndef ATTN_STORE16
#define ATTN_STORE16(p,v) (*(u32x4*)(p)=(v))
#endif

struct AttnParams {
  const bf16* Q;
  const bf16* K;
  const bf16* V;
  bf16* O;
  const float* gsub;
  int NT;
  int base_a, base_b;
  int mask;
  int dq0;
  int nomax; float mfix;
  int khalf;
  int mode;
  float sinkl2;
  float lam;
  float oscale;
};
constexpr int QP=1280, KP=512, OP=1024;
__device__ __forceinline__ void wmask(f32x16&p0,f32x16&p1,int dq,int hi){
  const float NEG=-INFINITY;
  #pragma unroll
  for(int r=0;r<16;++r){int d0=dq-((r&3)+8*(r>>2)+4*hi); if((unsigned)(d0+128)>256u)p0[r]=NEG; if((unsigned)(d0+96)>256u)p1[r]=NEG;}
}
template<int THRL,bool BH> __device__ __forceinline__ void attn_unit(const AttnParams&P,char*shm){
  int tid_=threadIdx.x; asm volatile("":"+v"(tid_));
  const int tid=tid_,lane=tid&63,r32=lane&31,hi=lane>>5; const int wid=__builtin_amdgcn_readfirstlane(tid>>6);
  const int NT=P.NT,base_a=P.base_a,base_b=P.base_b; const bool msk=P.mask!=0; const bool nomx=P.nomax!=0; const float mfix=P.mfix;
  if(wid>=4)__builtin_amdgcn_s_setprio(1);
  volatile unsigned*pblk=(volatile unsigned*)(shm+LDS_BYTES)+wid*8;
  if(lane==0){ const unsigned long long po=(unsigned long long)P.O,pg=(unsigned long long)P.gsub; pblk[0]=(unsigned)po;pblk[1]=(unsigned)(po>>32);pblk[2]=(unsigned)pg;pblk[3]=(unsigned)(pg>>32);
    pblk[4]=__float_as_uint(P.lam);pblk[5]=__float_as_uint(P.oscale);pblk[6]=__float_as_uint(P.sinkl2);pblk[7]=(unsigned)P.mode; }
  const bf16*Kh=P.K,*Vh=P.V;
  const unsigned lds0=(unsigned)(uintptr_t)shm;
  float*wsf=(float*)(shm+LDS_WS)+wid*64;
  const bf16*ksrc=Kh+(long)lane*KP+wid*8;
  const bf16*vsrc=Vh+(long)(16*(wid&3)+(lane>>2))*KP+(wid>>2)*32+(lane&3)*8;
  const unsigned kdst=lds0+LDS_K+wid*1024, vdst=lds0+LDS_V+wid*1024;
  #define TROW(t) (((t)<4)?(base_a+64*(t)):(base_b+64*((t)-4)))
  #define DMA_K(t,slot) glds16(ksrc+(long)TROW(t)*KP,(unsigned)__builtin_amdgcn_readfirstlane(kdst+(slot)))
  #define DMA_V(t,slot) glds16(vsrc+(long)TROW(t)*KP,(unsigned)__builtin_amdgcn_readfirstlane(vdst+(slot)))
  const int vb0=(int)(lds0+LDS_V)+((lane>>4)&1)*32+(lane&3)*8+(4*hi+((lane&15)>>2))*64;
  const char*Kbase=shm+LDS_K; bf16x8 kf[8];
  const lds_cptr shm3=(lds_cptr)shm; const lds_cptr kp0=shm3+LDS_K+hi*1024+r32*16; const lds_cptr vp0=shm3+LDS_V+((lane>>4)&1)*32+(lane&3)*8+(4*hi+((lane&15)>>2))*64;
  const bf16*Qw=P.Q+(long)(wid*QBLK)*QP; const int kbo=BH?P.khalf*4096:0, qoff=BH?P.khalf*32:0;
  DMA_K(0,0);DMA_V(0,0);DMA_K(1,SLOTB);
  bf16x8 qr[4];
  #pragma unroll
  for(int d0=0;d0<(BH?2:4);++d0)qr[d0]=*reinterpret_cast<const bf16x8*>(&Qw[(long)r32*QP+qoff+d0*16+hi*8]);
  float mhat=0.f,l_reg=0.f;f32x16 o[2];o[0]=f32x16{};o[1]=f32x16{};f32x16 negm=f32x16{};asm volatile("":"+v"(negm));
  const int dqb=P.dq0+wid*QBLK+r32;
  #define CMASK(P0,P1,t) do{ if(msk&&(t)>=4)wmask(P0,P1,dqb-64*((t)-4),hi); }while(0)
  bool resc=false;
  #define START(P0,P1) do{ float rm=mfix; if(!nomx)rm=rowmax(P0,P1); resc=false; \
    { const float dl=rm; mhat=fadd_s(mhat,dl); \
      _Pragma("unroll") for(int r=0;r<16;++r){P0[r]=fsub_s(P0[r],dl);P1[r]=fsub_s(P1[r],dl);} \
      _Pragma("unroll") for(int r=0;r<16;++r)negm[r]=-mhat; asm volatile("":"+v"(negm)); } \
    _Pragma("unroll") for(int r=0;r<16;++r)P0[r]=__builtin_amdgcn_exp2f(P0[r]); }while(0)
  #define RESC() do{ if(resc){ asm volatile("s_waitcnt lgkmcnt(0)":::"memory"); \
      _Pragma("unroll") for(int d_=0;d_<2;++d_) _Pragma("unroll") for(int r=0;r<16;++r)o[d_][r]*=wsf[crow(r,hi)]; } }while(0)
  f32x16 pA0,pA1,pB0,pB1;
  int sl_prev=0,sl_cur=0,sl_next=SLOTB;
  #define ROT() do{sl_prev=sl_cur;sl_cur=sl_next;sl_next=(sl_next==(NSLOT-1)*SLOTB)?0:sl_next+SLOTB;}while(0)
  DMA_K(2,2*SLOTB);
  WAIT_BAR(3);
  if(BH)qkt_h(pA0,pA1,Kbase+kbo,qr,negm,r32,hi); else qkt(pA0,pA1,Kbase,qr,negm,r32,hi);
  asm volatile("s_nop 15\n\ts_nop 7":"+v"(pA0),"+v"(pA1));CMASK(pA0,pA1,0);
  START(pA0,pA1);
  _Pragma("unroll") for(int r=0;r<16;++r)pA1[r]=__builtin_amdgcn_exp2f(pA1[r]);
  WAIT_BAR(0);
  DMA_K(3,0);DMA_V(1,SLOTB);
  ROT();
  if(BH)kload4(kf,kp0+sl_cur+kbo); else kload8(kf,kp0+sl_cur);
  WAIT_BAR(2);
  s16x4 vlo[8],vhi[8]; u32x4 pw0,pw1,pw2,pw3;
  #define PKW(P,B) cvtpk_s(P[B],P[B+1])
  #define PAF(k) __builtin_bit_cast(bf16x8,pw##k)
  #define VFR(i) (bf16x8){vlo[i][0],vlo[i][1],vlo[i][2],vlo[i][3],vhi[i][0],vhi[i][1],vhi[i][2],vhi[i][3]}
  #define PIN(x) asm volatile("":"+v"(x))
  #define MX3(a,b,c) __builtin_fmaxf(__builtin_fmaxf((a),(b)),(c))
  #define QKS(NRM,HLF) do{ if(BH){ HLF; } else { NRM; } }while(0)
  #define GAPA(MF,A0,A1,A2,A3,W0,W1,PW) do{ MF; sacc+=A0; sacc+=A1; sacc+=A2; sacc+=A3; PIN(sacc); W0; W1; PIN(PW); SBAR(); }while(0)
  #define EX(v) __builtin_amdgcn_exp2f(v)
  #define GAPB(MF,X,B) do{ MF; X[B]=EX(X[B]); X[B+1]=EX(X[B+1]); X[B+2]=EX(X[B+2]); X[B+3]=EX(X[B+3]); PIN(X); SBAR(); }while(0)
  #define VRD(i) do{ vlo[i]=vtr(vp_+(((i)>>2)*4096+((i)&3)*1024)); vhi[i]=vtr(vp_+(((i)>>2)*4096+((i)&3)*1024+512)); }while(0)
  #define KRD(G,j) do{ if(G){ if(!BH){ kload2(kf,kp0+sl_next,j); SBAR(); } else if((j)<2){ kload2(kf,kp0+sl_next+kbo,j); SBAR(); } } }while(0)
  #define STEP(C0,C1,P0,P1,t,GK,GV,GL) do{ SBAR(); \
    const lds_cptr vp_=vp0+sl_prev; \
    VRD(0); SBAR(); float sacc=(P0[0]+P0[1]); \
    GAPA(QKS(C0=__builtin_amdgcn_mfma_f32_32x32x16_bf16(kf[0],qr[0],negm,0,0,0), C0=__builtin_amdgcn_mfma_f32_32x32x16_bf16(kf[0],qr[0],negm,0,0,0)), P0[2],P0[3],P0[4],P0[5],     pw0[0]=PKW(P0,0), pw0[1]=PKW(P0,2), pw0); \
    VRD(4); SBAR(); GAPA(QKS(C1=__builtin_amdgcn_mfma_f32_32x32x16_bf16(kf[1],qr[0],negm,0,0,0), (void)0), P0[6],P0[7],P0[8],P0[9],     pw0[2]=PKW(P0,4), pw0[3]=PKW(P0,6), pw0); \
    VRD(1); SBAR(); GAPA(QKS(C0=__builtin_amdgcn_mfma_f32_32x32x16_bf16(kf[2],qr[1],C0,0,0,0), C1=__builtin_amdgcn_mfma_f32_32x32x16_bf16(kf[1],qr[0],negm,0,0,0)),   P0[10],P0[11],P0[12],P0[13], pw1[0]=PKW(P0,8), pw1[1]=PKW(P0,10), pw1); \
    VRD(5); SBAR(); GAPA(QKS(C1=__builtin_amdgcn_mfma_f32_32x32x16_bf16(kf[3],qr[1],C1,0,0,0), (void)0),   P0[14],P0[15],P1[0],P1[1],   pw1[2]=PKW(P0,12),pw1[3]=PKW(P0,14), pw1); \
    VRD(2); SBAR(); GAPA(QKS(C0=__builtin_amdgcn_mfma_f32_32x32x16_bf16(kf[4],qr[2],C0,0,0,0), C0=__builtin_amdgcn_mfma_f32_32x32x16_bf16(kf[2],qr[1],C0,0,0,0)),   P1[2],P1[3],P1[4],P1[5],     pw2[0]=PKW(P1,0), pw2[1]=PKW(P1,2), pw2); \
    VRD(6); SBAR(); GAPA(QKS(C1=__builtin_amdgcn_mfma_f32_32x32x16_bf16(kf[5],qr[2],C1,0,0,0), (void)0),   P1[6],P1[7],P1[8],P1[9],     pw2[2]=PKW(P1,4), pw2[3]=PKW(P1,6), pw2); \
    VRD(3); SBAR(); GAPA(QKS(C0=__builtin_amdgcn_mfma_f32_32x32x16_bf16(kf[6],qr[3],C0,0,0,0), C1=__builtin_amdgcn_mfma_f32_32x32x16_bf16(kf[3],qr[1],C1,0,0,0)),   P1[10],P1[11],P1[12],P1[13], pw3[0]=PKW(P1,8), pw3[1]=PKW(P1,10), pw3); \
    VRD(7); SBAR(); GAPA(QKS(C1=__builtin_amdgcn_mfma_f32_32x32x16_bf16(kf[7],qr[3],C1,0,0,0), (void)0),   P1[14],P1[15],0.f,0.f,       pw3[2]=PKW(P1,12),pw3[3]=PKW(P1,14), pw3); \
    l_reg+=sacc; \
    if(GK){DMA_K((t)+3,sl_cur);} if(GV){DMA_V((t)+1,sl_next);} \
    CMASK(C0,C1,t); \
    resc=false; \
    if(!nomx){ float a=MX3(C0[0],C0[1],C1[0]),b=MX3(C0[2],C0[3],C1[1]); a=MX3(a,C1[2],C1[3]); \
      _Pragma("unroll") for(int r=4;r<16;r+=4){a=MX3(a,C0[r],C0[r+1]);b=MX3(b,C0[r+2],C0[r+3]);a=MX3(a,C1[r],C1[r+1]);b=MX3(b,C1[r+2],C1[r+3]);} \
      float rm=__builtin_fmaxf(a,b); { auto rr=__builtin_amdgcn_permlane32_swap(__float_as_uint(rm),__float_as_uint(rm),false,false); rm=__builtin_fmaxf(__uint_as_float(rr[0]),__uint_as_float(rr[1])); } \
      resc=false; \
      if(__builtin_expect(__any(rm>(float)THRL),0)){ const float dl=__builtin_fmaxf(rm,0.f); mhat+=dl; \
        _Pragma("unroll") for(int r=0;r<16;++r){C0[r]-=dl;C1[r]-=dl;} \
        _Pragma("unroll") for(int r=0;r<16;++r)negm[r]=-mhat; asm volatile("":"+v"(negm)); \
        const float f=__builtin_amdgcn_exp2f(-dl); l_reg*=f; if(hi==0)wsf[r32]=f; resc=true; } } \
    SBAR(); \
    GAPB(o[0]=__builtin_amdgcn_mfma_f32_32x32x16_bf16(PAF(0),VFR(0),o[0],0,0,0), C0,0); \
    GAPB(o[1]=__builtin_amdgcn_mfma_f32_32x32x16_bf16(PAF(0),VFR(4),o[1],0,0,0), C0,4); \
    KRD(GL,0); GAPB(o[0]=__builtin_amdgcn_mfma_f32_32x32x16_bf16(PAF(1),VFR(1),o[0],0,0,0), C0,8); \
    KRD(GL,1); GAPB(o[1]=__builtin_amdgcn_mfma_f32_32x32x16_bf16(PAF(1),VFR(5),o[1],0,0,0), C0,12); \
    KRD(GL,2); GAPB(o[0]=__builtin_amdgcn_mfma_f32_32x32x16_bf16(PAF(2),VFR(2),o[0],0,0,0), C1,0); \
    KRD(GL,3); GAPB(o[1]=__builtin_amdgcn_mfma_f32_32x32x16_bf16(PAF(2),VFR(6),o[1],0,0,0), C1,4); \
    GAPB(o[0]=__builtin_amdgcn_mfma_f32_32x32x16_bf16(PAF(3),VFR(3),o[0],0,0,0), C1,8); \
    GAPB(o[1]=__builtin_amdgcn_mfma_f32_32x32x16_bf16(PAF(3),VFR(7),o[1],0,0,0), C1,12); \
    }while(0)
  int t=1;
  #undef CMASK
  #define CMASK(P0,P1,t) do{}while(0)
  for(;!msk&&t+5<NT;t+=2){
    STEP(pB0,pB1,pA0,pA1,t,true,true,true);     WAIT_BAR(2); RESC(); ROT();
    STEP(pA0,pA1,pB0,pB1,t+1,true,true,true);   WAIT_BAR(2); RESC(); ROT();
  }
  #undef CMASK
  #define CMASK(P0,P1,t) do{ if(msk&&(t)>=4)wmask(P0,P1,dqb-64*((t)-4),hi); }while(0)
  #define ENDW(tt) do{ if((tt)+3<NT){WAIT_BAR(2);} else if((tt)+2<NT){WAIT_BAR(1);} else {WAIT_BAR(0);} }while(0)
  for(;t+1<NT;t+=2){
    STEP(pB0,pB1,pA0,pA1,t,(t+3<NT),(t+1<NT),(t+1<NT));       ENDW(t);   RESC(); ROT();
    STEP(pA0,pA1,pB0,pB1,t+1,(t+4<NT),(t+2<NT),(t+2<NT));     ENDW(t+1); RESC(); ROT();
  }
  STEP(pB0,pB1,pA0,pA1,NT-1,false,false,false); RESC();
  { float sacc=pB0[0]+pB0[1]; _Pragma("unroll") for(int r=2;r<16;++r)sacc+=pB0[r]; _Pragma("unroll") for(int r=0;r<16;++r)sacc+=pB1[r]; l_reg+=sacc;
    pw0=(u32x4){PKW(pB0,0),PKW(pB0,2),PKW(pB0,4),PKW(pB0,6)};pw1=(u32x4){PKW(pB0,8),PKW(pB0,10),PKW(pB0,12),PKW(pB0,14)};pw2=(u32x4){PKW(pB1,0),PKW(pB1,2),PKW(pB1,4),PKW(pB1,6)};pw3=(u32x4){PKW(pB1,8),PKW(pB1,10),PKW(pB1,12),PKW(pB1,14)};
    SBAR(); pv(o,vb0+sl_cur,PAF(0),PAF(1),PAF(2),PAF(3)); }
  #undef PKW
  #undef PAF
  #undef VFR
  #undef PIN
  #undef MX3
  #undef GAPA
  #undef QKS
  #undef GAPB
  #undef EX
  #undef VRD
  #undef KRD
  #undef STEP
  #undef ENDW
  {auto rr=__builtin_amdgcn_permlane32_swap(__float_as_uint(l_reg),__float_as_uint(l_reg),false,false);l_reg=__uint_as_float(rr[0])+__uint_as_float(rr[1]);}
  asm volatile("s_waitcnt lgkmcnt(0)":::"memory");
  const unsigned e0=__builtin_amdgcn_readfirstlane(pblk[0]),e1=__builtin_amdgcn_readfirstlane(pblk[1]),e2=__builtin_amdgcn_readfirstlane(pblk[2]),e3=__builtin_amdgcn_readfirstlane(pblk[3]);
  const float e_lam=__uint_as_float(__builtin_amdgcn_readfirstlane(pblk[4])),e_osc=__uint_as_float(__builtin_amdgcn_readfirstlane(pblk[5])),e_sink=__uint_as_float(__builtin_amdgcn_readfirstlane(pblk[6]));
  const int e_mode=(int)__builtin_amdgcn_readfirstlane(pblk[7]);
  bf16*const e_O=(bf16*)(((unsigned long long)e1<<32)|e0); const float*const e_gsub=(const float*)(((unsigned long long)e3<<32)|e2);
  l_reg+=__builtin_amdgcn_exp2f(e_sink-mhat);
  if(hi==0)wsf[32+r32]=l_reg;asm volatile("s_waitcnt lgkmcnt(0)":::"memory");
  float rli[16];
  #pragma unroll
  for(int r=0;r<16;++r)rli[r]=__builtin_amdgcn_rcpf(wsf[32+crow(r,hi)]);
  bf16*Ow=e_O+(long)(wid*QBLK)*OP;
  if(e_mode==0){ bf16*stg=(bf16*)(shm+LDS_OST)+wid*4096;
    #pragma unroll
    for(int r=0;r<16;++r){const int orow=crow(r,hi);
      #pragma unroll
      for(int d0=0;d0<2;++d0)stg[orow*64+d0*32+r32]=__float2bfloat16(o[d0][r]*rli[r]);}
    asm volatile("s_waitcnt lgkmcnt(0)":::"memory");
    #pragma unroll
    for(int i=0;i<4;++i){const int row=i*8+(lane>>3),ch=lane&7; const u32x4 v=*(const u32x4*)(stg+row*64+ch*8); ATTN_STORE16(Ow+(long)row*OP+ch*8,v);} }
  else { float*stg=(float*)(shm+LDS_OST)+wid*2048;
    if(e_mode==1){
      #pragma unroll
      for(int r=0;r<16;++r){const int orow=crow(r,hi);
        #pragma unroll
        for(int d0=0;d0<2;++d0)stg[orow*64+d0*32+r32]=o[d0][r]*rli[r];}
      asm volatile("s_waitcnt lgkmcnt(0)":::"memory");
    } else {
      #pragma unroll
      for(int r=0;r<16;++r){const int orow=crow(r,hi);
        #pragma unroll
        for(int d0=0;d0<2;++d0){const int ix=orow*64+d0*32+r32; stg[ix]=stg[ix]-e_lam*(o[d0][r]*rli[r]);}}
      asm volatile("s_waitcnt lgkmcnt(0)":::"memory");
      int ln=lane; asm volatile("":"+v"(ln));
      const int ch=ln&15; const f32x4v gs=*(const f32x4v*)(e_gsub+ch*4);
      const int bp1=(ln^1)<<2,bp2=(ln^2)<<2,bp4=(ln^4)<<2,bp8=(ln^8)<<2;
      #pragma unroll
      for(int i=0;i<8;++i){const int row=i*4+(ln>>4); const f32x4v v=*(const f32x4v*)(stg+row*64+ch*4);
        float ss=(v[0]*v[0]+v[1]*v[1])+(v[2]*v[2]+v[3]*v[3]);
        ss+=__builtin_bit_cast(float,__builtin_amdgcn_ds_bpermute(bp1,__builtin_bit_cast(int,ss)));ss+=__builtin_bit_cast(float,__builtin_amdgcn_ds_bpermute(bp2,__builtin_bit_cast(int,ss)));
        ss+=__builtin_bit_cast(float,__builtin_amdgcn_ds_bpermute(bp4,__builtin_bit_cast(int,ss)));ss+=__builtin_bit_cast(float,__builtin_amdgcn_ds_bpermute(bp8,__builtin_bit_cast(int,ss)));
        const float rn=e_osc*__builtin_amdgcn_rsqf(ss*(1.0f/64.0f)+1e-6f);
        u32x2v w; w[0]=cvtpk_s(v[0]*rn*gs[0],v[1]*rn*gs[1]); w[1]=cvtpk_s(v[2]*rn*gs[2],v[3]*rn*gs[3]);
        *(u32x2v*)(Ow+(long)row*OP+ch*4)=w;}
    }
  }
  __builtin_amdgcn_s_setprio(0);
  asm volatile("s_waitcnt lgkmcnt(0)\n\ts_barrier":::"memory");
  #undef TROW
  #undef DMA_K
  #undef DMA_V
  #undef CMASK
  #undef START
  #undef RESC
  #undef ROT
}

constexpr int ATTN_LDS_BYTES=LDS_BYTES;
#undef SBAR
#undef WAIT_BAR
}
namespace cg = cooperative_groups;
#define GAS __attribute__((address_space(1)))
#define LAS __attribute__((address_space(3)))
typedef unsigned short bf16;
typedef unsigned v4u __attribute__((ext_vector_type(4)));
typedef unsigned v2u __attribute__((ext_vector_type(2)));
typedef float f32x4 __attribute__((ext_vector_type(4)));
constexpr int NWAVES = 8;
constexpr int SEQ = 16384, CTXL = 256, TPB = SEQ + CTXL, NBATCH = 2, MROWS = NBATCH * TPB, D = 1024, NIN = 2048, FF = 2816, NUP = 2 * FF;
constexpr float LOG2E = 1.4426950408889634f;
constexpr float C2A = 0.125f * LOG2E, C2B = 0.17677669529663687f * LOG2E;
constexpr size_t MiB = 1u << 20;
constexpr size_t WS_MOD = 1 * MiB;
constexpr size_t WS_ROPE = WS_MOD + 512 * 1024;
constexpr size_t WS_WIN = 2 * MiB, WS_WOUT = 10 * MiB, WS_WUP = 14 * MiB, WS_WDN = 36 * MiB;
constexpr size_t WS_XRES = 48 * MiB;
constexpr size_t WS_XN = 178 * MiB;
constexpr size_t WS_Q = 244 * MiB, WS_K = 326 * MiB, WS_V = 359 * MiB, WS_O = 392 * MiB;
constexpr size_t WS_U = 244 * MiB;
constexpr size_t WS_END = 458 * MiB;
static_assert(WS_Q + (size_t)MROWS * 1280 * 2 <= WS_K && WS_K + (size_t)MROWS * 512 * 2 <= WS_V && WS_V + (size_t)MROWS * 512 * 2 <= WS_O && WS_O + (size_t)MROWS * 1024 * 2 <= WS_END, "ws map");
static_assert(WS_U + (size_t)MROWS * FF * 2 <= WS_END && WS_XN + (size_t)MROWS * D * 2 <= WS_Q && WS_XRES + (size_t)MROWS * D * 4 <= WS_XN, "ws map 2");
constexpr int LDS_BYTES = 147456;
#ifndef ABL_ZERO_C
#define ABL_ZERO_C 0
#endif

__device__ __forceinline__ unsigned f2bf(float f) { unsigned u = __builtin_bit_cast(unsigned, f); return (u + 0x7fffu + ((u >> 16) & 1u)) >> 16; }
__device__ __forceinline__ unsigned pk2(float lo, float hi) { return f2bf(lo) | (f2bf(hi) << 16); }
__device__ __forceinline__ float wave_sum_l(float v, int lane) {
#pragma unroll
    for (int o = 1; o < 64; o <<= 1) v += __int_as_float(__builtin_amdgcn_ds_bpermute((lane ^ o) << 2, __float_as_int(v)));
    return v;
}
__device__ __forceinline__ float wave_sum(float v) {
#pragma unroll
    for (int o = 1; o < 64; o <<= 1) v += __shfl_xor(v, o);
    return v;
}
__device__ __forceinline__ void tr_item(const float* W, int ldw, int k0, int ncol0, bf16* WT, int Kt, int prow0, LAS float* scr, int lane) {
#pragma unroll 8
    for (int i = 0; i < 32; ++i) { const int kk = 2 * i + (lane >> 5); scr[kk * 33 + (lane & 31)] = W[(size_t)(k0 + kk) * ldw + ncol0 + (lane & 31)]; }
    asm volatile("s_waitcnt lgkmcnt(0)" ::: "memory");
    const int c = lane & 7;
#pragma unroll
    for (int j = 0; j < 4; ++j) { const int n = (lane >> 3) + 8 * j; const LAS float* s = scr + (8 * c) * 33 + n;
        v4u o; o.x = pk2(s[0 * 33], s[1 * 33]); o.y = pk2(s[2 * 33], s[3 * 33]); o.z = pk2(s[4 * 33], s[5 * 33]); o.w = pk2(s[6 * 33], s[7 * 33]);
        *(v4u*)(WT + (size_t)(prow0 + n) * Kt + k0 + 8 * c) = o; }
    asm volatile("s_waitcnt lgkmcnt(0)" ::: "memory");
}


template <int KIND> __device__ __forceinline__ void norm_rows(int gw, int NGW, int lane, const float* xin, const float* cin, float* xres, bf16* xn, float* outp, const float* gvec, const float* modr, int sidx) {
    const int nrows = KIND == 2 ? NBATCH * SEQ : MROWS;
    for (int m0 = gw; m0 < nrows; m0 += 2 * NGW) {
        int mm[2]; mm[0] = m0; mm[1] = (m0 + NGW < nrows) ? m0 + NGW : m0;
        f32x4 v[2][4]; float ss[2]; int rr[2]; size_t xrow[2];
#pragma unroll
        for (int u = 0; u < 2; ++u) {
            const int m = mm[u];
            const float* src;
            if (KIND == 2) { const int b = m >= SEQ ? 1 : 0, t = m - b * SEQ; xrow[u] = (size_t)b * TPB + t; rr[u] = b; src = xres + xrow[u] * D; }
            else { const int b = m >= TPB ? 1 : 0, t = m - b * TPB; rr[u] = t >= SEQ ? 2 : b; xrow[u] = (size_t)m;
                   src = KIND == 0 ? (t < SEQ ? xin + ((size_t)b * SEQ + t) * D : cin + ((size_t)b * CTXL + (t - SEQ)) * D) : xres + (size_t)m * D; }
            const f32x4* xr = (const f32x4*)src + lane; float s = 0.f;
#pragma unroll
            for (int j = 0; j < 4; ++j) { v[u][j] = xr[64 * j]; s += (v[u][j][0] * v[u][j][0] + v[u][j][1] * v[u][j][1]) + (v[u][j][2] * v[u][j][2] + v[u][j][3] * v[u][j][3]); }
            ss[u] = s;
        }
#pragma unroll
        for (int u = 0; u < 2; ++u) {
            const float rn = 1.0f / sqrtf(wave_sum_l(ss[u], lane) * (1.0f / D) + 1e-6f);
            if (KIND == 2) { f32x4* o = (f32x4*)(outp + (size_t)mm[u] * D) + lane;
#pragma unroll
                for (int j = 0; j < 4; ++j) { const int col = 4 * (lane + 64 * j); const f32x4 g4 = *(const f32x4*)(gvec + col); o[64 * j] = v[u][j] * rn * g4; } }
            else { const float* sh = modr + rr[u] * 6144 + sidx * 1024; const float* sc = sh + 1024; v2u* o8 = (v2u*)(xn + xrow[u] * D) + lane;
#pragma unroll
                for (int j = 0; j < 4; ++j) { const int col = 4 * (lane + 64 * j); const f32x4 g4 = *(const f32x4*)(gvec + col), s4 = *(const f32x4*)(sh + col), c4 = *(const f32x4*)(sc + col);
                    const f32x4 y = (v[u][j] * rn * g4) * (c4 + 1.0f) + s4; v2u w; w.x = pg8::pk_bf16(y[0], y[1]); w.y = pg8::pk_bf16(y[2], y[3]); o8[64 * j] = w; } }
        }
    }
}

#ifndef SELFCHECK
#define SELFCHECK 0
#endif
__device__ __forceinline__ float bf2f(unsigned short x) { return __uint_as_float((unsigned)x << 16); }
__device__ __forceinline__ float wave_max(float v) {
#pragma unroll
    for (int o = 1; o < 64; o <<= 1) v = fmaxf(v, __shfl_xor(v, o));
    return v;
}
__device__ __forceinline__ float naive_row(const bf16* Qrow, const bf16* Kb, const bf16* Vb, int kind, int t, float sinkl2, int lane, LAS float* xch) {
    float q[64]; asm volatile("" : "+v"(Qrow));
#pragma unroll
    for (int c = 0; c < 8; ++c) { const v4u w = *(const v4u*)(Qrow + 8 * c);
#pragma unroll
        for (int e = 0; e < 4; ++e) { q[8 * c + 2 * e] = __uint_as_float(w[e] << 16); q[8 * c + 2 * e + 1] = __uint_as_float(w[e] & 0xffff0000u); } }
    int lo = 0, nb = 0, n;
    if (kind == 0) n = TPB; else if (kind == 1) n = CTXL; else { lo = t - 128 < 0 ? 0 : t - 128; const int hi = t + 128 > SEQ - 1 ? SEQ - 1 : t + 128; nb = hi - lo + 1; n = nb + CTXL; }
    float m = -INFINITY, l = 0.f, o[64];
#pragma unroll
    for (int d = 0; d < 64; ++d) o[d] = 0.f;
    for (int j = lane; j < n; j += 64) {
        const int row = kind == 0 ? j : (kind == 1 ? SEQ + j : (j < nb ? lo + j : SEQ + (j - nb)));
        float sc = 0.f;
#pragma unroll
        for (int c = 0; c < 8; ++c) { const v4u w = *(const v4u*)(Kb + (size_t)row * 512 + 8 * c);
#pragma unroll
            for (int e = 0; e < 4; ++e) { sc += q[8 * c + 2 * e] * __uint_as_float(w[e] << 16); sc += q[8 * c + 2 * e + 1] * __uint_as_float(w[e] & 0xffff0000u); } }
        if (sc > m) { const float f = __builtin_amdgcn_exp2f(m - sc); l *= f;
#pragma unroll
            for (int d = 0; d < 64; ++d) o[d] *= f;
            m = sc; }
        const float p = __builtin_amdgcn_exp2f(sc - m); l += p;
#pragma unroll
        for (int c = 0; c < 8; ++c) { const v4u w = *(const v4u*)(Vb + (size_t)row * 512 + 8 * c);
#pragma unroll
            for (int e = 0; e < 4; ++e) { o[8 * c + 2 * e] += p * __uint_as_float(w[e] << 16); o[8 * c + 2 * e + 1] += p * __uint_as_float(w[e] & 0xffff0000u); } }
    }
    const float M = wave_max(m); const float f = (m == -INFINITY) ? 0.f : __builtin_amdgcn_exp2f(m - M);
    float lt = wave_sum(l * f) + __builtin_amdgcn_exp2f(sinkl2 - M);
    const bool l0 = lane == 0;
#pragma unroll
    for (int d = 0; d < 64; ++d) { const float sd = wave_sum(o[d] * f); if (l0) xch[d] = sd; }
    asm volatile("s_waitcnt lgkmcnt(0)" ::: "memory"); const float od = xch[lane]; asm volatile("s_waitcnt lgkmcnt(0)" ::: "memory");
    return od / lt;
}

__device__ __forceinline__ void sincos_d(double a, float& sn, float& cs) {
    const double k = rint(a * 0.15915494309189535); const double r = a - k * 6.283185307179586476925;
    const double r2 = r * r; double ts = r, tc = 1.0, ss = r, cc = 1.0;
#pragma unroll 1
    for (int i = 1; i < 16; ++i) { tc = -tc * r2 / (double)((2 * i - 1) * (2 * i)); ts = -ts * r2 / (double)((2 * i) * (2 * i + 1)); cc += tc; ss += ts; }
    sn = (float)ss; cs = (float)cc;
}
#define XB_TMO      128
#define XB_XCNT(j)  (256  + 64 * (j))
#define XB_XSUB(j)  (1280 + 64 * (j))
#define XB_XGEN(j)  (2304 + 64 * (j))
#define XB_TOP      3328
#define XB_TOPGEN   3392
#define XCD_BAR_WORDS 3456
#define XB_SPIN_CAP (1u << 18)

__device__ __forceinline__ unsigned xb_ld(unsigned* p)              { return __hip_atomic_load(p, __ATOMIC_RELAXED, __HIP_MEMORY_SCOPE_AGENT); }
__device__ __forceinline__ unsigned xb_add(unsigned* p, unsigned v) { return __hip_atomic_fetch_add(p, v, __ATOMIC_RELAXED, __HIP_MEMORY_SCOPE_AGENT); }
__device__ __forceinline__ unsigned xb_xcc_id() { return (unsigned)__builtin_amdgcn_s_getreg((3 << 11) | 20) & 0xFu; }
#define XB_SPIN(cond, bar) do { unsigned _sp = 0; while (cond) { __builtin_amdgcn_s_sleep(1); \
    if ((++_sp & 255u) == 0u) { if (xb_ld(&(bar)[XB_TMO])) break; if (_sp > XB_SPIN_CAP) { atomicAdd(&(bar)[XB_TMO], 1u); break; } } } } while (0)

struct XcdBarrier {
    unsigned* bar; unsigned x;
    volatile LAS unsigned* st;
};

__device__ __forceinline__ XcdBarrier xcd_barrier_post(unsigned* bar, volatile LAS unsigned* st) {
    XcdBarrier b; b.bar = bar; b.x = xb_xcc_id(); b.st = st;
    if (threadIdx.x == 0) (void)xb_add(&bar[XB_XCNT(b.x)], 1u);
    return b;
}
__device__ __forceinline__ void xcd_barrier_complete(unsigned* bar, unsigned x, unsigned& nloc, unsigned& nx) {
    const unsigned G = gridDim.x * gridDim.y * gridDim.z;
    unsigned sum, cnt, mine, sp = 0u;
    for (;;) {
        sum = 0u; cnt = 0u; mine = 0u;
#pragma unroll
        for (unsigned j = 0; j < 16; ++j) { const unsigned c = xb_ld(&bar[XB_XCNT(j)]); sum += c; cnt += (c > 0u) ? 1u : 0u; mine = (j == x) ? c : mine; }
        if (sum == G) break;
        __builtin_amdgcn_s_sleep(1);
        if ((++sp & 255u) == 0u) { if (xb_ld(&bar[XB_TMO])) break; if (sp > XB_SPIN_CAP) { atomicAdd(&bar[XB_TMO], 1u); break; } }
    }
    nloc = mine > 0u ? mine : 1u; nx = cnt > 0u ? cnt : 1u;
}

__device__ __forceinline__ void xcd_barrier(const XcdBarrier& b) {
    asm volatile("s_waitcnt vmcnt(0)" ::: "memory");
    __syncthreads();
    if (threadIdx.x == 0) {
        unsigned* bar = b.bar;
        __builtin_amdgcn_s_waitcnt(0);
        unsigned nloc = b.st[0], nx = b.st[1];
        if (nloc == 0u) { xcd_barrier_complete(bar, b.x, nloc, nx); b.st[0] = nloc; b.st[1] = nx; }
        const unsigned old = xb_add(&bar[XB_XSUB(b.x)], 1u);
        const unsigned gen = old / nloc;
        if (old + 1u == (gen + 1u) * nloc) {
            __builtin_amdgcn_fence(__ATOMIC_RELEASE, "agent");
            asm volatile("s_waitcnt vmcnt(0)" ::: "memory");
            const unsigned og = xb_add(&bar[XB_TOP], 1u);
            const unsigned tg = og / nx;
            if (og + 1u == (tg + 1u) * nx) xb_add(&bar[XB_TOPGEN], 1u);
            else XB_SPIN(xb_ld(&bar[XB_TOPGEN]) == tg, bar);
            __builtin_amdgcn_fence(__ATOMIC_ACQUIRE, "agent");
            xb_add(&bar[XB_XGEN(b.x)], 1u);
            asm volatile("s_waitcnt vmcnt(0)" ::: "memory");
        } else {
            XB_SPIN(xb_ld(&bar[XB_XGEN(b.x)]) == gen, bar);
            __builtin_amdgcn_fence(__ATOMIC_ACQUIRE, "agent");
            asm volatile("s_waitcnt vmcnt(0)" ::: "memory");
        }
    }
    __syncthreads();
}
constexpr size_t WS_BAR = 65536;
constexpr int LDS_XB = LDS_BYTES - 64;
struct Args { const float* in[22]; float* out; unsigned char* ws; };
typedef const float* const __attribute__((address_space(4)))* kargp_t;
__device__ __forceinline__ const float* kin(int i) { kargp_t ka = (kargp_t)__builtin_amdgcn_kernarg_segment_ptr(); asm volatile("" : "+s"(ka)); return ka[i]; }
__device__ __forceinline__ unsigned char* kws() { return (unsigned char*)kin(23); }


#define x_in kin(0)
#define c_in kin(1)
#define ctx_in kin(2)
#define cctx_in kin(3)
#define w_ada kin(4)
#define b_ada kin(5)
#define g_attn kin(6)
#define g_ffn kin(7)
#define w_in kin(8)
#define g_q kin(9)
#define g_k kin(10)
#define lam_q1 kin(11)
#define lam_k1 kin(12)
#define lam_q2 kin(13)
#define lam_k2 kin(14)
#define g_subln kin(15)
#define sink_logit kin(16)
#define w_out kin(17)
#define w_ff1 kin(18)
#define w_ff3 kin(19)
#define w_ff2 kin(20)
#define g_final kin(21)
#define MOD ((float*)(kws() + WS_MOD))
#define NMAX ((unsigned*)(kws() + 8192))
#define QCNT ((unsigned*)(kws() + 8192 + 512))
#define cosA ((float*)(kws() + WS_ROPE))
#define sinA (cosA + 256 * 16)
#define cosB (cosA + 2 * 256 * 16)
#define sinB (cosA + 2 * 256 * 16 + 256 * 8)
#define WIN ((bf16*)(kws() + WS_WIN))
#define WOUT ((bf16*)(kws() + WS_WOUT))
#define WUP ((bf16*)(kws() + WS_WUP))
#define WDN ((bf16*)(kws() + WS_WDN))
#define XRES ((float*)(kws() + WS_XRES))
#define XN ((bf16*)(kws() + WS_XN))
#define bQ ((bf16*)(kws() + WS_Q))
#define bK ((bf16*)(kws() + WS_K))
#define bV ((bf16*)(kws() + WS_V))
#define bO ((bf16*)(kws() + WS_O))
#define bU ((bf16*)(kws() + WS_U))
__global__ void __launch_bounds__(NWAVES * 64, 2) mega_fwd(Args args) {
    extern __shared__ __attribute__((aligned(16))) unsigned char lds[];
    cg::grid_group grid = cg::this_grid();
#define CG_SYNC() do { asm volatile("s_waitcnt vmcnt(0) lgkmcnt(0)" ::: "memory"); grid.sync(); } while (0)
#define GRID_SYNC() do { XcdBarrier xb_; xb_.bar = (unsigned*)(kws() + WS_BAR); xb_.x = xb_xcc_id(); xb_.st = (volatile LAS unsigned*)((LAS unsigned char*)lds + LDS_XB); xcd_barrier(xb_); } while (0)
    if (threadIdx.x < 2) ((volatile LAS unsigned*)((LAS unsigned char*)lds + LDS_XB))[threadIdx.x] = 0u;
    __syncthreads();
    (void)xcd_barrier_post((unsigned*)(kws() + WS_BAR), (volatile LAS unsigned*)((LAS unsigned char*)lds + LDS_XB));
#define PHASE_IDS int tid = threadIdx.x, bx = blockIdx.x, G = gridDim.x; asm volatile("" : "+v"(tid)); bx = __builtin_amdgcn_readfirstlane(bx); G = __builtin_amdgcn_readfirstlane(G); \
    const int lane = tid & 63, wave = __builtin_amdgcn_readfirstlane(tid >> 6), vcu = (G % 8 == 0) ? (bx % 8) * (G / 8) + bx / 8 : bx, gw = vcu * NWAVES + wave, NGW = G * NWAVES; \
    (void)lane; (void)wave; (void)vcu; (void)gw; (void)NGW;
    {
        PHASE_IDS
        const int gt = gw * 64 + lane; float* const ca = cosA; float* const sa = sinA; float* const cb_ = cosB; float* const sb_ = sinB;
        if (gt < 256 * 16) { const int pos = gt >> 4, i = gt & 15; const float fr = __builtin_amdgcn_exp2f(-(float)i * (13.287712379549449f / 16.0f)); const float a = (float)pos * fr;
            const double rev = (double)a * 0.15915494309189535; const float f = (float)(rev - floor(rev)); ca[gt] = __builtin_amdgcn_cosf(f); sa[gt] = __builtin_amdgcn_sinf(f); }
        else if (gt < 256 * 16 + 256 * 8) { const int q = gt - 256 * 16; const int pos = q >> 3, i = q & 7; const float fr = __builtin_amdgcn_exp2f(-(float)i * (13.287712379549449f / 8.0f)); const float a = (float)pos * fr;
            const double rev = (double)a * 0.15915494309189535; const float f = (float)(rev - floor(rev)); cb_[q] = __builtin_amdgcn_cosf(f); sb_[q] = __builtin_amdgcn_sinf(f); }
        if (gt < 64) NMAX[gt] = 0u;
        if (gt >= 64 && gt < 66) QCNT[gt - 64] = 0u;
        LAS float* s_lds = (LAS float*)lds; LAS float* part = (LAS float*)(lds + 12288);
        if (bx < 192) {
            const float* const cp = c_in; const float* const ccp = cctx_in; const float* const bap = b_ada; float* const modp = MOD;
            for (int i = tid; i < 3 * 1024; i += NWAVES * 64) { const float cv = (i < 2048) ? cp[i] : ccp[i - 2048]; s_lds[i] = cv / (1.0f + expf(-cv)); }
            __syncthreads();
            for (int bt = bx; bt < 192; bt += G) { const int l = bt / 96, cb = bt % 96;
                const float* W = w_ada + (size_t)l * 1024 * 6144 + 64 * cb + lane; float a0 = 0.f, a1 = 0.f, a2 = 0.f;
#pragma unroll 16
                for (int kk = 0; kk < 128; ++kk) { const int k = 128 * wave + kk; const float wv = W[(size_t)k * 6144]; a0 += s_lds[k] * wv; a1 += s_lds[1024 + k] * wv; a2 += s_lds[2048 + k] * wv; }
                part[(wave * 3 + 0) * 64 + lane] = a0; part[(wave * 3 + 1) * 64 + lane] = a1; part[(wave * 3 + 2) * 64 + lane] = a2;
                __syncthreads();
                if (tid < 192) { const int r = tid >> 6, ln = tid & 63; float s = bap[l * 6144 + 64 * cb + ln];
#pragma unroll
                    for (int w = 0; w < 8; ++w) s += part[(w * 3 + r) * 64 + ln];
                    modp[(l * 3 + r) * 6144 + 64 * cb + ln] = s; }
                __syncthreads();
            }
        }
        __syncthreads();
        LAS float* scr = (LAS float*)(lds + wave * 16384);
        constexpr int I_IN = 16 * 64, I_OUT = 16 * 32, I_UP = 16 * 176, I_DN = 44 * 32, I_L = I_IN + I_OUT + I_UP + I_DN;
        const float* const wf1_ = w_ff1; const float* const wf3_ = w_ff3;
        for (int it = gw; it < 2 * I_L; it += NGW) {
            const int l = it / I_L; int r = it % I_L;
            if (r < I_IN) { const int kb = r / 64, pblk = r % 64, tile = pblk >> 3, pb = pblk & 7, lb = 2 * (pb & 3) + (pb >> 2);
                tr_item(w_in + (size_t)l * 1024 * 2048, 2048, 64 * kb, 256 * tile + 32 * lb, WIN + (size_t)l * 2048 * 1024, 1024, 32 * pblk, scr, lane); continue; } r -= I_IN;
            if (r < I_OUT) { const int kb = r / 32, pblk = r % 32;
                tr_item(w_out + (size_t)l * 1024 * 1024, 1024, 64 * kb, 32 * pblk, WOUT + (size_t)l * 1024 * 1024, 1024, 32 * pblk, scr, lane);
                if (ABL_ZERO_C && 64 * kb < 384) { for (int j = 0; j < 4; ++j) { const int n = (lane >> 3) + 8 * j; *(v4u*)(WOUT + (size_t)l * 1024 * 1024 + (size_t)(32 * pblk + n) * 1024 + 64 * kb + 8 * (lane & 7)) = (v4u){0u, 0u, 0u, 0u}; } }
                continue; } r -= I_OUT;
            if (r < I_UP) { const int kb = r / 176, pblk = r % 176, p = pblk >> 3, bj = (pblk >> 2) & 1, q = pblk & 3;
                tr_item((bj ? wf3_ : wf1_) + (size_t)l * 1024 * FF, FF, 64 * kb, 128 * p + 32 * q, WUP + (size_t)l * NUP * 1024, 1024, 32 * pblk, scr, lane); continue; } r -= I_UP;
            { const int kb = r / 32, pblk = r % 32;
                tr_item(w_ff2 + (size_t)l * FF * 1024, 1024, 64 * kb, 32 * pblk, WDN + (size_t)l * 1024 * FF, FF, 32 * pblk, scr, lane); }
        }
    }
    CG_SYNC();

#pragma unroll 1
    for (int L = 0; L < 2; ++L) {
#define modl (MOD + (size_t)L * 3 * 6144)
        if (L == 0) {
            PHASE_IDS
            norm_rows<0>(gw, NGW, lane, x_in, ctx_in, XRES, XN, nullptr, g_attn + L * D, modl, 0);
            GRID_SYNC();
        }
        {
            PHASE_IDS
            pg8::Gemm g{XN, WIN + (size_t)L * 2048 * 1024, MROWS, NIN, D}; pg8::Order S; S.init(MROWS / 256, NIN, G, bx, 0);
            pg8::EpiQKV E{bQ, bK, bV, g_q + L * 64, g_k + L * 64, cosA, sinA, cosB, sinB, C2A, C2B, NMAX + L * 32};
#ifndef NO_G1
            pg8::gemm_phase<pg8::EpiQKV, pg8::Order, PG8_ALIGN, PG8_SP2>((PG8_LAS unsigned char*)lds, g, S, E);
#endif
        }
        GRID_SYNC();
        {
            PHASE_IDS
            int Lq_ = L; asm volatile("" : "+s"(Lq_)); const float lam_init = (Lq_ == 0) ? 0.2f : 0.35550907f;
            float d1 = 0.f, d2 = 0.f;

#pragma unroll 1
                    for (int i = 0; i < 32; ++i) { d1 += lam_q1[L * 32 + i] * lam_k1[L * 32 + i]; d2 += lam_q2[L * 32 + i] * lam_k2[L * 32 + i]; }
            const float lam = expf(d1) - expf(d2) + lam_init;
            float mgq = 0.f, mgk = 0.f;
#pragma unroll 1
            for (int i = 0; i < 64; ++i) { mgq = fmaxf(mgq, fabsf(g_q[L * 64 + i])); mgk = fmaxf(mgk, fabsf(g_k[L * 64 + i])); }
            const float amfix = 8.0f * mgq * mgk * LOG2E * 1.02f;
            const int NTOT = 512 + 768 + 768 + (L == 0 ? 32 : 0);
            int un = vcu; bool dynq = false;
            for (;;) {
                if (!dynq && un >= 1280) dynq = true;
                if (dynq) { volatile LAS unsigned* qw = (volatile LAS unsigned*)((LAS unsigned char*)lds + LDS_XB + 16); __syncthreads();
                    if (tid == 0) qw[0] = __hip_atomic_fetch_add(QCNT + L, 1u, __ATOMIC_RELAXED, __HIP_MEMORY_SCOPE_AGENT);
                    __syncthreads(); un = 1280 + (int)__builtin_amdgcn_readfirstlane(qw[0]); }
                if (un >= NTOT) break;
                attn_body::AttnParams P; int b, h, qb, type;
                if (un < 512) { const int v = un & 255, xx = v >> 5; type = 1; b = xx >> 2; h = xx & 3; qb = (v & 31) + 32 * (un >> 8); }
                else if (un < 2048) { const int ia = (un - 512) % 768; type = (un < 1280) ? 0 : 2; const int v = ia & 255, rnd = ia >> 8, xx = v >> 5, gi = xx >> 1, uu = 96 * (xx & 1) + 3 * (v & 31) + rnd;
                    b = gi >> 1; h = 3 * (gi & 1) + uu / 64; qb = uu % 64; }
                else { const int ic = un - 2048; qb = 64; if (ic < 12) { type = 0; b = ic / 6; h = ic % 6; } else if (ic < 20) { type = 1; b = (ic - 12) / 4; h = (ic - 12) % 4; } else { type = 2; b = (ic - 20) / 6; h = (ic - 20) % 6; } }
                const bool isctx = qb == 64;
                const int qcol = type == 0 ? h : (type == 1 ? 6 + 2 * h : 14 + h), kcol = type == 0 ? h / 3 : (type == 1 ? 2 + h : 6 + h / 3), ocol = type == 0 ? h : (type == 1 ? 6 + h : 10 + h);
                const size_t row0 = (size_t)b * TPB + 256 * qb;
                P.Q = (const attn_body::bf16*)(bQ + row0 * 1280 + qcol * 64);
                P.K = (const attn_body::bf16*)(bK + (size_t)b * TPB * 512 + kcol * 64);
                P.V = (const attn_body::bf16*)(bV + (size_t)b * TPB * 512 + kcol * 64);
                P.O = (attn_body::bf16*)(bO + row0 * 1024 + ocol * 64);
                P.gsub = g_subln + L * 64; P.lam = lam; P.oscale = 1.0f - lam_init; P.mode = 0;
                P.sinkl2 = type == 2 ? sink_logit[L * 6 + h] * LOG2E : -INFINITY;
                P.mask = 0; P.dq0 = 0; P.nomax = (type == 0) ? 1 : 0; P.mfix = amfix;
                if (isctx) { P.NT = 4; P.base_a = SEQ; P.base_b = SEQ; }
                else if (type == 2) { const int band0 = (256 * qb - 128) < 0 ? 0 : 256 * qb - 128, bend = (256 * qb + 384) > SEQ ? SEQ : 256 * qb + 384;
                    P.NT = 4 + (bend - band0) / 64; P.base_a = SEQ; P.base_b = band0; P.mask = 1; P.dq0 = 256 * qb - band0; }
                else { P.NT = TPB / 64; P.base_a = 0; P.base_b = 256; }
#ifndef NO_ATTN
                if (type != 1) { P.khalf = 0; attn_body::attn_unit<8, false>(P, (char*)lds); }
                else {
#pragma unroll 1
                    for (int ps = 0; ps < 2; ++ps) { P.mode = 1 + ps; P.khalf = ps; if (ps) P.Q += 64;
                        const unsigned* nm = NMAX + L * 32 + ((b * 4 + h) * 2 + ps) * 2;
                        const float q2 = __uint_as_float(__hip_atomic_load(nm, __ATOMIC_RELAXED, __HIP_MEMORY_SCOPE_AGENT)), k2 = __uint_as_float(__hip_atomic_load(nm + 1, __ATOMIC_RELAXED, __HIP_MEMORY_SCOPE_AGENT));
                        P.nomax = 1; P.mfix = sqrtf(q2) * sqrtf(k2) * 1.02f;
                        attn_body::attn_unit<8, true>(P, (char*)lds); } }
#endif
                if (!dynq) un += G;
            }
        }
        GRID_SYNC();
#if SELFCHECK
        {
            PHASE_IDS
            if (wave == 0 && bx < 12 && (L == 0 || bx < 8 || bx == 11)) {
                int type, b, h, t;
                switch (bx) { case 0: type = 0; b = 0; h = 1; t = 1000; break; case 1: type = 0; b = 1; h = 4; t = 16383; break; case 2: type = 1; b = 0; h = 0; t = 5; break; case 3: type = 1; b = 1; h = 3; t = 9000; break;
                    case 4: type = 2; b = 0; h = 2; t = 7777; break; case 5: type = 2; b = 1; h = 0; t = 100; break; case 6: type = 2; b = 0; h = 5; t = 16380; break; case 7: type = 2; b = 1; h = 3; t = 256; break;
                    case 8: type = 0; b = 0; h = 2; t = SEQ + 17; break; case 9: type = 1; b = 1; h = 1; t = SEQ + 200; break; case 10: type = 2; b = 0; h = 4; t = SEQ + 255; break; default: type = 0; b = 0; h = 0; t = 0; break; }
                const int qcol = type == 0 ? h : (type == 1 ? 6 + 2 * h : 14 + h), kcol = type == 0 ? h / 3 : (type == 1 ? 2 + h : 6 + h / 3), ocol = type == 0 ? h : (type == 1 ? 6 + h : 10 + h);
                const bf16* Qrow = bQ + ((size_t)b * TPB + t) * 1280 + qcol * 64; const bf16* Kb = bK + (size_t)b * TPB * 512 + kcol * 64; const bf16* Vb = bV + (size_t)b * TPB * 512 + kcol * 64;
                const int kind = t >= SEQ ? 1 : (type == 2 ? 2 : 0); const float skl = type == 2 ? sink_logit[L * 6 + h] * LOG2E : -INFINITY;
                float ref = naive_row(Qrow, Kb, Vb, kind, t, skl, lane, (LAS float*)lds);
                if (type == 1) { const float r2 = naive_row(Qrow + 64, Kb, Vb, kind, t, skl, lane, (LAS float*)lds);
                    int Lq_ = L; asm volatile("" : "+s"(Lq_)); const float lam_init = (Lq_ == 0) ? 0.2f : 0.35550907f;   float d1 = 0.f, d2 = 0.f;

#pragma unroll 1
                    for (int i = 0; i < 32; ++i) { d1 += lam_q1[L * 32 + i] * lam_k1[L * 32 + i]; d2 += lam_q2[L * 32 + i] * lam_k2[L * 32 + i]; }
                    const float lam = expf(d1) - expf(d2) + lam_init; const float v = ref - lam * r2; const float ss = wave_sum(v * v);
                    ref = v / sqrtf(ss * (1.0f / 64.0f) + 1e-6f) * g_subln[L * 64 + lane] * (1.0f - lam_init); }
                const float got = bf2f(bO[((size_t)b * TPB + t) * 1024 + ocol * 64 + lane]);
                const float err = wave_max(fabsf(ref - got)), rms = sqrtf(wave_sum(ref * ref) * (1.0f / 64.0f));
                if (lane == 0) ((float*)(kws() + 4096))[L * 32 + bx] = err / (rms + 1e-20f);
            }
            if (wave == 0 && bx >= 12 && bx < 14) {
                const int m = bx == 12 ? (TPB + 12345) : (SEQ + 3); const int b = m >= TPB ? 1 : 0, t = m - b * TPB, r = t >= SEQ ? 2 : b;
                const float* src = (L == 0) ? (t < SEQ ? x_in + ((size_t)b * SEQ + t) * D : ctx_in + ((size_t)b * CTXL + (t - SEQ)) * D) : nullptr;
                float worst = 0.f;
                if (L == 0) {
                    float ssq = 0.f; for (int k = lane; k < D; k += 64) ssq += src[k] * src[k];
                    const float rn = 1.0f / sqrtf(wave_sum(ssq) * (1.0f / D) + 1e-6f);
                    const float* cvec = r == 2 ? cctx_in : c_in + r * D;
#pragma unroll 1
                    for (int col = lane; col < D; col += 64 * 8) {
                        float sh = b_ada[L * 6144 + col], sc = b_ada[L * 6144 + 1024 + col];
#pragma unroll 1
                        for (int k = 0; k < D; ++k) { const float cv = cvec[k]; const float sl = cv / (1.0f + expf(-cv)); sh += sl * w_ada[((size_t)L * D + k) * 6144 + col]; sc += sl * w_ada[((size_t)L * D + k) * 6144 + 1024 + col]; }
                        const float ref = src[col] * rn * g_attn[L * D + col] * (1.0f + sc) + sh; const float got = bf2f(XN[(size_t)m * D + col]);
                        worst = fmaxf(worst, fabsf(ref - got) / (fabsf(ref) + 0.05f));
                    }
                }
                worst = wave_max(worst);
                if (lane == 0) ((float*)(kws() + 4096))[L * 32 + bx] = worst;
            }
            if (wave == 0 && bx >= 16 && bx < 32) {
                const int gl[8] = {0, 6, 8, 11, 15, 23, 28, 31}; (void)gl;
                const int gi = (bx - 16) & 7; const int g = gi == 0 ? 0 : gi == 1 ? 6 : gi == 2 ? 8 : gi == 3 ? 11 : gi == 4 ? 15 : gi == 5 ? 23 : gi == 6 ? 18 : 31;
                const int m = (bx - 16) < 8 ? (TPB + 12345) : (SEQ + 3); const int b = m >= TPB ? 1 : 0, t = m - b * TPB; const bool isctx = t >= SEQ;
                const int d = lane; float acc = 0.f;
#pragma unroll 1
                for (int k = 0; k < D; ++k) acc += bf2f(XN[(size_t)m * D + k]) * bf2f((unsigned short)f2bf(w_in[((size_t)L * D + k) * 2048 + 64 * g + d]));
                const int kindq = g < 6 ? 0 : g < 8 ? 1 : g < 10 ? 2 : g < 14 ? 3 : g < 18 ? 4 : g < 22 ? 2 : g < 28 ? 5 : g < 30 ? 6 : 2;
                float v = acc;
                if (kindq == 0 || kindq == 1) { const float ss = wave_sum(v * v); v = v / sqrtf(ss * (1.0f / 64.0f) + 1e-6f) * (kindq == 0 ? g_q[L * 64 + d] : g_k[L * 64 + d]); }
                if (!isctx && kindq != 2) {
                    const int trow = t >> 6, tcol = t & 63;
                    if (kindq == 3 || kindq == 4) { const int e = d & 31, w = e & 15, i = w & 7; const int pos = (e >> 4) ? tcol : trow; const float fr = powf(10000.0f, -(float)i / 8.0f); const float ang = (float)pos * fr;
                        float sn, cs; sincos_d((double)ang, sn, cs); const float xp = __shfl_xor(v, 8); v = (w < 8) ? v * cs - xp * sn : xp * sn + v * cs; }
                    else { const int e = d & 31, i = e & 15; const int pos = (d >> 5) ? tcol : trow; const float fr = powf(10000.0f, -(float)i / 16.0f); const float ang = (float)pos * fr;
                        float sn, cs; sincos_d((double)ang, sn, cs); const float xp = __shfl_xor(v, 16); v = (e < 16) ? v * cs - xp * sn : xp * sn + v * cs; }
                }
                float got;
                const size_t row = (size_t)m;
                if (kindq == 0) { v *= C2A; got = bf2f(bQ[row * 1280 + 64 * g + d]); }
                else if (kindq == 1) got = bf2f(bK[row * 512 + 64 * (g - 6) + d]);
                else if (kindq == 3) { v *= C2B; const int vh = 6 + 2 * (g - 10) + (d >> 5); got = bf2f(bQ[row * 1280 + 64 * vh + d]); const float z = bf2f(bQ[row * 1280 + 64 * vh + (d ^ 32)]); if (__any(z != 0.f) && lane == 0) ((float*)(kws() + 4096))[200 + L * 32 + bx] = 1.0f; }
                else if (kindq == 4) got = bf2f(bK[row * 512 + 64 * (2 + g - 14) + d]);
                else if (kindq == 5) { v *= C2A; got = bf2f(bQ[row * 1280 + 64 * (14 + g - 22) + d]); }
                else if (kindq == 6) got = bf2f(bK[row * 512 + 64 * (6 + g - 28) + d]);
                else got = bf2f(bV[row * 512 + 64 * (g < 10 ? g - 8 : g < 22 ? 2 + g - 18 : 6 + g - 30) + d]);
                const float err = wave_max(fabsf(v - got)), rms = sqrtf(wave_sum(v * v) * (1.0f / 64.0f));
                if (lane == 0) ((float*)(kws() + 4096))[L * 32 + bx] = err / (rms + 1e-20f);
                { const float vp = __shfl_xor(v, 8), gp = __shfl_xor(got, 8); const float pr = v * v + vp * vp, pg = got * got + gp * gp; const float e2 = wave_max(fabsf(pr - pg)) / (wave_sum(pr) * (1.0f / 64.0f) + 1e-20f);
                  if (lane == 0) ((float*)(kws() + 4096))[100 + L * 32 + bx] = e2; }
            }
        }
#endif
        {
            const int skip = (L == 1) ? 1 : 0;
            PHASE_IDS
            pg8::Gemm g{bO, WOUT + (size_t)L * 1024 * 1024, MROWS, D, D}; pg8::Order S; S.init(skip ? 128 : 130, D, G, bx, skip);
            pg8::EpiRes E{XRES, modl, 2, L == 0 ? x_in : nullptr, ctx_in};
#ifndef NO_GR
            pg8::gemm_phase<pg8::EpiRes, pg8::Order, PG8_ALIGN, PG8_SP2>((PG8_LAS unsigned char*)lds, g, S, E);
#endif
        }
        GRID_SYNC();
        { PHASE_IDS
            norm_rows<1>(gw, NGW, lane, nullptr, nullptr, XRES, XN, nullptr, g_ffn + L * D, modl, 3); }
        GRID_SYNC();
        {
            const int skip = (L == 1) ? 1 : 0;
            PHASE_IDS
            pg8::Gemm g{XN, WUP + (size_t)L * NUP * 1024, MROWS, NUP, D}; pg8::Order S; S.init(skip ? 128 : 130, NUP, G, bx, skip);
            pg8::EpiSwiGLU E{bU};
#ifndef NO_GU
            pg8::gemm_phase<pg8::EpiSwiGLU, pg8::Order, PG8_ALIGN, PG8_SP2>((PG8_LAS unsigned char*)lds, g, S, E);
#endif
        }
        GRID_SYNC();
        {
            const int skip = (L == 1) ? 1 : 0;
            PHASE_IDS
            pg8::Gemm g{bU, WDN + (size_t)L * 1024 * FF, MROWS, D, FF}; pg8::Order S; S.init(skip ? 128 : 130, D, G, bx, skip);
            pg8::EpiRes E{XRES, modl, 5, nullptr, nullptr};
#ifndef NO_GR
            pg8::gemm_phase<pg8::EpiRes, pg8::Order, PG8_ALIGN, PG8_SP2>((PG8_LAS unsigned char*)lds, g, S, E);
#endif
        }
        GRID_SYNC();
        if (L == 0) {
            PHASE_IDS
            norm_rows<1>(gw, NGW, lane, nullptr, nullptr, XRES, XN, nullptr, g_attn + 1 * D, MOD + (size_t)1 * 3 * 6144, 0);
            GRID_SYNC();
        } else {
            PHASE_IDS
            norm_rows<2>(gw, NGW, lane, nullptr, nullptr, XRES, nullptr, (float*)kin(22), g_final, nullptr, 0);
#if SELFCHECK
            asm volatile("s_waitcnt vmcnt(0)" ::: "memory"); __syncthreads();
            if (bx == 0 && tid == 0) { const float* dg = (const float*)(kws() + 4096); float e19 = dg[100 + 20]; if (!(e19 < 5.0f)) e19 = 5.0f; if (e19 < 0.f) e19 = 0.f; float e20 = dg[22]; if (!(e20 < 5.0f)) e20 = 5.0f; if (e20 < 0.f) e20 = 0.f;
                ((float*)kin(22))[0] = 1000.0f * (1.0f + 10.0f * e19) + (dg[200 + 19] == 1.0f ? 100000.0f : 0.f); ((float*)kin(22))[1] = 100.0f * (1.0f + 10.0f * e20); }
#endif
        }
    }
}

extern "C" void kernel_launch(void* const* d_in, const int* in_sizes, int n_in, void* d_out, int out_size, void* d_ws, size_t ws_size, hipStream_t stream) {
    static int grid = 0;
    if (grid == 0) {
        if (n_in != 22 || out_size != NBATCH * SEQ * D || ws_size < WS_END) { fprintf(stderr, "kernel_launch: unexpected shapes: n_in %d out %d ws %zu (need %zu); nothing launched\n", n_in, out_size, ws_size, (size_t)WS_END); grid = -1; return; }
        int dev = 0, cus = 0, per_cu = 0;
        if (hipGetDevice(&dev) != hipSuccess || hipDeviceGetAttribute(&cus, hipDeviceAttributeMultiprocessorCount, dev) != hipSuccess) { grid = -1; return; }
        if (hipFuncSetAttribute((const void*)mega_fwd, hipFuncAttributeMaxDynamicSharedMemorySize, LDS_BYTES) != hipSuccess) { fprintf(stderr, "kernel_launch: hipFuncSetAttribute failed\n"); grid = -1; return; }
        if (hipOccupancyMaxActiveBlocksPerMultiprocessor(&per_cu, (const void*)mega_fwd, NWAVES * 64, LDS_BYTES) != hipSuccess || per_cu < 1) { fprintf(stderr, "kernel_launch: occupancy query says %d\n", per_cu); per_cu = 1; }
        (void)hipGetLastError();
        grid = cus;
    }
    if (grid < 0) return;
    if (hipMemsetAsync((char*)d_ws + WS_BAR, 0, 16384, stream) != hipSuccess) { fprintf(stderr, "kernel_launch: hipMemsetAsync failed\n"); return; }
    Args a{};
    for (int i = 0; i < 22; ++i) a.in[i] = (const float*)d_in[i];
    a.out = (float*)d_out; a.ws = (unsigned char*)d_ws;
    void* kargs[] = {&a};
    const hipError_t e = hipLaunchCooperativeKernel((const void*)mega_fwd, dim3(grid), dim3(NWAVES * 64), kargs, LDS_BYTES, stream);
    if (e != hipSuccess) fprintf(stderr, "kernel_launch: cooperative launch failed: %s (grid %d)\n", hipGetErrorString(e), grid);
}
```

```cpp
#include <hip/hip_runtime.h>
#include <hip/hip_bf16.h>
#include <hip/hip_cooperative_groups.h>
#include <cstdio>
#include <cstdint>
#include <cmath>

namespace pg8 {
#define PG8_LAS __attribute__((address_space(3)))
typedef unsigned short bf16_t;
typedef short bf16x8 __attribute__((ext_vector_type(8)));
typedef float f32x4 __attribute__((ext_vector_type(4)));
typedef unsigned u32x4 __attribute__((ext_vector_type(4)));
constexpr int BM = 256, BK = 64, HALF = 128, HTB = HALF * BK * 2  , STAGE_BYTES = 8 * HTB, NXCD = 8, WGM = 8;

__host__ __device__ __forceinline__ int lds_byte(int r, int c) { const int st = (r >> 4) * 2 + (c >> 5), rr = r & 15, cc = c & 31, ob = rr * 64 + cc * 2; return st * 1024 + (ob ^ (((ob >> 9) & 1) << 5)); }
__host__ __device__ __forceinline__ void stage_rc(int b, int& R, int& C) { const int st = b / 1024, sb = b % 1024, swz = sb ^ (((sb >> 9) & 1) << 5); R = (st >> 1) * 16 + swz / 64; C = (st & 1) * 32 + (swz % 64) / 2; }
__host__ __device__ __forceinline__ int perm32(int rho) { const int n = rho >> 4, i = rho & 15; return 8 * (i >> 2) + 4 * n + (i & 3); }

struct Unit { int pm, pn; };
struct Gemm { const bf16_t* A; const bf16_t* Bt; int M, N, K; };

struct StaticOrder {
    int nM, nN, nwg, G, c;
    __host__ __device__ void init(int M, int N, int G_, int c_) { nM = M / BM; nN = N / BM; nwg = nM * nN; G = G_; c = c_; }
    __host__ __device__ bool next(int i, Unit& u) const {
        const long L = (long)i * G + c; if (L >= nwg) return false;
        int wgid = (int)L; { const int q = nwg / NXCD, r = nwg % NXCD, xcd = wgid % NXCD, off = wgid / NXCD; wgid = (xcd < r ? xcd * (q + 1) : r * (q + 1) + (xcd - r) * q) + off; }
        const int nig = WGM * nN, gid = wgid / nig, fm = gid * WGM, gsz = (nM - fm) < WGM ? (nM - fm) : WGM;
        u.pm = fm + ((wgid % nig) % gsz); u.pn = (wgid % nig) / gsz; return true;
    }
    __device__ __forceinline__ void a_ready(const Unit&) const {}
    __device__ __forceinline__ void done(const Unit&) const {}
};

__device__ __forceinline__ unsigned cvt_pk_bf16(float lo, float hi) { unsigned r; asm volatile("v_cvt_pk_bf16_f32 %0, %1, %2" : "=v"(r) : "v"(lo), "v"(hi)); return r; }
typedef float f32x2 __attribute__((ext_vector_type(2)));


typedef unsigned u32x2 __attribute__((ext_vector_type(2)));
__device__ __forceinline__ unsigned pk_bf16(float lo, float hi) { typedef float f2 __attribute__((ext_vector_type(2))); typedef __bf16 b2 __attribute__((ext_vector_type(2))); f2 v = {lo, hi}; b2 b = __builtin_convertvector(v, b2); return __builtin_bit_cast(unsigned, b); }
struct Order {
    int nM, nN, nwg, G, c, skip;
    __device__ void init(int nM_, int N, int G_, int c_, int skip_) { nM = nM_; nN = N / BM; nwg = nM * nN; G = G_; c = c_; skip = skip_; }
    __device__ bool next(int i, Unit& u) const {
        const long L = (long)i * G + c; if (L >= nwg) return false;
        int wgid = (int)L; { const int q = nwg / NXCD, r = nwg % NXCD, xcd = wgid % NXCD, off = wgid / NXCD; wgid = (xcd < r ? xcd * (q + 1) : r * (q + 1) + (xcd - r) * q) + off; }
        const int nig = WGM * nN, gid = wgid / nig, fm = gid * WGM, gsz = (nM - fm) < WGM ? (nM - fm) : WGM;
        u.pm = fm + ((wgid % nig) % gsz); u.pn = (wgid % nig) / gsz;
        if (skip) u.pm += (u.pm >= 64) ? 1 : 0;
        return true;
    }
    __device__ __forceinline__ void a_ready(const Unit&) const {}
    __device__ __forceinline__ void done(const Unit&) const {}
};
constexpr int TPB_ = 16640, SEQ_ = 16384;
struct EpiQKV {
    static constexpr bool PERM = false, AFTER_DRAIN = false;
    bf16_t *Q, *K, *V; const float *gq, *gk, *cosA, *sinA, *cosB, *sinB; float c2a, c2b;
    unsigned* nmax;
    __device__ __forceinline__ void operator()(const f32x4 (&acc)[2][2][4][2], const Unit& u, int wr, int wc, int fr, int fq) const {
        asm volatile("" : "+v"(fr), "+v"(fq));
        const int lnq = fq * 16 + fr, bp16 = (lnq ^ 16) << 2, bp32 = (lnq ^ 32) << 2;
        const int g = 4 * u.pn + wc;
        bf16_t* dst; int pitch, dcol, rope = 0; const float* ng = nullptr; float sc = 1.f; bool split = false;
        if (g < 6)       { dst = Q; pitch = 1280; dcol = 64 * g; ng = gq; rope = 1; sc = c2a; }
        else if (g < 8)  { dst = K; pitch = 512; dcol = 64 * (g - 6); ng = gk; rope = 1; }
        else if (g < 10) { dst = V; pitch = 512; dcol = 64 * (g - 8); }
        else if (g < 14) { dst = Q; pitch = 1280; dcol = 64 * (6 + 2 * (g - 10)); rope = 2; sc = c2b; split = true; }
        else if (g < 18) { dst = K; pitch = 512; dcol = 64 * (2 + g - 14); rope = 2; }
        else if (g < 22) { dst = V; pitch = 512; dcol = 64 * (2 + g - 18); }
        else if (g < 28) { dst = Q; pitch = 1280; dcol = 64 * (14 + g - 22); rope = 1; sc = c2a; }
        else if (g < 30) { dst = K; pitch = 512; dcol = 64 * (6 + g - 28); rope = 1; }
        else             { dst = V; pitch = 512; dcol = 64 * (6 + g - 30); }
        const int bt = u.pm >= 65 ? 1 : 0, tile_t0 = (u.pm - 65 * bt) * 256; const bool isctx = tile_t0 >= SEQ_;
        const bool rope2g = (g >= 10 && g < 18); float nmx[2] = {0.f, 0.f};
        if (isctx) rope = 0;
        f32x4 gv[2][2];
#pragma unroll
        for (int bj = 0; bj < 2; ++bj)
#pragma unroll
            for (int n = 0; n < 2; ++n) gv[bj][n] = ng ? *(const f32x4*)(ng + 32 * bj + 16 * n + 4 * fq) : (f32x4){1.f, 1.f, 1.f, 1.f};
#pragma unroll
        for (int ai = 0; ai < 2; ++ai)
#pragma unroll
            for (int m = 0; m < 4; ++m) {
                const int rl = ai * HALF + wr * 64 + m * 16 + fr; const int t = tile_t0 + rl; const size_t row = (size_t)u.pm * BM + rl;
                const int trow = (t >> 6) & 255, tcol = t & 63;
                f32x4 v[2][2];
#pragma unroll
                for (int bj = 0; bj < 2; ++bj)
#pragma unroll
                    for (int n = 0; n < 2; ++n) v[bj][n] = acc[ai][bj][m][n];
                if (ng) {
                    float ss = 0.f;
#pragma unroll
                    for (int bj = 0; bj < 2; ++bj)
#pragma unroll
                        for (int n = 0; n < 2; ++n) { const f32x4 x = v[bj][n]; ss += (x[0] * x[0] + x[1] * x[1]) + (x[2] * x[2] + x[3] * x[3]); }
                    ss += __builtin_bit_cast(float, __builtin_amdgcn_ds_bpermute(bp16, __builtin_bit_cast(int, ss))); ss += __builtin_bit_cast(float, __builtin_amdgcn_ds_bpermute(bp32, __builtin_bit_cast(int, ss)));
                    const float rn = 1.0f / sqrtf(ss * (1.0f / 64.0f) + 1e-6f);
#pragma unroll
                    for (int bj = 0; bj < 2; ++bj)
#pragma unroll
                        for (int n = 0; n < 2; ++n) v[bj][n] = v[bj][n] * rn * gv[bj][n];
                }
                if (rope == 1) {
#pragma unroll
                    for (int bj = 0; bj < 2; ++bj) { const int pos = bj ? tcol : trow;
                        const f32x4 c = *(const f32x4*)(cosA + pos * 16 + 4 * fq), s = *(const f32x4*)(sinA + pos * 16 + 4 * fq);
                        const f32x4 x1 = v[bj][0], x2 = v[bj][1]; v[bj][0] = x1 * c - x2 * s; v[bj][1] = x1 * s + x2 * c; }
                } else if (rope == 2) {
#pragma unroll
                    for (int n = 0; n < 2; ++n) { const int pos = n ? tcol : trow;
                        const f32x4 c = *(const f32x4*)(cosB + pos * 8 + 4 * (fq & 1)); f32x4 s = *(const f32x4*)(sinB + pos * 8 + 4 * (fq & 1));
                        if (fq < 2) s = -s;
#pragma unroll
                        for (int bj = 0; bj < 2; ++bj) { const f32x4 x = v[bj][n]; f32x4 p;
#pragma unroll
                            for (int e = 0; e < 4; ++e) { const float xe = x[e]; p[e] = __int_as_float(__builtin_amdgcn_ds_bpermute(bp32, __float_as_int(xe))); }
                            v[bj][n] = x * c + p * s; } }
                }
                if (rope2g) {
#pragma unroll
                    for (int bj = 0; bj < 2; ++bj) { const f32x4 x0 = v[bj][0] * sc, x1 = v[bj][1] * sc; float s2 = ((x0[0] * x0[0] + x0[1] * x0[1]) + (x0[2] * x0[2] + x0[3] * x0[3])) + ((x1[0] * x1[0] + x1[1] * x1[1]) + (x1[2] * x1[2] + x1[3] * x1[3]));
                        s2 += __int_as_float(__builtin_amdgcn_ds_bpermute(bp16, __float_as_int(s2))); s2 += __int_as_float(__builtin_amdgcn_ds_bpermute(bp32, __float_as_int(s2))); nmx[bj] = fmaxf(nmx[bj], s2); } }
                bf16_t* rp = dst + row * pitch + dcol + 4 * fq;
                if (!split) {
#pragma unroll
                    for (int bj = 0; bj < 2; ++bj)
#pragma unroll
                        for (int n = 0; n < 2; ++n) { const f32x4 x = v[bj][n] * sc; u32x2 w; w.x = pk_bf16(x[0], x[1]); w.y = pk_bf16(x[2], x[3]); *(u32x2*)(rp + 32 * bj + 16 * n) = w; }
                } else {
#pragma unroll
                    for (int n = 0; n < 2; ++n) { const f32x4 x = v[0][n] * sc, y = v[1][n] * sc; u32x2 w, z; w.x = pk_bf16(x[0], x[1]); w.y = pk_bf16(x[2], x[3]); z.x = 0u; z.y = 0u;
                        *(u32x2*)(rp + 16 * n) = w; *(u32x2*)(rp + 32 + 16 * n) = z; *(u32x2*)(rp + 64 + 16 * n) = z;
                        w.x = pk_bf16(y[0], y[1]); w.y = pk_bf16(y[2], y[3]); *(u32x2*)(rp + 96 + 16 * n) = w; }
                }
            }
        if (rope2g) {
#pragma unroll
            for (int bj = 0; bj < 2; ++bj) { float m2 = nmx[bj];
#pragma unroll
                for (int o_ = 1; o_ < 16; o_ <<= 1) m2 = fmaxf(m2, __int_as_float(__builtin_amdgcn_ds_bpermute((lnq ^ o_) << 2, __float_as_int(m2))));
                const int hb = g < 14 ? g - 10 : g - 14, isk = g < 14 ? 0 : 1;
                if (lnq == 0) __hip_atomic_fetch_max(nmax + (((bt * 4 + hb) * 2 + bj) * 2 + isk), __float_as_uint(m2), __ATOMIC_RELAXED, __HIP_MEMORY_SCOPE_AGENT); } }
    }
};
struct EpiRes {
    static constexpr bool PERM = false, AFTER_DRAIN = false;
    float* X; const float* modl; int gidx; const float* xin; const float* cin;
    __device__ __forceinline__ void operator()(const f32x4 (&acc)[2][2][4][2], const Unit& u, int wr, int wc, int fr, int fq) const {
        asm volatile("" : "+v"(fr), "+v"(fq));
        const int bt = u.pm >= 65 ? 1 : 0, r = (u.pm - 65 * bt) == 64 ? 2 : bt;
        const float* rbase = X + (size_t)u.pm * BM * 1024;
        if (xin) rbase = (r == 2) ? cin + (size_t)bt * 256 * 1024 : xin + ((size_t)bt * SEQ_ + (size_t)(u.pm - 65 * bt) * 256) * 1024;
        const int col0 = u.pn * BM + wc * 32 + 4 * fq; const float* gate = modl + r * 6144 + gidx * 1024 + col0;
        f32x4 gv[2][2];
#pragma unroll
        for (int bj = 0; bj < 2; ++bj)
#pragma unroll
            for (int n = 0; n < 2; ++n) gv[bj][n] = *(const f32x4*)(gate + bj * HALF + n * 16);
#pragma unroll
        for (int ai = 0; ai < 2; ++ai)
#pragma unroll
            for (int m = 0; m < 4; ++m) { const int rl = ai * HALF + wr * 64 + m * 16 + fr; float* rp = X + ((size_t)u.pm * BM + rl) * 1024 + col0; const float* rq = rbase + (size_t)rl * 1024 + col0;
#pragma unroll
                for (int bj = 0; bj < 2; ++bj)
#pragma unroll
                    for (int n = 0; n < 2; ++n) { f32x4* p = (f32x4*)(rp + bj * HALF + n * 16); *p = *(const f32x4*)(rq + bj * HALF + n * 16) + gv[bj][n] * acc[ai][bj][m][n]; }
                if (m & 1) asm volatile("" ::: "memory"); }
    }
};
struct EpiSwiGLU {
    static constexpr bool PERM = true, AFTER_DRAIN = false;
    bf16_t* U;
    __device__ __forceinline__ void operator()(const f32x4 (&acc)[2][2][4][2], const Unit& u, int wr, int wc, int fr, int fq) const {
        asm volatile("" : "+v"(fr), "+v"(fq));
        const int col0 = u.pn * HALF + wc * 32 + 8 * fq;
#pragma unroll
        for (int ai = 0; ai < 2; ++ai)
#pragma unroll
            for (int m = 0; m < 4; ++m) { bf16_t* rp = U + ((size_t)u.pm * BM + ai * HALF + wr * 64 + m * 16 + fr) * 2816 + col0;
                float o[8];
#pragma unroll
                for (int n = 0; n < 2; ++n)
#pragma unroll
                    for (int j = 0; j < 4; ++j) { const float a = acc[ai][0][m][n][j], b = acc[ai][1][m][n][j];
                        o[4 * n + j] = a * __builtin_amdgcn_rcpf(1.0f + __builtin_amdgcn_exp2f(-1.4426950408889634f * a)) * b; }
                u32x4 w; w.x = pk_bf16(o[0], o[1]); w.y = pk_bf16(o[2], o[3]); w.z = pk_bf16(o[4], o[5]); w.w = pk_bf16(o[6], o[7]);
                *(u32x4*)rp = w; }
    }
};

template <class Epi, class Sched, bool ALIGN_EPI = false, bool SP2 = false>
__device__ __forceinline__ void gemm_phase(PG8_LAS unsigned char* lds, const Gemm g, const Sched& S, const Epi& E) {
    int tid_ = threadIdx.x; asm volatile("" : "+v"(tid_));
    const int tid = tid_, wid = __builtin_amdgcn_readfirstlane(tid >> 6), lane = tid & 63, wr = wid >> 2, wc = wid & 3, fr = lane & 15, fq = lane >> 4;
    const int K = g.K, nt = K / BK;
    unsigned voffA[2], voffB[2];
#pragma unroll
    for (int i = 0; i < 2; ++i) { int R, C; stage_rc(tid * 16 + i * 8192, R, C); const int Rb = Epi::PERM ? ((R & ~31) + perm32(R & 31)) : R;
        voffA[i] = (unsigned)(R * K + C) * 2u; voffB[i] = (unsigned)(Rb * K + C) * 2u; }
    const size_t kstep = (size_t)(BK * 2);
    const size_t hstep = (size_t)HALF * K * 2;
    const size_t tstep = 2 * hstep;
    const unsigned ldsw = (unsigned)wid * 1024u;
    const int aoff = lds_byte(wr * 64 + fr, fq * 8), boff = lds_byte(wc * 32 + fr, fq * 8);
#define PG8_SA(b, h) (((b) * 2 + (h)) * HTB)
#define PG8_SB(b, h) ((4 + (b) * 2 + (h)) * HTB)
#define PG8_STAGE(bufoff, gbase, voff) do { _Pragma("unroll") for (int _i = 0; _i < 2; ++_i) \
        __builtin_amdgcn_global_load_lds((const unsigned*)((const char*)(gbase) + (voff)[_i]), (PG8_LAS unsigned*)(lds + (bufoff) + ldsw + _i * 8192), 16, 0, 0); } while (0)
#define PG8_LDA(dst, b, h) do { _Pragma("unroll") for (int m = 0; m < 4; ++m) _Pragma("unroll") for (int k = 0; k < 2; ++k) dst[m][k] = *(const PG8_LAS bf16x8*)(lds + PG8_SA(b, h) + aoff + m * 2048 + k * 1024); } while (0)
#define PG8_LDB(dst, b, h) do { _Pragma("unroll") for (int n = 0; n < 2; ++n) _Pragma("unroll") for (int k = 0; k < 2; ++k) dst[n][k] = *(const PG8_LAS bf16x8*)(lds + PG8_SB(b, h) + boff + n * 2048 + k * 1024); } while (0)
#define PG8_MMA(ai, bj, At, Bt) do { __builtin_amdgcn_s_setprio(1); _Pragma("unroll") for (int m = 0; m < 4; ++m) _Pragma("unroll") for (int n = 0; n < 2; ++n) _Pragma("unroll") for (int k = 0; k < 2; ++k) \
        acc[ai][bj][m][n] = __builtin_amdgcn_mfma_f32_16x16x32_bf16(Bt[n][k], At[m][k], acc[ai][bj][m][n], 0, 0, 0); __builtin_amdgcn_s_setprio(0); } while (0)
#define PG8_WAIT_V(n) asm volatile("s_waitcnt vmcnt(" #n ")" ::: "memory")
#define PG8_WAIT_L(n) asm volatile("s_waitcnt lgkmcnt(" #n ")" ::: "memory")
#define PG8_BAR __builtin_amdgcn_s_barrier()
#define PG8_SCHED __builtin_amdgcn_sched_barrier(0)
    Unit cur, nxt; int ui = 0;
    if (!S.next(0, cur)) return;
    f32x4 acc[2][2][4][2];
#pragma unroll
    for (int a = 0; a < 2; ++a)
#pragma unroll
        for (int b = 0; b < 2; ++b)
#pragma unroll
            for (int m = 0; m < 4; ++m)
#pragma unroll
                for (int n = 0; n < 2; ++n) acc[a][b][m][n] = (f32x4){0.f, 0.f, 0.f, 0.f};
    bf16x8 At[4][2], B0[2][2], B1[2][2];
    const char* cA = (const char*)g.A + (size_t)cur.pm * tstep; const char* cB = (const char*)g.Bt + (size_t)cur.pn * tstep;
    S.a_ready(cur);
    if constexpr (SP2) {
        PG8_STAGE(PG8_SB(0, 0), cB, voffB); PG8_STAGE(PG8_SB(0, 1), cB + hstep, voffB); PG8_STAGE(PG8_SA(0, 0), cA, voffA); PG8_STAGE(PG8_SA(0, 1), cA + hstep, voffA);
        if (wr == 1) PG8_BAR;
        PG8_WAIT_V(2); PG8_BAR;
        PG8_STAGE(PG8_SB(1, 0), cB + kstep, voffB); PG8_STAGE(PG8_SA(1, 0), cA + kstep, voffA); PG8_STAGE(PG8_SB(1, 1), cB + hstep + kstep, voffB);
        PG8_WAIT_V(6); PG8_BAR;
    } else {
        PG8_STAGE(PG8_SB(0, 0), cB, voffB); PG8_STAGE(PG8_SA(0, 0), cA, voffA); PG8_STAGE(PG8_SB(0, 1), cB + hstep, voffB); PG8_STAGE(PG8_SA(0, 1), cA + hstep, voffA);
        if (wr == 1) PG8_BAR;
        PG8_WAIT_V(4); PG8_BAR;
        PG8_STAGE(PG8_SB(1, 0), cB + kstep, voffB); PG8_STAGE(PG8_SA(1, 0), cA + kstep, voffA); PG8_STAGE(PG8_SB(1, 1), cB + hstep + kstep, voffB);
        PG8_WAIT_V(6); PG8_BAR;
    }
    for (;;) {
        const bool has_next = S.next(ui + 1, nxt);
        const char* nA = has_next ? (const char*)g.A + (size_t)nxt.pm * tstep : cA; const char* nB = has_next ? (const char*)g.Bt + (size_t)nxt.pn * tstep : cB;
        for (int t = 0; t < nt; t += 2) {
            const bool last = (t == nt - 2);
            const char* a1 = cA + (size_t)(t + 1) * kstep;
            const char* a2 = last ? nA : cA + (size_t)(t + 2) * kstep; const char* b2 = last ? nB : cB + (size_t)(t + 2) * kstep;
            const char* a3 = a2 + kstep; const char* b3 = b2 + kstep;
            if (last && has_next) S.a_ready(nxt);
            if constexpr (SP2) {
            PG8_LDB(B0, 0, 0); PG8_LDB(B1, 0, 1); PG8_SCHED; PG8_LDA(At, 0, 0); PG8_STAGE(PG8_SA(1, 1), a1 + hstep, voffA);
            PG8_WAIT_V(8); PG8_WAIT_L(0); PG8_BAR; PG8_MMA(0, 0, At, B0); PG8_MMA(0, 1, At, B1); PG8_BAR; PG8_SCHED;
            PG8_LDA(At, 0, 1); PG8_STAGE(PG8_SB(0, 0), b2, voffB); PG8_STAGE(PG8_SB(0, 1), b2 + hstep, voffB); PG8_STAGE(PG8_SA(0, 0), a2, voffA);
            PG8_WAIT_V(8); PG8_WAIT_L(0); PG8_BAR; PG8_MMA(1, 0, At, B0); PG8_MMA(1, 1, At, B1); PG8_BAR; PG8_SCHED;
            PG8_LDB(B0, 1, 0); PG8_LDB(B1, 1, 1); PG8_SCHED; PG8_LDA(At, 1, 0); PG8_STAGE(PG8_SA(0, 1), a2 + hstep, voffA);
            PG8_WAIT_V(8); PG8_WAIT_L(0); PG8_BAR; PG8_MMA(0, 0, At, B0); PG8_MMA(0, 1, At, B1); PG8_BAR; PG8_SCHED;
            PG8_LDA(At, 1, 1); PG8_STAGE(PG8_SB(1, 0), b3, voffB); PG8_STAGE(PG8_SB(1, 1), b3 + hstep, voffB); PG8_STAGE(PG8_SA(1, 0), a3, voffA);
            PG8_WAIT_V(8); PG8_WAIT_L(0); PG8_BAR; PG8_MMA(1, 0, At, B0); PG8_MMA(1, 1, At, B1); PG8_BAR; PG8_SCHED;
            } else {
            PG8_LDB(B0, 0, 0); PG8_SCHED; PG8_LDA(At, 0, 0); PG8_STAGE(PG8_SA(1, 1), a1 + hstep, voffA);
            PG8_WAIT_L(8); PG8_BAR; PG8_WAIT_L(0); PG8_MMA(0, 0, At, B0); PG8_BAR; PG8_SCHED;
            PG8_LDB(B1, 0, 1); PG8_STAGE(PG8_SB(0, 0), b2, voffB);
            PG8_BAR; PG8_WAIT_L(0); PG8_MMA(0, 1, At, B1); PG8_BAR;
            PG8_LDA(At, 0, 1); PG8_STAGE(PG8_SA(0, 0), a2, voffA);
            PG8_BAR; PG8_WAIT_L(0); PG8_MMA(1, 0, At, B0); PG8_BAR; PG8_SCHED;
            PG8_STAGE(PG8_SB(0, 1), b2 + hstep, voffB);
            PG8_WAIT_V(6); PG8_BAR; PG8_MMA(1, 1, At, B1); PG8_BAR;
            PG8_LDB(B0, 1, 0); PG8_SCHED; PG8_LDA(At, 1, 0); PG8_STAGE(PG8_SA(0, 1), a2 + hstep, voffA);
            PG8_WAIT_L(8); PG8_BAR; PG8_WAIT_L(0); PG8_MMA(0, 0, At, B0); PG8_BAR; PG8_SCHED;
            PG8_LDB(B1, 1, 1); PG8_STAGE(PG8_SB(1, 0), b3, voffB);
            PG8_BAR; PG8_WAIT_L(0); PG8_MMA(0, 1, At, B1); PG8_BAR;
            PG8_LDA(At, 1, 1); PG8_STAGE(PG8_SA(1, 0), a3, voffA);
            PG8_BAR; PG8_WAIT_L(0); PG8_MMA(1, 0, At, B0); PG8_BAR; PG8_SCHED;
            PG8_STAGE(PG8_SB(1, 1), b3 + hstep, voffB);
            PG8_WAIT_V(6); PG8_BAR; PG8_MMA(1, 1, At, B1); PG8_BAR;
            }
        }
        if constexpr (ALIGN_EPI) { if (wr == 0) PG8_BAR; }
        if constexpr (!Epi::AFTER_DRAIN) { E(acc, cur, wr, wc, fr, fq); S.done(cur); }
        if (!has_next) break;
#pragma unroll
        for (int a = 0; a < 2; ++a)
#pragma unroll
            for (int b = 0; b < 2; ++b)
#pragma unroll
                for (int m = 0; m < 4; ++m)
#pragma unroll
                    for (int n = 0; n < 2; ++n) acc[a][b][m][n] = (f32x4){0.f, 0.f, 0.f, 0.f};
        cur = nxt; cA = nA; cB = nB; ++ui;
        if constexpr (ALIGN_EPI) { if (wr == 1) PG8_BAR; }
    }
    PG8_WAIT_V(0);
    if constexpr (!ALIGN_EPI) { if (wr == 0) PG8_BAR; }
    PG8_BAR;
    if constexpr (Epi::AFTER_DRAIN) { E.fused(acc, cur, wr, wc, fr, fq, lds, wid, lane); S.done(cur); }
#undef PG8_SA
#undef PG8_SB
#undef PG8_STAGE
#undef PG8_LDA
#undef PG8_LDB
#undef PG8_MMA
#undef PG8_WAIT_V
#undef PG8_WAIT_L
#undef PG8_BAR
#undef PG8_SCHED
}
}

#ifndef PG8_SP2
#define PG8_SP2 true
#endif
#ifndef PG8_ALIGN
#define PG8_ALIGN true
#endif

namespace attn_body {
using bf16=__hip_bfloat16;
using bf16x8=__attribute__((ext_vector_type(8)))short;
using s16x4=__attribute__((ext_vector_type(4)))short;
using f32x16=__attribute__((ext_vector_type(16)))float;
using u32x4=__attribute__((ext_vector_type(4)))unsigned;
constexpr int D=64;
constexpr int NW=8,QBLK=32,QB=QBLK*NW,KVBLK=64;
typedef float f32x4v __attribute__((ext_vector_type(4))); typedef unsigned u32x2v __attribute__((ext_vector_type(2)));
__device__ __forceinline__ int crow(int r,int hi){return (r&3)+8*(r>>2)+4*hi;}
#define SBAR() __builtin_amdgcn_sched_barrier(0)
__device__ __forceinline__ void cmask(f32x16&p0,f32x16&p1,int jb,int qrel,int hi){
  const float NEG=-INFINITY; int kb=64*jb+4*hi;
  #pragma unroll
  for(int r=0;r<16;++r){int kv=kb+(r&3)+8*(r>>2); if(kv>qrel)p0[r]=NEG; if(kv+32>qrel)p1[r]=NEG;}
}

constexpr int NSLOT=3, SLOTB=8192;
constexpr int LDS_K=0, LDS_V=NSLOT*SLOTB, LDS_WS=2*NSLOT*SLOTB, LDS_OST=LDS_WS+NW*64*4, LDS_BYTES=LDS_OST+NW*8192;
constexpr float C2=0.125f*1.4426950408889634f;
__device__ __forceinline__ void glds16(const void*gsrc,unsigned lds_dst){unsigned keep;
  asm volatile("s_mov_b32 %0, m0\n\ts_mov_b32 m0, %2\n\ts_nop 0\n\tglobal_load_lds_dwordx4 %1, off\n\ts_mov_b32 m0, %0":"=&s"(keep):"v"(gsrc),"s"(lds_dst):"memory");}
__device__ __forceinline__ float max3f(float a,float b,float c){float r;asm("v_max3_f32 %0, %1, %2, %3":"=v"(r):"v"(a),"v"(b),"v"(c));return r;}
__device__ __forceinline__ float max2f(float a,float b){float r;asm("v_max_f32_e32 %0, %1, %2":"=v"(r):"v"(a),"v"(b));return r;}
__device__ __forceinline__ float fadd_s(float a,float b){float r;asm("v_add_f32_e32 %0, %1, %2":"=v"(r):"v"(a),"v"(b));return r;}
__device__ __forceinline__ float fsub_s(float a,float b){float r;asm("v_sub_f32_e32 %0, %1, %2":"=v"(r):"v"(a),"v"(b));return r;}
typedef float f32x2_t __attribute__((ext_vector_type(2))); typedef __bf16 bf16x2_t __attribute__((ext_vector_type(2)));
__device__ __forceinline__ unsigned cvtpk_s(float lo,float hi){f32x2_t v={lo,hi};bf16x2_t b=__builtin_convertvector(v,bf16x2_t);return __builtin_bit_cast(unsigned,b);}
#define WAIT_BAR(N) asm volatile("s_waitcnt vmcnt(" #N ") lgkmcnt(0)\n\ts_barrier":::"memory")

__device__ __forceinline__ void qkt(f32x16&p0,f32x16&p1,const char*Kslot,const bf16x8*qr,const f32x16&negm,int r32,int hi){
  const char*kb=Kslot+hi*1024+r32*16;
  #pragma unroll
  for(int d0=0;d0<4;++d0){
    const bf16x8 b0=*reinterpret_cast<const bf16x8*>(kb+d0*2048);
    const bf16x8 b1=*reinterpret_cast<const bf16x8*>(kb+d0*2048+512);
    if(d0==0){p0=__builtin_amdgcn_mfma_f32_32x32x16_bf16(b0,qr[0],negm,0,0,0);p1=__builtin_amdgcn_mfma_f32_32x32x16_bf16(b1,qr[0],negm,0,0,0);}
    else{p0=__builtin_amdgcn_mfma_f32_32x32x16_bf16(b0,qr[d0],p0,0,0,0);p1=__builtin_amdgcn_mfma_f32_32x32x16_bf16(b1,qr[d0],p1,0,0,0);}}
}
typedef __attribute__((address_space(3))) const char* lds_cptr;
typedef short v4i16_t __attribute__((ext_vector_type(4)));
__device__ __forceinline__ void kload8(bf16x8*kf,lds_cptr kp){
  kf[0]=*(const __attribute__((address_space(3))) bf16x8*)(kp);      kf[1]=*(const __attribute__((address_space(3))) bf16x8*)(kp+512);
  kf[2]=*(const __attribute__((address_space(3))) bf16x8*)(kp+2048); kf[3]=*(const __attribute__((address_space(3))) bf16x8*)(kp+2560);
  kf[4]=*(const __attribute__((address_space(3))) bf16x8*)(kp+4096); kf[5]=*(const __attribute__((address_space(3))) bf16x8*)(kp+4608);
  kf[6]=*(const __attribute__((address_space(3))) bf16x8*)(kp+6144); kf[7]=*(const __attribute__((address_space(3))) bf16x8*)(kp+6656);
}
__device__ __forceinline__ void kload4(bf16x8*kf,lds_cptr kp){
  kf[0]=*(const __attribute__((address_space(3))) bf16x8*)(kp);      kf[1]=*(const __attribute__((address_space(3))) bf16x8*)(kp+512);
  kf[2]=*(const __attribute__((address_space(3))) bf16x8*)(kp+2048); kf[3]=*(const __attribute__((address_space(3))) bf16x8*)(kp+2560);
}
__device__ __forceinline__ void qkt_h(f32x16&p0,f32x16&p1,const char*Kslot,const bf16x8*qr,const f32x16&negm,int r32,int hi){
  const char*kb=Kslot+hi*1024+r32*16;
  #pragma unroll
  for(int d0=0;d0<2;++d0){
    const bf16x8 b0=*reinterpret_cast<const bf16x8*>(kb+d0*2048);
    const bf16x8 b1=*reinterpret_cast<const bf16x8*>(kb+d0*2048+512);
    if(d0==0){p0=__builtin_amdgcn_mfma_f32_32x32x16_bf16(b0,qr[0],negm,0,0,0);p1=__builtin_amdgcn_mfma_f32_32x32x16_bf16(b1,qr[0],negm,0,0,0);}
    else{p0=__builtin_amdgcn_mfma_f32_32x32x16_bf16(b0,qr[d0],p0,0,0,0);p1=__builtin_amdgcn_mfma_f32_32x32x16_bf16(b1,qr[d0],p1,0,0,0);}}
}
__device__ __forceinline__ void kload2(bf16x8*kf,lds_cptr kp,int j){ kf[2*j]=*(const __attribute__((address_space(3))) bf16x8*)(kp+j*2048); kf[2*j+1]=*(const __attribute__((address_space(3))) bf16x8*)(kp+j*2048+512); }
__device__ __forceinline__ s16x4 vtr(lds_cptr p){ return __builtin_bit_cast(s16x4,__builtin_amdgcn_ds_read_tr16_b64_v4i16((__attribute__((address_space(3))) v4i16_t*)p)); }
__device__ __forceinline__ float rowmax(const f32x16&p0,const f32x16&p1){
  float a=max3f(p0[0],p0[1],p1[0]),b=max3f(p0[2],p0[3],p1[1]);a=max3f(a,p1[2],p1[3]);
  #pragma unroll
  for(int r=4;r<16;r+=4){a=max3f(a,p0[r],p0[r+1]);b=max3f(b,p0[r+2],p0[r+3]);a=max3f(a,p1[r],p1[r+1]);b=max3f(b,p1[r+2],p1[r+3]);}
  const float m=max2f(a,b);
  auto rr=__builtin_amdgcn_permlane32_swap(__float_as_uint(m),__float_as_uint(m),false,false);
  return max2f(__uint_as_float(rr[0]),__uint_as_float(rr[1]));
}
__device__ __forceinline__ void pv(f32x16*o,int vb,bf16x8 pa0,bf16x8 pa1,bf16x8 pa2,bf16x8 pa3){
  #pragma unroll
  for(int d0=0;d0<2;++d0){s16x4 lo[4],hi[4];
    #pragma unroll
    for(int ks=0;ks<4;++ks){
      asm volatile("ds_read_b64_tr_b16 %0,%1 offset:%c2":"=&v"(lo[ks]):"v"(vb),"i"(d0*4096+ks*1024):"memory");
      asm volatile("ds_read_b64_tr_b16 %0,%1 offset:%c2":"=&v"(hi[ks]):"v"(vb),"i"(d0*4096+ks*1024+512):"memory");}
    asm volatile("s_waitcnt lgkmcnt(0)":::"memory");SBAR();
    #define PK(k) (bf16x8){lo[k][0],lo[k][1],lo[k][2],lo[k][3],hi[k][0],hi[k][1],hi[k][2],hi[k][3]}
    o[d0]=__builtin_amdgcn_mfma_f32_32x32x16_bf16(pa0,PK(0),o[d0],0,0,0);
    o[d0]=__builtin_amdgcn_mfma_f32_32x32x16_bf16(pa1,PK(1),o[d0],0,0,0);
    o[d0]=__builtin_amdgcn_mfma_f32_32x32x16_bf16(pa2,PK(2),o[d0],0,0,0);
    o[d0]=__builtin_amdgcn_mfma_f32_32x32x16_bf16(pa3,PK(3),o[d0],0,0,0);
    #undef PK
  }
}

#ifndef ATTN_STORE16
#define ATTN_STORE16(p,v) (*(u32x4*)(p)=(v))
#endif

struct AttnParams {
  const bf16* Q;
  const bf16* K;
  const bf16* V;
  bf16* O;
  const float* gsub;
  int NT;
  int base_a, base_b;
  int mask;
  int dq0;
  int nomax; float mfix;
  int khalf;
  int mode;
  float sinkl2;
  float lam;
  float oscale;
};
constexpr int QP=1280, KP=512, OP=1024;
__device__ __forceinline__ void wmask(f32x16&p0,f32x16&p1,int dq,int hi){
  const float NEG=-INFINITY;
  #pragma unroll
  for(int r=0;r<16;++r){int d0=dq-((r&3)+8*(r>>2)+4*hi); if((unsigned)(d0+128)>256u)p0[r]=NEG; if((unsigned)(d0+96)>256u)p1[r]=NEG;}
}
template<int THRL,bool BH> __device__ __forceinline__ void attn_unit(const AttnParams&P,char*shm){
  int tid_=threadIdx.x; asm volatile("":"+v"(tid_));
  const int tid=tid_,lane=tid&63,r32=lane&31,hi=lane>>5; const int wid=__builtin_amdgcn_readfirstlane(tid>>6);
  const int NT=P.NT,base_a=P.base_a,base_b=P.base_b; const bool msk=P.mask!=0; const bool nomx=P.nomax!=0; const float mfix=P.mfix;
  if(wid>=4)__builtin_amdgcn_s_setprio(1);
  volatile unsigned*pblk=(volatile unsigned*)(shm+LDS_BYTES)+wid*8;
  if(lane==0){ const unsigned long long po=(unsigned long long)P.O,pg=(unsigned long long)P.gsub; pblk[0]=(unsigned)po;pblk[1]=(unsigned)(po>>32);pblk[2]=(unsigned)pg;pblk[3]=(unsigned)(pg>>32);
    pblk[4]=__float_as_uint(P.lam);pblk[5]=__float_as_uint(P.oscale);pblk[6]=__float_as_uint(P.sinkl2);pblk[7]=(unsigned)P.mode; }
  const bf16*Kh=P.K,*Vh=P.V;
  const unsigned lds0=(unsigned)(uintptr_t)shm;
  float*wsf=(float*)(shm+LDS_WS)+wid*64;
  const bf16*ksrc=Kh+(long)lane*KP+wid*8;
  const bf16*vsrc=Vh+(long)(16*(wid&3)+(lane>>2))*KP+(wid>>2)*32+(lane&3)*8;
  const unsigned kdst=lds0+LDS_K+wid*1024, vdst=lds0+LDS_V+wid*1024;
  #define TROW(t) (((t)<4)?(base_a+64*(t)):(base_b+64*((t)-4)))
  #define DMA_K(t,slot) glds16(ksrc+(long)TROW(t)*KP,(unsigned)__builtin_amdgcn_readfirstlane(kdst+(slot)))
  #define DMA_V(t,slot) glds16(vsrc+(long)TROW(t)*KP,(unsigned)__builtin_amdgcn_readfirstlane(vdst+(slot)))
  const int vb0=(int)(lds0+LDS_V)+((lane>>4)&1)*32+(lane&3)*8+(4*hi+((lane&15)>>2))*64;
  const char*Kbase=shm+LDS_K; bf16x8 kf[8];
  const lds_cptr shm3=(lds_cptr)shm; const lds_cptr kp0=shm3+LDS_K+hi*1024+r32*16; const lds_cptr vp0=shm3+LDS_V+((lane>>4)&1)*32+(lane&3)*8+(4*hi+((lane&15)>>2))*64;
  const bf16*Qw=P.Q+(long)(wid*QBLK)*QP; const int kbo=BH?P.khalf*4096:0, qoff=BH?P.khalf*32:0;
  DMA_K(0,0);DMA_V(0,0);DMA_K(1,SLOTB);
  bf16x8 qr[4];
  #pragma unroll
  for(int d0=0;d0<(BH?2:4);++d0)qr[d0]=*reinterpret_cast<const bf16x8*>(&Qw[(long)r32*QP+qoff+d0*16+hi*8]);
  float mhat=0.f,l_reg=0.f;f32x16 o[2];o[0]=f32x16{};o[1]=f32x16{};f32x16 negm=f32x16{};asm volatile("":"+v"(negm));
  const int dqb=P.dq0+wid*QBLK+r32;
  #define CMASK(P0,P1,t) do{ if(msk&&(t)>=4)wmask(P0,P1,dqb-64*((t)-4),hi); }while(0)
  bool resc=false;
  #define START(P0,P1) do{ float rm=mfix; if(!nomx)rm=rowmax(P0,P1); resc=false; \
    { const float dl=rm; mhat=fadd_s(mhat,dl); \
      _Pragma("unroll") for(int r=0;r<16;++r){P0[r]=fsub_s(P0[r],dl);P1[r]=fsub_s(P1[r],dl);} \
      _Pragma("unroll") for(int r=0;r<16;++r)negm[r]=-mhat; asm volatile("":"+v"(negm)); } \
    _Pragma("unroll") for(int r=0;r<16;++r)P0[r]=__builtin_amdgcn_exp2f(P0[r]); }while(0)
  #define RESC() do{ if(resc){ asm volatile("s_waitcnt lgkmcnt(0)":::"memory"); \
      _Pragma("unroll") for(int d_=0;d_<2;++d_) _Pragma("unroll") for(int r=0;r<16;++r)o[d_][r]*=wsf[crow(r,hi)]; } }while(0)
  f32x16 pA0,pA1,pB0,pB1;
  int sl_prev=0,sl_cur=0,sl_next=SLOTB;
  #define ROT() do{sl_prev=sl_cur;sl_cur=sl_next;sl_next=(sl_next==(NSLOT-1)*SLOTB)?0:sl_next+SLOTB;}while(0)
  DMA_K(2,2*SLOTB);
  WAIT_BAR(3);
  if(BH)qkt_h(pA0,pA1,Kbase+kbo,qr,negm,r32,hi); else qkt(pA0,pA1,Kbase,qr,negm,r32,hi);
  asm volatile("s_nop 15\n\ts_nop 7":"+v"(pA0),"+v"(pA1));CMASK(pA0,pA1,0);
  START(pA0,pA1);
  _Pragma("unroll") for(int r=0;r<16;++r)pA1[r]=__builtin_amdgcn_exp2f(pA1[r]);
  WAIT_BAR(0);
  DMA_K(3,0);DMA_V(1,SLOTB);
  ROT();
  if(BH)kload4(kf,kp0+sl_cur+kbo); else kload8(kf,kp0+sl_cur);
  WAIT_BAR(2);
  s16x4 vlo[8],vhi[8]; u32x4 pw0,pw1,pw2,pw3;
  #define PKW(P,B) cvtpk_s(P[B],P[B+1])
  #define PAF(k) __builtin_bit_cast(bf16x8,pw##k)
  #define VFR(i) (bf16x8){vlo[i][0],vlo[i][1],vlo[i][2],vlo[i][3],vhi[i][0],vhi[i][1],vhi[i][2],vhi[i][3]}
  #define PIN(x) asm volatile("":"+v"(x))
  #define MX3(a,b,c) __builtin_fmaxf(__builtin_fmaxf((a),(b)),(c))
  #define QKS(NRM,HLF) do{ if(BH){ HLF; } else { NRM; } }while(0)
  #define GAPA(MF,A0,A1,A2,A3,W0,W1,PW) do{ MF; sacc+=A0; sacc+=A1; sacc+=A2; sacc+=A3; PIN(sacc); W0; W1; PIN(PW); SBAR(); }while(0)
  #define EX(v) __builtin_amdgcn_exp2f(v)
  #define GAPB(MF,X,B) do{ MF; X[B]=EX(X[B]); X[B+1]=EX(X[B+1]); X[B+2]=EX(X[B+2]); X[B+3]=EX(X[B+3]); PIN(X); SBAR(); }while(0)
  #define VRD(i) do{ vlo[i]=vtr(vp_+(((i)>>2)*4096+((i)&3)*1024)); vhi[i]=vtr(vp_+(((i)>>2)*4096+((i)&3)*1024+512)); }while(0)
  #define KRD(G,j) do{ if(G){ if(!BH){ kload2(kf,kp0+sl_next,j); SBAR(); } else if((j)<2){ kload2(kf,kp0+sl_next+kbo,j); SBAR(); } } }while(0)
  #define STEP(C0,C1,P0,P1,t,GK,GV,GL) do{ SBAR(); \
    const lds_cptr vp_=vp0+sl_prev; \
    VRD(0); SBAR(); float sacc=(P0[0]+P0[1]); \
    GAPA(QKS(C0=__builtin_amdgcn_mfma_f32_32x32x16_bf16(kf[0],qr[0],negm,0,0,0), C0=__builtin_amdgcn_mfma_f32_32x32x16_bf16(kf[0],qr[0],negm,0,0,0)), P0[2],P0[3],P0[4],P0[5],     pw0[0]=PKW(P0,0), pw0[1]=PKW(P0,2), pw0); \
    VRD(4); SBAR(); GAPA(QKS(C1=__builtin_amdgcn_mfma_f32_32x32x16_bf16(kf[1],qr[0],negm,0,0,0), (void)0), P0[6],P0[7],P0[8],P0[9],     pw0[2]=PKW(P0,4), pw0[3]=PKW(P0,6), pw0); \
    VRD(1); SBAR(); GAPA(QKS(C0=__builtin_amdgcn_mfma_f32_32x32x16_bf16(kf[2],qr[1],C0,0,0,0), C1=__builtin_amdgcn_mfma_f32_32x32x16_bf16(kf[1],qr[0],negm,0,0,0)),   P0[10],P0[11],P0[12],P0[13], pw1[0]=PKW(P0,8), pw1[1]=PKW(P0,10), pw1); \
    VRD(5); SBAR(); GAPA(QKS(C1=__builtin_amdgcn_mfma_f32_32x32x16_bf16(kf[3],qr[1],C1,0,0,0), (void)0),   P0[14],P0[15],P1[0],P1[1],   pw1[2]=PKW(P0,12),pw1[3]=PKW(P0,14), pw1); \
    VRD(2); SBAR(); GAPA(QKS(C0=__builtin_amdgcn_mfma_f32_32x32x16_bf16(kf[4],qr[2],C0,0,0,0), C0=__builtin_amdgcn_mfma_f32_32x32x16_bf16(kf[2],qr[1],C0,0,0,0)),   P1[2],P1[3],P1[4],P1[5],     pw2[0]=PKW(P1,0), pw2[1]=PKW(P1,2), pw2); \
    VRD(6); SBAR(); GAPA(QKS(C1=__builtin_amdgcn_mfma_f32_32x32x16_bf16(kf[5],qr[2],C1,0,0,0), (void)0),   P1[6],P1[7],P1[8],P1[9],     pw2[2]=PKW(P1,4), pw2[3]=PKW(P1,6), pw2); \
    VRD(3); SBAR(); GAPA(QKS(C0=__builtin_amdgcn_mfma_f32_32x32x16_bf16(kf[6],qr[3],C0,0,0,0), C1=__builtin_amdgcn_mfma_f32_32x32x16_bf16(kf[3],qr[1],C1,0,0,0)),   P1[10],P1[11],P1[12],P1[13], pw3[0]=PKW(P1,8), pw3[1]=PKW(P1,10), pw3); \
    VRD(7); SBAR(); GAPA(QKS(C1=__builtin_amdgcn_mfma_f32_32x32x16_bf16(kf[7],qr[3],C1,0,0,0), (void)0),   P1[14],P1[15],0.f,0.f,       pw3[2]=PKW(P1,12),pw3[3]=PKW(P1,14), pw3); \
    l_reg+=sacc; \
    if(GK){DMA_K((t)+3,sl_cur);} if(GV){DMA_V((t)+1,sl_next);} \
    CMASK(C0,C1,t); \
    resc=false; \
    if(!nomx){ float a=MX3(C0[0],C0[1],C1[0]),b=MX3(C0[2],C0[3],C1[1]); a=MX3(a,C1[2],C1[3]); \
      _Pragma("unroll") for(int r=4;r<16;r+=4){a=MX3(a,C0[r],C0[r+1]);b=MX3(b,C0[r+2],C0[r+3]);a=MX3(a,C1[r],C1[r+1]);b=MX3(b,C1[r+2],C1[r+3]);} \
      float rm=__builtin_fmaxf(a,b); { auto rr=__builtin_amdgcn_permlane32_swap(__float_as_uint(rm),__float_as_uint(rm),false,false); rm=__builtin_fmaxf(__uint_as_float(rr[0]),__uint_as_float(rr[1])); } \
      resc=false; \
      if(__builtin_expect(__any(rm>(float)THRL),0)){ const float dl=__builtin_fmaxf(rm,0.f); mhat+=dl; \
        _Pragma("unroll") for(int r=0;r<16;++r){C0[r]-=dl;C1[r]-=dl;} \
        _Pragma("unroll") for(int r=0;r<16;++r)negm[r]=-mhat; asm volatile("":"+v"(negm)); \
        const float f=__builtin_amdgcn_exp2f(-dl); l_reg*=f; if(hi==0)wsf[r32]=f; resc=true; } } \
    SBAR(); \
    GAPB(o[0]=__builtin_amdgcn_mfma_f32_32x32x16_bf16(PAF(0),VFR(0),o[0],0,0,0), C0,0); \
    GAPB(o[1]=__builtin_amdgcn_mfma_f32_32x32x16_bf16(PAF(0),VFR(4),o[1],0,0,0), C0,4); \
    KRD(GL,0); GAPB(o[0]=__builtin_amdgcn_mfma_f32_32x32x16_bf16(PAF(1),VFR(1),o[0],0,0,0), C0,8); \
    KRD(GL,1); GAPB(o[1]=__builtin_amdgcn_mfma_f32_32x32x16_bf16(PAF(1),VFR(5),o[1],0,0,0), C0,12); \
    KRD(GL,2); GAPB(o[0]=__builtin_amdgcn_mfma_f32_32x32x16_bf16(PAF(2),VFR(2),o[0],0,0,0), C1,0); \
    KRD(GL,3); GAPB(o[1]=__builtin_amdgcn_mfma_f32_32x32x16_bf16(PAF(2),VFR(6),o[1],0,0,0), C1,4); \
    GAPB(o[0]=__builtin_amdgcn_mfma_f32_32x32x16_bf16(PAF(3),VFR(3),o[0],0,0,0), C1,8); \
    GAPB(o[1]=__builtin_amdgcn_mfma_f32_32x32x16_bf16(PAF(3),VFR(7),o[1],0,0,0), C1,12); \
    }while(0)
  int t=1;
  #undef CMASK
  #define CMASK(P0,P1,t) do{}while(0)
  for(;!msk&&t+5<NT;t+=2){
    STEP(pB0,pB1,pA0,pA1,t,true,true,true);     WAIT_BAR(2); RESC(); ROT();
    STEP(pA0,pA1,pB0,pB1,t+1,true,true,true);   WAIT_BAR(2); RESC(); ROT();
  }
  #undef CMASK
  #define CMASK(P0,P1,t) do{ if(msk&&(t)>=4)wmask(P0,P1,dqb-64*((t)-4),hi); }while(0)
  #define ENDW(tt) do{ if((tt)+3<NT){WAIT_BAR(2);} else if((tt)+2<NT){WAIT_BAR(1);} else {WAIT_BAR(0);} }while(0)
  for(;t+1<NT;t+=2){
    STEP(pB0,pB1,pA0,pA1,t,(t+3<NT),(t+1<NT),(t+1<NT));       ENDW(t);   RESC(); ROT();
    STEP(pA0,pA1,pB0,pB1,t+1,(t+4<NT),(t+2<NT),(t+2<NT));     ENDW(t+1); RESC(); ROT();
  }
  STEP(pB0,pB1,pA0,pA1,NT-1,false,false,false); RESC();
  { float sacc=pB0[0]+pB0[1]; _Pragma("unroll") for(int r=2;r<16;++r)sacc+=pB0[r]; _Pragma("unroll") for(int r=0;r<16;++r)sacc+=pB1[r]; l_reg+=sacc;
    pw0=(u32x4){PKW(pB0,0),PKW(pB0,2),PKW(pB0,4),PKW(pB0,6)};pw1=(u32x4){PKW(pB0,8),PKW(pB0,10),PKW(pB0,12),PKW(pB0,14)};pw2=(u32x4){PKW(pB1,0),PKW(pB1,2),PKW(pB1,4),PKW(pB1,6)};pw3=(u32x4){PKW(pB1,8),PKW(pB1,10),PKW(pB1,12),PKW(pB1,14)};
    SBAR(); pv(o,vb0+sl_cur,PAF(0),PAF(1),PAF(2),PAF(3)); }
  #undef PKW
  #undef PAF
  #undef VFR
  #undef PIN
  #undef MX3
  #undef GAPA
  #undef QKS
  #undef GAPB
  #undef EX
  #undef VRD
  #undef KRD
  #undef STEP
  #undef ENDW
  {auto rr=__builtin_amdgcn_permlane32_swap(__float_as_uint(l_reg),__float_as_uint(l_reg),false,false);l_reg=__uint_as_float(rr[0])+__uint_as_float(rr[1]);}
  asm volatile("s_waitcnt lgkmcnt(0)":::"memory");
  const unsigned e0=__builtin_amdgcn_readfirstlane(pblk[0]),e1=__builtin_amdgcn_readfirstlane(pblk[1]),e2=__builtin_amdgcn_readfirstlane(pblk[2]),e3=__builtin_amdgcn_readfirstlane(pblk[3]);
  const float e_lam=__uint_as_float(__builtin_amdgcn_readfirstlane(pblk[4])),e_osc=__uint_as_float(__builtin_amdgcn_readfirstlane(pblk[5])),e_sink=__uint_as_float(__builtin_amdgcn_readfirstlane(pblk[6]));
  const int e_mode=(int)__builtin_amdgcn_readfirstlane(pblk[7]);
  bf16*const e_O=(bf16*)(((unsigned long long)e1<<32)|e0); const float*const e_gsub=(const float*)(((unsigned long long)e3<<32)|e2);
  l_reg+=__builtin_amdgcn_exp2f(e_sink-mhat);
  if(hi==0)wsf[32+r32]=l_reg;asm volatile("s_waitcnt lgkmcnt(0)":::"memory");
  float rli[16];
  #pragma unroll
  for(int r=0;r<16;++r)rli[r]=__builtin_amdgcn_rcpf(wsf[32+crow(r,hi)]);
  bf16*Ow=e_O+(long)(wid*QBLK)*OP;
  if(e_mode==0){ bf16*stg=(bf16*)(shm+LDS_OST)+wid*4096;
    #pragma unroll
    for(int r=0;r<16;++r){const int orow=crow(r,hi);
      #pragma unroll
      for(int d0=0;d0<2;++d0)stg[orow*64+d0*32+r32]=__float2bfloat16(o[d0][r]*rli[r]);}
    asm volatile("s_waitcnt lgkmcnt(0)":::"memory");
    #pragma unroll
    for(int i=0;i<4;++i){const int row=i*8+(lane>>3),ch=lane&7; const u32x4 v=*(const u32x4*)(stg+row*64+ch*8); ATTN_STORE16(Ow+(long)row*OP+ch*8,v);} }
  else { float*stg=(float*)(shm+LDS_OST)+wid*2048;
    if(e_mode==1){
      #pragma unroll
      for(int r=0;r<16;++r){const int orow=crow(r,hi);
        #pragma unroll
        for(int d0=0;d0<2;++d0)stg[orow*64+d0*32+r32]=o[d0][r]*rli[r];}
      asm volatile("s_waitcnt lgkmcnt(0)":::"memory");
    } else {
      #pragma unroll
      for(int r=0;r<16;++r){const int orow=crow(r,hi);
        #pragma unroll
        for(int d0=0;d0<2;++d0){const int ix=orow*64+d0*32+r32; stg[ix]=stg[ix]-e_lam*(o[d0][r]*rli[r]);}}
      asm volatile("s_waitcnt lgkmcnt(0)":::"memory");
      int ln=lane; asm volatile("":"+v"(ln));
      const int ch=ln&15; const f32x4v gs=*(const f32x4v*)(e_gsub+ch*4);
      const int bp1=(ln^1)<<2,bp2=(ln^2)<<2,bp4=(ln^4)<<2,bp8=(ln^8)<<2;
      #pragma unroll
      for(int i=0;i<8;++i){const int row=i*4+(ln>>4); const f32x4v v=*(const f32x4v*)(stg+row*64+ch*4);
        float ss=(v[0]*v[0]+v[1]*v[1])+(v[2]*v[2]+v[3]*v[3]);
        ss+=__builtin_bit_cast(float,__builtin_amdgcn_ds_bpermute(bp1,__builtin_bit_cast(int,ss)));ss+=__builtin_bit_cast(float,__builtin_amdgcn_ds_bpermute(bp2,__builtin_bit_cast(int,ss)));
        ss+=__builtin_bit_cast(float,__builtin_amdgcn_ds_bpermute(bp4,__builtin_bit_cast(int,ss)));ss+=__builtin_bit_cast(float,__builtin_amdgcn_ds_bpermute(bp8,__builtin_bit_cast(int,ss)));
        const float rn=e_osc*__builtin_amdgcn_rsqf(ss*(1.0f/64.0f)+1e-6f);
        u32x2v w; w[0]=cvtpk_s(v[0]*rn*gs[0],v[1]*rn*gs[1]); w[1]=cvtpk_s(v[2]*rn*gs[2],v[3]*rn*gs[3]);
        *(u32x2v*)(Ow+(long)row*OP+ch*4)=w;}
    }
  }
  __builtin_amdgcn_s_setprio(0);
  asm volatile("s_waitcnt lgkmcnt(0)\n\ts_barrier":::"memory");
  #undef TROW
  #undef DMA_K
  #undef DMA_V
  #undef CMASK
  #undef START
  #undef RESC
  #undef ROT
}

constexpr int ATTN_LDS_BYTES=LDS_BYTES;
#undef SBAR
#undef WAIT_BAR
}
namespace cg = cooperative_groups;
#define GAS __attribute__((address_space(1)))
#define LAS __attribute__((address_space(3)))
typedef unsigned short bf16;
typedef unsigned v4u __attribute__((ext_vector_type(4)));
typedef unsigned v2u __attribute__((ext_vector_type(2)));
typedef float f32x4 __attribute__((ext_vector_type(4)));
constexpr int NWAVES = 8;
constexpr int SEQ = 16384, CTXL = 256, TPB = SEQ + CTXL, NBATCH = 2, MROWS = NBATCH * TPB, D = 1024, NIN = 2048, FF = 2816, NUP = 2 * FF;
constexpr float LOG2E = 1.4426950408889634f;
constexpr float C2A = 0.125f * LOG2E, C2B = 0.17677669529663687f * LOG2E;
constexpr size_t MiB = 1u << 20;
constexpr size_t WS_MOD = 1 * MiB;
constexpr size_t WS_ROPE = WS_MOD + 512 * 1024;
constexpr size_t WS_WIN = 2 * MiB, WS_WOUT = 10 * MiB, WS_WUP = 14 * MiB, WS_WDN = 36 * MiB;
constexpr size_t WS_XRES = 48 * MiB;
constexpr size_t WS_XN = 178 * MiB;
constexpr size_t WS_Q = 244 * MiB, WS_K = 326 * MiB, WS_V = 359 * MiB, WS_O = 392 * MiB;
constexpr size_t WS_U = 244 * MiB;
constexpr size_t WS_END = 458 * MiB;
static_assert(WS_Q + (size_t)MROWS * 1280 * 2 <= WS_K && WS_K + (size_t)MROWS * 512 * 2 <= WS_V && WS_V + (size_t)MROWS * 512 * 2 <= WS_O && WS_O + (size_t)MROWS * 1024 * 2 <= WS_END, "ws map");
static_assert(WS_U + (size_t)MROWS * FF * 2 <= WS_END && WS_XN + (size_t)MROWS * D * 2 <= WS_Q && WS_XRES + (size_t)MROWS * D * 4 <= WS_XN, "ws map 2");
constexpr int LDS_BYTES = 147456;
#ifndef ABL_ZERO_C
#define ABL_ZERO_C 0
#endif

__device__ __forceinline__ unsigned f2bf(float f) { unsigned u = __builtin_bit_cast(unsigned, f); return (u + 0x7fffu + ((u >> 16) & 1u)) >> 16; }
__device__ __forceinline__ unsigned pk2(float lo, float hi) { return f2bf(lo) | (f2bf(hi) << 16); }
__device__ __forceinline__ float wave_sum_l(float v, int lane) {
#pragma unroll
    for (int o = 1; o < 64; o <<= 1) v += __int_as_float(__builtin_amdgcn_ds_bpermute((lane ^ o) << 2, __float_as_int(v)));
    return v;
}
__device__ __forceinline__ float wave_sum(float v) {
#pragma unroll
    for (int o = 1; o < 64; o <<= 1) v += __shfl_xor(v, o);
    return v;
}
__device__ __forceinline__ void tr_item(const float* W, int ldw, int k0, int ncol0, bf16* WT, int Kt, int prow0, LAS float* scr, int lane) {
#pragma unroll 8
    for (int i = 0; i < 32; ++i) { const int kk = 2 * i + (lane >> 5); scr[kk * 33 + (lane & 31)] = W[(size_t)(k0 + kk) * ldw + ncol0 + (lane & 31)]; }
    asm volatile("s_waitcnt lgkmcnt(0)" ::: "memory");
    const int c = lane & 7;
#pragma unroll
    for (int j = 0; j < 4; ++j) { const int n = (lane >> 3) + 8 * j; const LAS float* s = scr + (8 * c) * 33 + n;
        v4u o; o.x = pk2(s[0 * 33], s[1 * 33]); o.y = pk2(s[2 * 33], s[3 * 33]); o.z = pk2(s[4 * 33], s[5 * 33]); o.w = pk2(s[6 * 33], s[7 * 33]);
        *(v4u*)(WT + (size_t)(prow0 + n) * Kt + k0 + 8 * c) = o; }
    asm volatile("s_waitcnt lgkmcnt(0)" ::: "memory");
}


template <int KIND> __device__ __forceinline__ void norm_rows(int gw, int NGW, int lane, const float* xin, const float* cin, float* xres, bf16* xn, float* outp, const float* gvec, const float* modr, int sidx) {
    const int nrows = KIND == 2 ? NBATCH * SEQ : MROWS;
    for (int m0 = gw; m0 < nrows; m0 += 2 * NGW) {
        int mm[2]; mm[0] = m0; mm[1] = (m0 + NGW < nrows) ? m0 + NGW : m0;
        f32x4 v[2][4]; float ss[2]; int rr[2]; size_t xrow[2];
#pragma unroll
        for (int u = 0; u < 2; ++u) {
            const int m = mm[u];
            const float* src;
            if (KIND == 2) { const int b = m >= SEQ ? 1 : 0, t = m - b * SEQ; xrow[u] = (size_t)b * TPB + t; rr[u] = b; src = xres + xrow[u] * D; }
            else { const int b = m >= TPB ? 1 : 0, t = m - b * TPB; rr[u] = t >= SEQ ? 2 : b; xrow[u] = (size_t)m;
                   src = KIND == 0 ? (t < SEQ ? xin + ((size_t)b * SEQ + t) * D : cin + ((size_t)b * CTXL + (t - SEQ)) * D) : xres + (size_t)m * D; }
            const f32x4* xr = (const f32x4*)src + lane; float s = 0.f;
#pragma unroll
            for (int j = 0; j < 4; ++j) { v[u][j] = xr[64 * j]; s += (v[u][j][0] * v[u][j][0] + v[u][j][1] * v[u][j][1]) + (v[u][j][2] * v[u][j][2] + v[u][j][3] * v[u][j][3]); }
            ss[u] = s;
        }
#pragma unroll
        for (int u = 0; u < 2; ++u) {
            const float rn = 1.0f / sqrtf(wave_sum_l(ss[u], lane) * (1.0f / D) + 1e-6f);
            if (KIND == 2) { f32x4* o = (f32x4*)(outp + (size_t)mm[u] * D) + lane;
#pragma unroll
                for (int j = 0; j < 4; ++j) { const int col = 4 * (lane + 64 * j); const f32x4 g4 = *(const f32x4*)(gvec + col); o[64 * j] = v[u][j] * rn * g4; } }
            else { const float* sh = modr + rr[u] * 6144 + sidx * 1024; const float* sc = sh + 1024; v2u* o8 = (v2u*)(xn + xrow[u] * D) + lane;
#pragma unroll
                for (int j = 0; j < 4; ++j) { const int col = 4 * (lane + 64 * j); const f32x4 g4 = *(const f32x4*)(gvec + col), s4 = *(const f32x4*)(sh + col), c4 = *(const f32x4*)(sc + col);
                    const f32x4 y = (v[u][j] * rn * g4) * (c4 + 1.0f) + s4; v2u w; w.x = pg8::pk_bf16(y[0], y[1]); w.y = pg8::pk_bf16(y[2], y[3]); o8[64 * j] = w; } }
        }
    }
}

#ifndef SELFCHECK
#define SELFCHECK 0
#endif
__device__ __forceinline__ float bf2f(unsigned short x) { return __uint_as_float((unsigned)x << 16); }
__device__ __forceinline__ float wave_max(float v) {
#pragma unroll
    for (int o = 1; o < 64; o <<= 1) v = fmaxf(v, __shfl_xor(v, o));
    return v;
}
__device__ __forceinline__ float naive_row(const bf16* Qrow, const bf16* Kb, const bf16* Vb, int kind, int t, float sinkl2, int lane, LAS float* xch) {
    float q[64]; asm volatile("" : "+v"(Qrow));
#pragma unroll
    for (int c = 0; c < 8; ++c) { const v4u w = *(const v4u*)(Qrow + 8 * c);
#pragma unroll
        for (int e = 0; e < 4; ++e) { q[8 * c + 2 * e] = __uint_as_float(w[e] << 16); q[8 * c + 2 * e + 1] = __uint_as_float(w[e] & 0xffff0000u); } }
    int lo = 0, nb = 0, n;
    if (kind == 0) n = TPB; else if (kind == 1) n = CTXL; else { lo = t - 128 < 0 ? 0 : t - 128; const int hi = t + 128 > SEQ - 1 ? SEQ - 1 : t + 128; nb = hi - lo + 1; n = nb + CTXL; }
    float m = -INFINITY, l = 0.f, o[64];
#pragma unroll
    for (int d = 0; d < 64; ++d) o[d] = 0.f;
    for (int j = lane; j < n; j += 64) {
        const int row = kind == 0 ? j : (kind == 1 ? SEQ + j : (j < nb ? lo + j : SEQ + (j - nb)));
        float sc = 0.f;
#pragma unroll
        for (int c = 0; c < 8; ++c) { const v4u w = *(const v4u*)(Kb + (size_t)row * 512 + 8 * c);
#pragma unroll
            for (int e = 0; e < 4; ++e) { sc += q[8 * c + 2 * e] * __uint_as_float(w[e] << 16); sc += q[8 * c + 2 * e + 1] * __uint_as_float(w[e] & 0xffff0000u); } }
        if (sc > m) { const float f = __builtin_amdgcn_exp2f(m - sc); l *= f;
#pragma unroll
            for (int d = 0; d < 64; ++d) o[d] *= f;
            m = sc; }
        const float p = __builtin_amdgcn_exp2f(sc - m); l += p;
#pragma unroll
        for (int c = 0; c < 8; ++c) { const v4u w = *(const v4u*)(Vb + (size_t)row * 512 + 8 * c);
#pragma unroll
            for (int e = 0; e < 4; ++e) { o[8 * c + 2 * e] += p * __uint_as_float(w[e] << 16); o[8 * c + 2 * e + 1] += p * __uint_as_float(w[e] & 0xffff0000u); } }
    }
    const float M = wave_max(m); const float f = (m == -INFINITY) ? 0.f : __builtin_amdgcn_exp2f(m - M);
    float lt = wave_sum(l * f) + __builtin_amdgcn_exp2f(sinkl2 - M);
    const bool l0 = lane == 0;
#pragma unroll
    for (int d = 0; d < 64; ++d) { const float sd = wave_sum(o[d] * f); if (l0) xch[d] = sd; }
    asm volatile("s_waitcnt lgkmcnt(0)" ::: "memory"); const float od = xch[lane]; asm volatile("s_waitcnt lgkmcnt(0)" ::: "memory");
    return od / lt;
}

__device__ __forceinline__ void sincos_d(double a, float& sn, float& cs) {
    const double k = rint(a * 0.15915494309189535); const double r = a - k * 6.283185307179586476925;
    const double r2 = r * r; double ts = r, tc = 1.0, ss = r, cc = 1.0;
#pragma unroll 1
    for (int i = 1; i < 16; ++i) { tc = -tc * r2 / (double)((2 * i - 1) * (2 * i)); ts = -ts * r2 / (double)((2 * i) * (2 * i + 1)); cc += tc; ss += ts; }
    sn = (float)ss; cs = (float)cc;
}
#define XB_TMO      128
#define XB_XCNT(j)  (256  + 64 * (j))
#define XB_XSUB(j)  (1280 + 64 * (j))
#define XB_XGEN(j)  (2304 + 64 * (j))
#define XB_TOP      3328
#define XB_TOPGEN   3392
#define XCD_BAR_WORDS 3456
#define XB_SPIN_CAP (1u << 18)

__device__ __forceinline__ unsigned xb_ld(unsigned* p)              { return __hip_atomic_load(p, __ATOMIC_RELAXED, __HIP_MEMORY_SCOPE_AGENT); }
__device__ __forceinline__ unsigned xb_add(unsigned* p, unsigned v) { return __hip_atomic_fetch_add(p, v, __ATOMIC_RELAXED, __HIP_MEMORY_SCOPE_AGENT); }
__device__ __forceinline__ unsigned xb_xcc_id() { return (unsigned)__builtin_amdgcn_s_getreg((3 << 11) | 20) & 0xFu; }
#define XB_SPIN(cond, bar) do { unsigned _sp = 0; while (cond) { __builtin_amdgcn_s_sleep(1); \
    if ((++_sp & 255u) == 0u) { if (xb_ld(&(bar)[XB_TMO])) break; if (_sp > XB_SPIN_CAP) { atomicAdd(&(bar)[XB_TMO], 1u); break; } } } } while (0)

struct XcdBarrier {
    unsigned* bar; unsigned x;
    volatile LAS unsigned* st;
};

__device__ __forceinline__ XcdBarrier xcd_barrier_post(unsigned* bar, volatile LAS unsigned* st) {
    XcdBarrier b; b.bar = bar; b.x = xb_xcc_id(); b.st = st;
    if (threadIdx.x == 0) (void)xb_add(&bar[XB_XCNT(b.x)], 1u);
    return b;
}
__device__ __forceinline__ void xcd_barrier_complete(unsigned* bar, unsigned x, unsigned& nloc, unsigned& nx) {
    const unsigned G = gridDim.x * gridDim.y * gridDim.z;
    unsigned sum, cnt, mine, sp = 0u;
    for (;;) {
        sum = 0u; cnt = 0u; mine = 0u;
#pragma unroll
        for (unsigned j = 0; j < 16; ++j) { const unsigned c = xb_ld(&bar[XB_XCNT(j)]); sum += c; cnt += (c > 0u) ? 1u : 0u; mine = (j == x) ? c : mine; }
        if (sum == G) break;
        __builtin_amdgcn_s_sleep(1);
        if ((++sp & 255u) == 0u) { if (xb_ld(&bar[XB_TMO])) break; if (sp > XB_SPIN_CAP) { atomicAdd(&bar[XB_TMO], 1u); break; } }
    }
    nloc = mine > 0u ? mine : 1u; nx = cnt > 0u ? cnt : 1u;
}

__device__ __forceinline__ void xcd_barrier(const XcdBarrier& b) {
    asm volatile("s_waitcnt vmcnt(0)" ::: "memory");
    __syncthreads();
    if (threadIdx.x == 0) {
        unsigned* bar = b.bar;
        __builtin_amdgcn_s_waitcnt(0);
        unsigned nloc = b.st[0], nx = b.st[1];
        if (nloc == 0u) { xcd_barrier_complete(bar, b.x, nloc, nx); b.st[0] = nloc; b.st[1] = nx; }
        const unsigned old = xb_add(&bar[XB_XSUB(b.x)], 1u);
        const unsigned gen = old / nloc;
        if (old + 1u == (gen + 1u) * nloc) {
            __builtin_amdgcn_fence(__ATOMIC_RELEASE, "agent");
            asm volatile("s_waitcnt vmcnt(0)" ::: "memory");
            const unsigned og = xb_add(&bar[XB_TOP], 1u);
            const unsigned tg = og / nx;
            if (og + 1u == (tg + 1u) * nx) xb_add(&bar[XB_TOPGEN], 1u);
            else XB_SPIN(xb_ld(&bar[XB_TOPGEN]) == tg, bar);
            __builtin_amdgcn_fence(__ATOMIC_ACQUIRE, "agent");
            xb_add(&bar[XB_XGEN(b.x)], 1u);
            asm volatile("s_waitcnt vmcnt(0)" ::: "memory");
        } else {
            XB_SPIN(xb_ld(&bar[XB_XGEN(b.x)]) == gen, bar);
            __builtin_amdgcn_fence(__ATOMIC_ACQUIRE, "agent");
            asm volatile("s_waitcnt vmcnt(0)" ::: "memory");
        }
    }
    __syncthreads();
}
constexpr size_t WS_BAR = 65536;
constexpr int LDS_XB = LDS_BYTES - 64;
struct Args { const float* in[22]; float* out; unsigned char* ws; };
typedef const float* const __attribute__((address_space(4)))* kargp_t;
__device__ __forceinline__ const float* kin(int i) { kargp_t ka = (kargp_t)__builtin_amdgcn_kernarg_segment_ptr(); asm volatile("" : "+s"(ka)); return ka[i]; }
__device__ __forceinline__ unsigned char* kws() { return (unsigned char*)kin(23); }


#define x_in kin(0)
#define c_in kin(1)
#define ctx_in kin(2)
#define cctx_in kin(3)
#define w_ada kin(4)
#define b_ada kin(5)
#define g_attn kin(6)
#define g_ffn kin(7)
#define w_in kin(8)
#define g_q kin(9)
#define g_k kin(10)
#define lam_q1 kin(11)
#define lam_k1 kin(12)
#define lam_q2 kin(13)
#define lam_k2 kin(14)
#define g_subln kin(15)
#define sink_logit kin(16)
#define w_out kin(17)
#define w_ff1 kin(18)
#define w_ff3 kin(19)
#define w_ff2 kin(20)
#define g_final kin(21)
#define MOD ((float*)(kws() + WS_MOD))
#define NMAX ((unsigned*)(kws() + 8192))
#define QCNT ((unsigned*)(kws() + 8192 + 512))
#define MODRDY ((unsigned*)(kws() + WS_BAR + 14336))
#define cosA ((float*)(kws() + WS_ROPE))
#define sinA (cosA + 256 * 16)
#define cosB (cosA + 2 * 256 * 16)
#define sinB (cosA + 2 * 256 * 16 + 256 * 8)
#define WIN ((bf16*)(kws() + WS_WIN))
#define WOUT ((bf16*)(kws() + WS_WOUT))
#define WUP ((bf16*)(kws() + WS_WUP))
#define WDN ((bf16*)(kws() + WS_WDN))
#define XRES ((float*)(kws() + WS_XRES))
#define XN ((bf16*)(kws() + WS_XN))
#define bQ ((bf16*)(kws() + WS_Q))
#define bK ((bf16*)(kws() + WS_K))
#define bV ((bf16*)(kws() + WS_V))
#define bO ((bf16*)(kws() + WS_O))
#define bU ((bf16*)(kws() + WS_U))
__global__ void __launch_bounds__(NWAVES * 64, 2) mega_fwd(Args args) {
    extern __shared__ __attribute__((aligned(16))) unsigned char lds[];
    cg::grid_group grid = cg::this_grid();
#define CG_SYNC() do { asm volatile("s_waitcnt vmcnt(0) lgkmcnt(0)" ::: "memory"); grid.sync(); } while (0)
#define GRID_SYNC() do { XcdBarrier xb_; xb_.bar = (unsigned*)(kws() + WS_BAR); xb_.x = xb_xcc_id(); xb_.st = (volatile LAS unsigned*)((LAS unsigned char*)lds + LDS_XB); xcd_barrier(xb_); } while (0)
    if (threadIdx.x < 2) ((volatile LAS unsigned*)((LAS unsigned char*)lds + LDS_XB))[threadIdx.x] = 0u;
    __syncthreads();
    (void)xcd_barrier_post((unsigned*)(kws() + WS_BAR), (volatile LAS unsigned*)((LAS unsigned char*)lds + LDS_XB));
#define PHASE_IDS int tid = threadIdx.x, bx = blockIdx.x, G = gridDim.x; asm volatile("" : "+v"(tid)); bx = __builtin_amdgcn_readfirstlane(bx); G = __builtin_amdgcn_readfirstlane(G); \
    const int lane = tid & 63, wave = __builtin_amdgcn_readfirstlane(tid >> 6), vcu = (G % 8 == 0) ? (bx % 8) * (G / 8) + bx / 8 : bx, gw = vcu * NWAVES + wave, NGW = G * NWAVES; \
    (void)lane; (void)wave; (void)vcu; (void)gw; (void)NGW;
    {
        PHASE_IDS
        const int gt = gw * 64 + lane; float* const ca = cosA; float* const sa = sinA; float* const cb_ = cosB; float* const sb_ = sinB;
        if (gt < 256 * 16) { const int pos = gt >> 4, i = gt & 15; const float fr = __builtin_amdgcn_exp2f(-(float)i * (13.287712379549449f / 16.0f)); const float a = (float)pos * fr;
            const double rev = (double)a * 0.15915494309189535; const float f = (float)(rev - floor(rev)); ca[gt] = __builtin_amdgcn_cosf(f); sa[gt] = __builtin_amdgcn_sinf(f); }
        else if (gt < 256 * 16 + 256 * 8) { const int q = gt - 256 * 16; const int pos = q >> 3, i = q & 7; const float fr = __builtin_amdgcn_exp2f(-(float)i * (13.287712379549449f / 8.0f)); const float a = (float)pos * fr;
            const double rev = (double)a * 0.15915494309189535; const float f = (float)(rev - floor(rev)); cb_[q] = __builtin_amdgcn_cosf(f); sb_[q] = __builtin_amdgcn_sinf(f); }
        if (gt < 64) NMAX[gt] = 0u;
        if (gt >= 64 && gt < 66) QCNT[gt - 64] = 0u;
        LAS float* s_lds = (LAS float*)lds; LAS float* part = (LAS float*)(lds + 12288);
        if (bx < 192) {
            const float* const cp = c_in; const float* const ccp = cctx_in; const float* const bap = b_ada; float* const modp = MOD;
            for (int i = tid; i < 3 * 1024; i += NWAVES * 64) { const float cv = (i < 2048) ? cp[i] : ccp[i - 2048]; s_lds[i] = cv / (1.0f + expf(-cv)); }
            __syncthreads();
            for (int bt = bx; bt < 192; bt += G) { const int l = bt / 96, cb = bt % 96;
                const float* W = w_ada + (size_t)l * 1024 * 6144 + 64 * cb + lane; float a0 = 0.f, a1 = 0.f, a2 = 0.f;
#pragma unroll 16
                for (int kk = 0; kk < 128; ++kk) { const int k = 128 * wave + kk; const float wv = W[(size_t)k * 6144]; a0 += s_lds[k] * wv; a1 += s_lds[1024 + k] * wv; a2 += s_lds[2048 + k] * wv; }
                part[(wave * 3 + 0) * 64 + lane] = a0; part[(wave * 3 + 1) * 64 + lane] = a1; part[(wave * 3 + 2) * 64 + lane] = a2;
                __syncthreads();
                if (tid < 192) { const int r = tid >> 6, ln = tid & 63; float s = bap[l * 6144 + 64 * cb + ln];
#pragma unroll
                    for (int w = 0; w < 8; ++w) s += part[(w * 3 + r) * 64 + ln];
                    modp[(l * 3 + r) * 6144 + 64 * cb + ln] = s; }
                asm volatile("s_waitcnt vmcnt(0)" ::: "memory");
                __syncthreads();
                if (l == 0 && tid == 0) {
                    __builtin_amdgcn_fence(__ATOMIC_RELEASE, "agent"); asm volatile("s_waitcnt vmcnt(0)" ::: "memory");
                    __hip_atomic_fetch_add(MODRDY, 1u, __ATOMIC_RELAXED, __HIP_MEMORY_SCOPE_AGENT); }
            }
        }
        __syncthreads();
        LAS float* scr = (LAS float*)(lds + wave * 16384);
        constexpr int I_IN = 16 * 64, I_OUT = 16 * 32, I_UP = 16 * 176, I_DN = 44 * 32, I_L = I_IN + I_OUT + I_UP + I_DN;
        const float* const wf1_ = w_ff1; const float* const wf3_ = w_ff3;
        for (int it = gw; it < 2 * I_L; it += NGW) {
            const int l = it / I_L; int r = it % I_L;
            if (r < I_IN) { const int kb = r / 64, pblk = r % 64, tile = pblk >> 3, pb = pblk & 7, lb = 2 * (pb & 3) + (pb >> 2);
                tr_item(w_in + (size_t)l * 1024 * 2048, 2048, 64 * kb, 256 * tile + 32 * lb, WIN + (size_t)l * 2048 * 1024, 1024, 32 * pblk, scr, lane); continue; } r -= I_IN;
            if (r < I_OUT) { const int kb = r / 32, pblk = r % 32;
                tr_item(w_out + (size_t)l * 1024 * 1024, 1024, 64 * kb, 32 * pblk, WOUT + (size_t)l * 1024 * 1024, 1024, 32 * pblk, scr, lane);
                if (ABL_ZERO_C && 64 * kb < 384) { for (int j = 0; j < 4; ++j) { const int n = (lane >> 3) + 8 * j; *(v4u*)(WOUT + (size_t)l * 1024 * 1024 + (size_t)(32 * pblk + n) * 1024 + 64 * kb + 8 * (lane & 7)) = (v4u){0u, 0u, 0u, 0u}; } }
                continue; } r -= I_OUT;
            if (r < I_UP) { const int kb = r / 176, pblk = r % 176, p = pblk >> 3, bj = (pblk >> 2) & 1, q = pblk & 3;
                tr_item((bj ? wf3_ : wf1_) + (size_t)l * 1024 * FF, FF, 64 * kb, 128 * p + 32 * q, WUP + (size_t)l * NUP * 1024, 1024, 32 * pblk, scr, lane); continue; } r -= I_UP;
            { const int kb = r / 32, pblk = r % 32;
                tr_item(w_ff2 + (size_t)l * FF * 1024, 1024, 64 * kb, 32 * pblk, WDN + (size_t)l * 1024 * FF, FF, 32 * pblk, scr, lane); }
        }
    }
    if (gridDim.x == 0x7fffffffu) CG_SYNC();
    {
        if ((threadIdx.x & 63) == 0) { unsigned sp_ = 0; while (__hip_atomic_load(MODRDY, __ATOMIC_RELAXED, __HIP_MEMORY_SCOPE_AGENT) < 96u) { __builtin_amdgcn_s_sleep(2); if (++sp_ > (1u << 22)) break; } }
        __builtin_amdgcn_fence(__ATOMIC_ACQUIRE, "agent"); asm volatile("s_waitcnt vmcnt(0)" ::: "memory");
    }

#pragma unroll 1
    for (int L = 0; L < 2; ++L) {
#define modl (MOD + (size_t)L * 3 * 6144)
        if (L == 0) {
            PHASE_IDS
            norm_rows<0>(gw, NGW, lane, x_in, ctx_in, XRES, XN, nullptr, g_attn + L * D, modl, 0);
            GRID_SYNC();
        }
        {
            PHASE_IDS
            pg8::Gemm g{XN, WIN + (size_t)L * 2048 * 1024, MROWS, NIN, D}; pg8::Order S; S.init(MROWS / 256, NIN, G, bx, 0);
            pg8::EpiQKV E{bQ, bK, bV, g_q + L * 64, g_k + L * 64, cosA, sinA, cosB, sinB, C2A, C2B, NMAX + L * 32};
#ifndef NO_G1
            pg8::gemm_phase<pg8::EpiQKV, pg8::Order, PG8_ALIGN, PG8_SP2>((PG8_LAS unsigned char*)lds, g, S, E);
#endif
        }
        GRID_SYNC();
        {
            PHASE_IDS
            int Lq_ = L; asm volatile("" : "+s"(Lq_)); const float lam_init = (Lq_ == 0) ? 0.2f : 0.35550907f;
            float d1 = 0.f, d2 = 0.f;

#pragma unroll 1
                    for (int i = 0; i < 32; ++i) { d1 += lam_q1[L * 32 + i] * lam_k1[L * 32 + i]; d2 += lam_q2[L * 32 + i] * lam_k2[L * 32 + i]; }
            const float lam = expf(d1) - expf(d2) + lam_init;
            float mgq = 0.f, mgk = 0.f;
#pragma unroll 1
            for (int i = 0; i < 64; ++i) { mgq = fmaxf(mgq, fabsf(g_q[L * 64 + i])); mgk = fmaxf(mgk, fabsf(g_k[L * 64 + i])); }
            const float amfix = 8.0f * mgq * mgk * LOG2E * 1.02f;
            const int NTOT = 512 + 768 + 768 + (L == 0 ? 32 : 0);
            int un = vcu; bool dynq = false;
            for (;;) {
                if (!dynq && un >= 1280) dynq = true;
                if (dynq) { volatile LAS unsigned* qw = (volatile LAS unsigned*)((LAS unsigned char*)lds + LDS_XB + 16); __syncthreads();
                    if (tid == 0) qw[0] = __hip_atomic_fetch_add(QCNT + L, 1u, __ATOMIC_RELAXED, __HIP_MEMORY_SCOPE_AGENT);
                    __syncthreads(); un = 1280 + (int)__builtin_amdgcn_readfirstlane(qw[0]); }
                if (un >= NTOT) break;
                attn_body::AttnParams P; int b, h, qb, type;
                if (un < 512) { const int v = un & 255, xx = v >> 5; type = 1; b = xx >> 2; h = xx & 3; qb = (v & 31) + 32 * (un >> 8); }
                else if (un < 2048) { const int ia = (un - 512) % 768; type = (un < 1280) ? 0 : 2; const int v = ia & 255, rnd = ia >> 8, xx = v >> 5, gi = xx >> 1, uu = 96 * (xx & 1) + 3 * (v & 31) + rnd;
                    b = gi >> 1; h = 3 * (gi & 1) + uu / 64; qb = uu % 64; }
                else { const int ic = un - 2048; qb = 64; if (ic < 12) { type = 0; b = ic / 6; h = ic % 6; } else if (ic < 20) { type = 1; b = (ic - 12) / 4; h = (ic - 12) % 4; } else { type = 2; b = (ic - 20) / 6; h = (ic - 20) % 6; } }
                const bool isctx = qb == 64;
                const int qcol = type == 0 ? h : (type == 1 ? 6 + 2 * h : 14 + h), kcol = type == 0 ? h / 3 : (type == 1 ? 2 + h : 6 + h / 3), ocol = type == 0 ? h : (type == 1 ? 6 + h : 10 + h);
                const size_t row0 = (size_t)b * TPB + 256 * qb;
                P.Q = (const attn_body::bf16*)(bQ + row0 * 1280 + qcol * 64);
                P.K = (const attn_body::bf16*)(bK + (size_t)b * TPB * 512 + kcol * 64);
                P.V = (const attn_body::bf16*)(bV + (size_t)b * TPB * 512 + kcol * 64);
                P.O = (attn_body::bf16*)(bO + row0 * 1024 + ocol * 64);
                P.gsub = g_subln + L * 64; P.lam = lam; P.oscale = 1.0f - lam_init; P.mode = 0;
                P.sinkl2 = type == 2 ? sink_logit[L * 6 + h] * LOG2E : -INFINITY;
                P.mask = 0; P.dq0 = 0; P.nomax = (type == 0) ? 1 : 0; P.mfix = amfix;
                if (isctx) { P.NT = 4; P.base_a = SEQ; P.base_b = SEQ; }
                else if (type == 2) { const int band0 = (256 * qb - 128) < 0 ? 0 : 256 * qb - 128, bend = (256 * qb + 384) > SEQ ? SEQ : 256 * qb + 384;
                    P.NT = 4 + (bend - band0) / 64; P.base_a = SEQ; P.base_b = band0; P.mask = 1; P.dq0 = 256 * qb - band0; }
                else { P.NT = TPB / 64; P.base_a = 0; P.base_b = 256; }
#ifndef NO_ATTN
                if (type != 1) { P.khalf = 0; attn_body::attn_unit<8, false>(P, (char*)lds); }
                else {
#pragma unroll 1
                    for (int ps = 0; ps < 2; ++ps) { P.mode = 1 + ps; P.khalf = ps; if (ps) P.Q += 64;
                        const unsigned* nm = NMAX + L * 32 + ((b * 4 + h) * 2 + ps) * 2;
                        const float q2 = __uint_as_float(__hip_atomic_load(nm, __ATOMIC_RELAXED, __HIP_MEMORY_SCOPE_AGENT)), k2 = __uint_as_float(__hip_atomic_load(nm + 1, __ATOMIC_RELAXED, __HIP_MEMORY_SCOPE_AGENT));
                        P.nomax = 1; P.mfix = sqrtf(q2) * sqrtf(k2) * 1.02f;
                        attn_body::attn_unit<8, true>(P, (char*)lds); } }
#endif
                if (!dynq) un += G;
            }
        }
        GRID_SYNC();
#if SELFCHECK
        {
            PHASE_IDS
            if (wave == 0 && bx < 12 && (L == 0 || bx < 8 || bx == 11)) {
                int type, b, h, t;
                switch (bx) { case 0: type = 0; b = 0; h = 1; t = 1000; break; case 1: type = 0; b = 1; h = 4; t = 16383; break; case 2: type = 1; b = 0; h = 0; t = 5; break; case 3: type = 1; b = 1; h = 3; t = 9000; break;
                    case 4: type = 2; b = 0; h = 2; t = 7777; break; case 5: type = 2; b = 1; h = 0; t = 100; break; case 6: type = 2; b = 0; h = 5; t = 16380; break; case 7: type = 2; b = 1; h = 3; t = 256; break;
                    case 8: type = 0; b = 0; h = 2; t = SEQ + 17; break; case 9: type = 1; b = 1; h = 1; t = SEQ + 200; break; case 10: type = 2; b = 0; h = 4; t = SEQ + 255; break; default: type = 0; b = 0; h = 0; t = 0; break; }
                const int qcol = type == 0 ? h : (type == 1 ? 6 + 2 * h : 14 + h), kcol = type == 0 ? h / 3 : (type == 1 ? 2 + h : 6 + h / 3), ocol = type == 0 ? h : (type == 1 ? 6 + h : 10 + h);
                const bf16* Qrow = bQ + ((size_t)b * TPB + t) * 1280 + qcol * 64; const bf16* Kb = bK + (size_t)b * TPB * 512 + kcol * 64; const bf16* Vb = bV + (size_t)b * TPB * 512 + kcol * 64;
                const int kind = t >= SEQ ? 1 : (type == 2 ? 2 : 0); const float skl = type == 2 ? sink_logit[L * 6 + h] * LOG2E : -INFINITY;
                float ref = naive_row(Qrow, Kb, Vb, kind, t, skl, lane, (LAS float*)lds);
                if (type == 1) { const float r2 = naive_row(Qrow + 64, Kb, Vb, kind, t, skl, lane, (LAS float*)lds);
                    int Lq_ = L; asm volatile("" : "+s"(Lq_)); const float lam_init = (Lq_ == 0) ? 0.2f : 0.35550907f;   float d1 = 0.f, d2 = 0.f;

#pragma unroll 1
                    for (int i = 0; i < 32; ++i) { d1 += lam_q1[L * 32 + i] * lam_k1[L * 32 + i]; d2 += lam_q2[L * 32 + i] * lam_k2[L * 32 + i]; }
                    const float lam = expf(d1) - expf(d2) + lam_init; const float v = ref - lam * r2; const float ss = wave_sum(v * v);
                    ref = v / sqrtf(ss * (1.0f / 64.0f) + 1e-6f) * g_subln[L * 64 + lane] * (1.0f - lam_init); }
                const float got = bf2f(bO[((size_t)b * TPB + t) * 1024 + ocol * 64 + lane]);
                const float err = wave_max(fabsf(ref - got)), rms = sqrtf(wave_sum(ref * ref) * (1.0f / 64.0f));
                if (lane == 0) ((float*)(kws() + 4096))[L * 32 + bx] = err / (rms + 1e-20f);
            }
            if (wave == 0 && bx >= 12 && bx < 14) {
                const int m = bx == 12 ? (TPB + 12345) : (SEQ + 3); const int b = m >= TPB ? 1 : 0, t = m - b * TPB, r = t >= SEQ ? 2 : b;
                const float* src = (L == 0) ? (t < SEQ ? x_in + ((size_t)b * SEQ + t) * D : ctx_in + ((size_t)b * CTXL + (t - SEQ)) * D) : nullptr;
                float worst = 0.f;
                if (L == 0) {
                    float ssq = 0.f; for (int k = lane; k < D; k += 64) ssq += src[k] * src[k];
                    const float rn = 1.0f / sqrtf(wave_sum(ssq) * (1.0f / D) + 1e-6f);
                    const float* cvec = r == 2 ? cctx_in : c_in + r * D;
#pragma unroll 1
                    for (int col = lane; col < D; col += 64 * 8) {
                        float sh = b_ada[L * 6144 + col], sc = b_ada[L * 6144 + 1024 + col];
#pragma unroll 1
                        for (int k = 0; k < D; ++k) { const float cv = cvec[k]; const float sl = cv / (1.0f + expf(-cv)); sh += sl * w_ada[((size_t)L * D + k) * 6144 + col]; sc += sl * w_ada[((size_t)L * D + k) * 6144 + 1024 + col]; }
                        const float ref = src[col] * rn * g_attn[L * D + col] * (1.0f + sc) + sh; const float got = bf2f(XN[(size_t)m * D + col]);
                        worst = fmaxf(worst, fabsf(ref - got) / (fabsf(ref) + 0.05f));
                    }
                }
                worst = wave_max(worst);
                if (lane == 0) ((float*)(kws() + 4096))[L * 32 + bx] = worst;
            }
            if (wave == 0 && bx >= 16 && bx < 32) {
                const int gl[8] = {0, 6, 8, 11, 15, 23, 28, 31}; (void)gl;
                const int gi = (bx - 16) & 7; const int g = gi == 0 ? 0 : gi == 1 ? 6 : gi == 2 ? 8 : gi == 3 ? 11 : gi == 4 ? 15 : gi == 5 ? 23 : gi == 6 ? 18 : 31;
                const int m = (bx - 16) < 8 ? (TPB + 12345) : (SEQ + 3); const int b = m >= TPB ? 1 : 0, t = m - b * TPB; const bool isctx = t >= SEQ;
                const int d = lane; float acc = 0.f;
#pragma unroll 1
                for (int k = 0; k < D; ++k) acc += bf2f(XN[(size_t)m * D + k]) * bf2f((unsigned short)f2bf(w_in[((size_t)L * D + k) * 2048 + 64 * g + d]));
                const int kindq = g < 6 ? 0 : g < 8 ? 1 : g < 10 ? 2 : g < 14 ? 3 : g < 18 ? 4 : g < 22 ? 2 : g < 28 ? 5 : g < 30 ? 6 : 2;
                float v = acc;
                if (kindq == 0 || kindq == 1) { const float ss = wave_sum(v * v); v = v / sqrtf(ss * (1.0f / 64.0f) + 1e-6f) * (kindq == 0 ? g_q[L * 64 + d] : g_k[L * 64 + d]); }
                if (!isctx && kindq != 2) {
                    const int trow = t >> 6, tcol = t & 63;
                    if (kindq == 3 || kindq == 4) { const int e = d & 31, w = e & 15, i = w & 7; const int pos = (e >> 4) ? tcol : trow; const float fr = powf(10000.0f, -(float)i / 8.0f); const float ang = (float)pos * fr;
                        float sn, cs; sincos_d((double)ang, sn, cs); const float xp = __shfl_xor(v, 8); v = (w < 8) ? v * cs - xp * sn : xp * sn + v * cs; }
                    else { const int e = d & 31, i = e & 15; const int pos = (d >> 5) ? tcol : trow; const float fr = powf(10000.0f, -(float)i / 16.0f); const float ang = (float)pos * fr;
                        float sn, cs; sincos_d((double)ang, sn, cs); const float xp = __shfl_xor(v, 16); v = (e < 16) ? v * cs - xp * sn : xp * sn + v * cs; }
                }
                float got;
                const size_t row = (size_t)m;
                if (kindq == 0) { v *= C2A; got = bf2f(bQ[row * 1280 + 64 * g + d]); }
                else if (kindq == 1) got = bf2f(bK[row * 512 + 64 * (g - 6) + d]);
                else if (kindq == 3) { v *= C2B; const int vh = 6 + 2 * (g - 10) + (d >> 5); got = bf2f(bQ[row * 1280 + 64 * vh + d]); const float z = bf2f(bQ[row * 1280 + 64 * vh + (d ^ 32)]); if (__any(z != 0.f) && lane == 0) ((float*)(kws() + 4096))[200 + L * 32 + bx] = 1.0f; }
                else if (kindq == 4) got = bf2f(bK[row * 512 + 64 * (2 + g - 14) + d]);
                else if (kindq == 5) { v *= C2A; got = bf2f(bQ[row * 1280 + 64 * (14 + g - 22) + d]); }
                else if (kindq == 6) got = bf2f(bK[row * 512 + 64 * (6 + g - 28) + d]);
                else got = bf2f(bV[row * 512 + 64 * (g < 10 ? g - 8 : g < 22 ? 2 + g - 18 : 6 + g - 30) + d]);
                const float err = wave_max(fabsf(v - got)), rms = sqrtf(wave_sum(v * v) * (1.0f / 64.0f));
                if (lane == 0) ((float*)(kws() + 4096))[L * 32 + bx] = err / (rms + 1e-20f);
                { const float vp = __shfl_xor(v, 8), gp = __shfl_xor(got, 8); const float pr = v * v + vp * vp, pg = got * got + gp * gp; const float e2 = wave_max(fabsf(pr - pg)) / (wave_sum(pr) * (1.0f / 64.0f) + 1e-20f);
                  if (lane == 0) ((float*)(kws() + 4096))[100 + L * 32 + bx] = e2; }
            }
        }
#endif
        {
            const int skip = (L == 1) ? 1 : 0;
            PHASE_IDS
            pg8::Gemm g{bO, WOUT + (size_t)L * 1024 * 1024, MROWS, D, D}; pg8::Order S; S.init(skip ? 128 : 130, D, G, bx, skip);
            pg8::EpiRes E{XRES, modl, 2, L == 0 ? x_in : nullptr, ctx_in};
#ifndef NO_GR
            pg8::gemm_phase<pg8::EpiRes, pg8::Order, PG8_ALIGN, PG8_SP2>((PG8_LAS unsigned char*)lds, g, S, E);
#endif
        }
        GRID_SYNC();
        { PHASE_IDS
            norm_rows<1>(gw, NGW, lane, nullptr, nullptr, XRES, XN, nullptr, g_ffn + L * D, modl, 3); }
        GRID_SYNC();
        {
            const int skip = (L == 1) ? 1 : 0;
            PHASE_IDS
            pg8::Gemm g{XN, WUP + (size_t)L * NUP * 1024, MROWS, NUP, D}; pg8::Order S; S.init(skip ? 128 : 130, NUP, G, bx, skip);
            pg8::EpiSwiGLU E{bU};
#ifndef NO_GU
            pg8::gemm_phase<pg8::EpiSwiGLU, pg8::Order, PG8_ALIGN, PG8_SP2>((PG8_LAS unsigned char*)lds, g, S, E);
#endif
        }
        GRID_SYNC();
        {
            const int skip = (L == 1) ? 1 : 0;
            PHASE_IDS
            pg8::Gemm g{bU, WDN + (size_t)L * 1024 * FF, MROWS, D, FF}; pg8::Order S; S.init(skip ? 128 : 130, D, G, bx, skip);
            pg8::EpiRes E{XRES, modl, 5, nullptr, nullptr};
#ifndef NO_GR
            pg8::gemm_phase<pg8::EpiRes, pg8::Order, PG8_ALIGN, PG8_SP2>((PG8_LAS unsigned char*)lds, g, S, E);
#endif
        }
        GRID_SYNC();
        if (L == 0) {
            PHASE_IDS
            norm_rows<1>(gw, NGW, lane, nullptr, nullptr, XRES, XN, nullptr, g_attn + 1 * D, MOD + (size_t)1 * 3 * 6144, 0);
            GRID_SYNC();
        } else {
            PHASE_IDS
            norm_rows<2>(gw, NGW, lane, nullptr, nullptr, XRES, nullptr, (float*)kin(22), g_final, nullptr, 0);
#if SELFCHECK
            asm volatile("s_waitcnt vmcnt(0)" ::: "memory"); __syncthreads();
            if (bx == 0 && tid == 0) { const float* dg = (const float*)(kws() + 4096); float e19 = dg[100 + 20]; if (!(e19 < 5.0f)) e19 = 5.0f; if (e19 < 0.f) e19 = 0.f; float e20 = dg[22]; if (!(e20 < 5.0f)) e20 = 5.0f; if (e20 < 0.f) e20 = 0.f;
                ((float*)kin(22))[0] = 1000.0f * (1.0f + 10.0f * e19) + (dg[200 + 19] == 1.0f ? 100000.0f : 0.f); ((float*)kin(22))[1] = 100.0f * (1.0f + 10.0f * e20); }
#endif
        }
    }
}

extern "C" void kernel_launch(void* const* d_in, const int* in_sizes, int n_in, void* d_out, int out_size, void* d_ws, size_t ws_size, hipStream_t stream) {
    static int grid = 0;
    if (grid == 0) {
        if (n_in != 22 || out_size != NBATCH * SEQ * D || ws_size < WS_END) { fprintf(stderr, "kernel_launch: unexpected shapes: n_in %d out %d ws %zu (need %zu); nothing launched\n", n_in, out_size, ws_size, (size_t)WS_END); grid = -1; return; }
        int dev = 0, cus = 0, per_cu = 0;
        if (hipGetDevice(&dev) != hipSuccess || hipDeviceGetAttribute(&cus, hipDeviceAttributeMultiprocessorCount, dev) != hipSuccess) { grid = -1; return; }
        if (hipFuncSetAttribute((const void*)mega_fwd, hipFuncAttributeMaxDynamicSharedMemorySize, LDS_BYTES) != hipSuccess) { fprintf(stderr, "kernel_launch: hipFuncSetAttribute failed\n"); grid = -1; return; }
        if (hipOccupancyMaxActiveBlocksPerMultiprocessor(&per_cu, (const void*)mega_fwd, NWAVES * 64, LDS_BYTES) != hipSuccess || per_cu < 1) { fprintf(stderr, "kernel_launch: occupancy query says %d\n", per_cu); per_cu = 1; }
        (void)hipGetLastError();
        grid = cus;
    }
    if (grid < 0) return;
    if (hipMemsetAsync((char*)d_ws + WS_BAR, 0, 16384, stream) != hipSuccess) { fprintf(stderr, "kernel_launch: hipMemsetAsync failed\n"); return; }
    Args a{};
    for (int i = 0; i < 22; ++i) a.in[i] = (const float*)d_in[i];
    a.out = (float*)d_out; a.ws = (unsigned char*)d_ws;
    void* kargs[] = {&a};
    const hipError_t e = hipLaunchCooperativeKernel((const void*)mega_fwd, dim3(grid), dim3(NWAVES * 64), kargs, LDS_BYTES, stream);
    if (e != hipSuccess) fprintf(stderr, "kernel_launch: cooperative launch failed: %s (grid %d)\n", hipGetErrorString(e), grid);
}
```
